# Optimizing an MI355X kernel written in HIP

```python
import math
import jax, jax.numpy as jnp
from jax import lax
import numpy as np

D_MODEL = 1024
BATCH = 2
SEQ = 8192
DEPTH = 2
DEC_BATCH = 32
DEC_SEQ = 1
PAST_LEN = 8192
PAGE_SIZE = 128

H_A = 4
DK_A = 128
DV_A = 128
CONV_W = 4
CHUNK = 64
C_QKV = 2 * H_A * DK_A + H_A * DV_A
H_B = 8
G_B = 2
DH_B = 64
KV_B = 2 * G_B * DH_B
CMP_LEN = 32
CMP_STRIDE = 16
CMP_HID = 256
SLC_BLK = 64
N_SEL = 16
WINDOW = 512
Q_BLK = 128
D_FF = 2816
N_EXP = 8
TOP_K = 2
D_FF_EXP = 2816
IN_SPLITS = [C_QKV, H_A * DV_A, H_A, H_A, H_B * DH_B, KV_B, KV_B, KV_B, 3 * H_B, 2 * D_MODEL]
N_IN = C_QKV + H_A * DV_A + 2 * H_A + H_B * DH_B + 3 * KV_B + 3 * H_B + 2 * D_MODEL
ALPHA = (2 * DEPTH) ** 0.25
BETA_INIT = (8 * DEPTH) ** -0.25
EPS = 1e-5
F32 = jnp.float32

kernel_name = "hybrid_gdn_nsa_deepnorm_adaln_step"


def _split(x, sizes):
    offs = [int(o) for o in np.cumsum(sizes)[:-1]]
    return jnp.split(x, offs, axis=-1)


def _ln(x):
    xf = x.astype(F32)
    mu = jnp.mean(xf, -1, keepdims=True)
    var = jnp.mean(jnp.square(xf - mu), -1, keepdims=True)
    return (xf - mu) * lax.rsqrt(var + EPS)


def _ln_affine(x, g, b):
    return _ln(x) * g + b


def _l2norm(x):
    xf = x.astype(F32)
    return xf * lax.rsqrt(jnp.sum(xf * xf, -1, keepdims=True) + 1e-6)


def _gated_rmsnorm(o, z, w):
    of = o.astype(F32)
    o = of * lax.rsqrt(jnp.mean(of * of, -1, keepdims=True) + EPS) * w
    return o * jax.nn.silu(z.astype(F32))


def _masked_softmax(s, mask):
    s = jnp.where(mask, s.astype(F32), -1e30)
    m = jnp.max(s, -1, keepdims=True)
    e = jnp.where(mask, jnp.exp(s - m), 0.0)
    return e / jnp.maximum(jnp.sum(e, -1, keepdims=True), 1e-30)


def _short_conv(x, buf, w):
    T = x.shape[1]
    xp = jnp.concatenate([buf.astype(x.dtype), x], axis=1)
    y = sum(w[j] * xp[:, j:j + T] for j in range(CONV_W))
    return jax.nn.silu(y), xp[:, T:]


def _gated_delta_rule(q, k, v, beta, g, s0):
    B, T, H, DK = q.shape
    DV = v.shape[-1]
    n = -(-T // CHUNK)
    pad = n * CHUNK - T

    def prep(a):
        a = a.astype(F32)
        a = jnp.pad(a, [(0, 0), (0, pad)] + [(0, 0)] * (a.ndim - 2))
        a = a.reshape((B, n, CHUNK) + a.shape[2:])
        return jnp.moveaxis(a, 3, 1)

    q, k, v, beta, g = (prep(a) for a in (q, k, v, beta, g))
    q = q * (DK ** -0.5)
    gc = jnp.cumsum(g, axis=-1)
    idx = jnp.arange(CHUNK)
    incl = idx[:, None] >= idx[None, :]
    strict = idx[:, None] > idx[None, :]
    decay = jnp.exp(jnp.where(incl, gc[..., :, None] - gc[..., None, :], -jnp.inf))
    kb = k * beta[..., None]
    a = jnp.where(strict, jnp.einsum('bhnid,bhnjd->bhnij', kb, k) * decay, 0.0)
    rhs = jnp.concatenate([v * beta[..., None], kb * jnp.exp(gc)[..., None]], axis=-1)
    uw = lax.linalg.triangular_solve(a, rhs, left_side=True, lower=True, unit_diagonal=True)
    u, w = uw[..., :DV], uw[..., DV:]
    qk = jnp.einsum('bhnid,bhnjd->bhnij', q, k) * decay
    q_dec = q * jnp.exp(gc)[..., None]
    g_last = gc[..., -1]
    k_dec = k * jnp.exp(g_last[..., None] - gc)[..., None]

    def step(s, xs):
        u_n, w_n, qd_n, qk_n, kd_n, gl_n = xs
        v_new = u_n - jnp.einsum('bhck,bhkv->bhcv', w_n, s)
        o_n = jnp.einsum('bhck,bhkv->bhcv', qd_n, s) + jnp.einsum('bhij,bhjv->bhiv', qk_n, v_new)
        s = s * jnp.exp(gl_n)[..., None, None] + jnp.einsum('bhck,bhcv->bhkv', kd_n, v_new)
        return s, o_n

    xs = tuple(jnp.moveaxis(t_, 2, 0) for t_ in (u, w, q_dec, qk, k_dec, g_last))
    s_fin, o = lax.scan(step, s0.astype(F32), xs)
    o = jnp.transpose(o, (1, 0, 3, 2, 4)).reshape(B, n * CHUNK, H, DV)[:, :T]
    return o, s_fin


def _compress(rows, pos_emb, w1, w2):
    B, L = rows.shape[:2]
    r = CMP_LEN // CMP_STRIDE
    n_seg = L // CMP_STRIDE
    n_cmp = n_seg - r + 1
    seg = rows[:, :n_seg * CMP_STRIDE].reshape(B, n_seg, CMP_STRIDE, 2, G_B, DH_B)
    w1 = w1.reshape(2, r, CMP_STRIDE, DH_B, CMP_HID)
    pe = pos_emb.reshape(2, r, CMP_STRIDE, DH_B)
    hid = 0.0
    for m in range(r):
        part = seg[:, m:m + n_cmp] + jnp.transpose(pe[:, m], (1, 0, 2))[:, :, None, :]
        hid = hid + jnp.einsum('bnskgd,ksdh->bnkgh', part, w1[:, m])
    return jnp.einsum('bnkgh,khd->bnkgd', jax.nn.silu(hid), w2)


def _nsa(q, gates, rows_c, rows_s, win_pad, pos0, cmp_pos, cmp_w1, cmp_w2):
    B, T = q.shape[:2]
    L = rows_s.shape[1]
    R = H_B // G_B
    kv_cmp = _compress(rows_c, cmp_pos, cmp_w1, cmp_w2)
    kc, vc = kv_cmp[:, :, 0], kv_cmp[:, :, 1]
    n_cmp = kc.shape[1]
    cmp_end = jnp.arange(n_cmp) * CMP_STRIDE + CMP_LEN - 1
    n_slc = -(-L // SLC_BLK)
    kv_blk = jnp.pad(rows_s, [(0, 0), (0, n_slc * SLC_BLK - L), (0, 0), (0, 0), (0, 0)])
    kv_blk = kv_blk.reshape(B, n_slc, SLC_BLK, 2, G_B, DH_B).transpose(0, 4, 1, 2, 3, 5)
    ci = jnp.arange(n_cmp)[:, None] * CMP_STRIDE
    sj = jnp.arange(n_slc)[None, :] * SLC_BLK
    overlap = ((ci < sj + SLC_BLK) & (ci + CMP_LEN > sj)).astype(F32)
    n_sel = min(N_SEL, n_slc)
    qb = Q_BLK if T % Q_BLK == 0 else T
    n_qb = T // qb
    q_blocks = q.reshape(B, n_qb, qb, G_B, R, DH_B).transpose(1, 0, 2, 3, 4, 5)
    g_blocks = gates.reshape(B, n_qb, qb, H_B, 3).transpose(1, 0, 2, 3, 4)
    bi = jnp.arange(B)[:, None, None, None]
    gi = jnp.arange(G_B)[None, :, None, None]
    blk = jnp.arange(n_slc)
    scale = DH_B ** -0.5

    def block(args):
        iq, qbk, gbk = args
        t = pos0 + iq * qb + jnp.arange(qb)
        qf = qbk.astype(F32) * scale
        s = jnp.einsum('btgrd,bngd->bgrtn', qf, kc)
        p_c = _masked_softmax(s, cmp_end[None, :] <= t[:, None])
        o_c = jnp.einsum('bgrtn,bngd->btgrd', p_c, vc)
        imp = jnp.einsum('bgrtn,nj->bgtj', p_c, overlap)
        forced = (blk[None, :] == (t // SLC_BLK)[:, None]) | (blk[None, :] == 0)
        valid = blk[None, :] * SLC_BLK <= t[:, None]
        imp = jnp.where(forced, 1e9, jnp.where(valid, imp, -1.0))
        _, idx = lax.top_k(imp, n_sel)
        kv_sel = kv_blk[bi, gi, idx]
        s = jnp.einsum('btgrd,bgtnsd->bgrtns', qf, kv_sel[..., 0, :])
        kpos = idx[..., None] * SLC_BLK + jnp.arange(SLC_BLK)
        m_s = (kpos <= t[None, None, :, None, None])[:, :, None]
        p_s = _masked_softmax(s.reshape(B, G_B, R, qb, n_sel * SLC_BLK),
                              m_s.reshape(B, G_B, 1, qb, n_sel * SLC_BLK)).reshape(s.shape)
        o_s = jnp.einsum('bgrtns,bgtnsd->btgrd', p_s, kv_sel[..., 1, :])
        kv_w = lax.dynamic_slice_in_dim(win_pad, iq * qb, WINDOW + qb, axis=1)
        wpos = pos0 - WINDOW + iq * qb + jnp.arange(WINDOW + qb)
        dlt = t[:, None] - wpos[None, :]
        m_w = (dlt >= 0) & (dlt < WINDOW) & (wpos[None, :] >= 0)
        s = jnp.einsum('btgrd,bsgd->bgrts', qf, kv_w[:, :, 0])
        p_w = _masked_softmax(s, m_w)
        o_w = jnp.einsum('bgrts,bsgd->btgrd', p_w, kv_w[:, :, 1])
        gf = jax.nn.sigmoid(gbk.astype(F32)).reshape(B, qb, G_B, R, 3)
        return gf[..., 0:1] * o_c + gf[..., 1:2] * o_s + gf[..., 2:3] * o_w

    o = lax.map(block, (jnp.arange(n_qb), q_blocks, g_blocks))
    return o.transpose(1, 0, 2, 3, 4, 5).reshape(B, T, H_B * DH_B)


def _mixer(h, conv_buf, s0, past_c, past_s, win_buf, w_in, conv_w, a_log, dt_bias, norm_w_a,
           cmp_pos, cmp_w1, cmp_w2, w_up_a, w_up_b, w_out):
    B, T, _ = h.shape
    pos0 = past_s.shape[1]
    qkv_a, z_a, b_a, a_a, q_b, kv_c, kv_s, kv_w, g_b, g_m = _split(h @ w_in, IN_SPLITS)
    qkv_a, conv_new = _short_conv(qkv_a, conv_buf, conv_w)
    q_a, k_a, v_a = _split(qkv_a, [H_A * DK_A, H_A * DK_A, H_A * DV_A])
    q_a = _l2norm(q_a.reshape(B, T, H_A, DK_A))
    k_a = _l2norm(k_a.reshape(B, T, H_A, DK_A))
    v_a = v_a.reshape(B, T, H_A, DV_A)
    beta = jax.nn.sigmoid(b_a.astype(F32))
    g_dec = -jnp.exp(a_log) * jax.nn.softplus(a_a.astype(F32) + dt_bias)
    o_a, s_new = _gated_delta_rule(q_a, k_a, v_a, beta, g_dec, s0)
    o_a = _gated_rmsnorm(o_a, z_a.reshape(B, T, H_A, DV_A), norm_w_a).reshape(B, T, H_A * DV_A)
    kv_c = kv_c.reshape(B, T, 2, G_B, DH_B)
    kv_s = kv_s.reshape(B, T, 2, G_B, DH_B)
    kv_w = kv_w.reshape(B, T, 2, G_B, DH_B)
    rows_c = jnp.concatenate([past_c.astype(kv_c.dtype), kv_c], axis=1)
    rows_s = jnp.concatenate([past_s.astype(kv_s.dtype), kv_s], axis=1)
    win_all = jnp.concatenate([win_buf.astype(kv_w.dtype), kv_w], axis=1)
    n_w = win_all.shape[1]
    win_pad = jnp.pad(win_all, [(0, 0), (WINDOW + T - n_w, 0), (0, 0), (0, 0), (0, 0)])
    win_new = win_all[:, n_w - min(WINDOW, n_w):]
    o_b = _nsa(q_b.reshape(B, T, H_B, DH_B), g_b.reshape(B, T, H_B, 3), rows_c, rows_s, win_pad,
               pos0, cmp_pos, cmp_w1, cmp_w2)
    ga, gb = jnp.split(jax.nn.sigmoid(g_m.astype(F32)), 2, axis=-1)
    y = (ga * (o_a @ w_up_a) + gb * (o_b @ w_up_b)) @ w_out
    return y, s_new, conv_new, kv_c, kv_s, win_new


def _swiglu(h, w_gu, w_down):
    gt, up = jnp.split(h @ w_gu, 2, axis=-1)
    return (jax.nn.silu(gt) * up) @ w_down


def _moe(h, w_router, w_gu, w_down):
    B, T, D = h.shape
    x = h.reshape(B * T, D)
    probs = jax.nn.softmax((x @ w_router).astype(F32), axis=-1)
    top_p, top_i = lax.top_k(probs, TOP_K)
    top_p = top_p / jnp.sum(top_p, -1, keepdims=True)
    y = jnp.zeros((B * T, D), F32)
    for e in range(N_EXP):
        w_e = jnp.sum(jnp.where(top_i == e, top_p, 0.0), axis=-1)
        y = y + w_e[:, None] * _swiglu(x, w_gu[e], w_down[e])
    return y.reshape(B, T, D)


def setup_inputs(seed: int = 0) -> dict:
    key = jax.random.key(seed)
    ks = iter(jax.random.split(key, 40))

    def nrm(shape, s=1.0):
        return s * jax.random.normal(next(ks), shape, F32)

    n_pages = PAST_LEN // PAGE_SIZE
    n_used = DEC_BATCH * n_pages
    n_pool = n_used + max(1, n_used // 4)
    w_buf = min(WINDOW, PAST_LEN)
    n_dense = (DEPTH + 1) // 2
    n_moe = DEPTH // 2
    page_table = jax.random.permutation(next(ks), n_pool)[:n_used].reshape(DEC_BATCH, n_pages).astype(jnp.int32)
    dt = jnp.exp(jax.random.uniform(next(ks), (DEPTH, H_A), F32, math.log(1e-3), math.log(1e-1)))
    a_log = jnp.log(jax.random.uniform(next(ks), (DEPTH, H_A), F32, 1.0, 16.0))
    return {
        'x_prompt': nrm((BATCH, SEQ, D_MODEL)),
        'x_sample': nrm((DEC_BATCH, DEC_SEQ, D_MODEL)),
        'state_delta': nrm((DEPTH, DEC_BATCH, H_A, DK_A, DV_A), 0.1),
        'state_conv': nrm((DEPTH, DEC_BATCH, CONV_W - 1, C_QKV)),
        'cache_cmp_kv': nrm((DEPTH, n_pool, PAGE_SIZE, 2, G_B, DH_B)),
        'cache_slc_kv': nrm((DEPTH, n_pool, PAGE_SIZE, 2, G_B, DH_B)),
        'state_win_kv': nrm((DEPTH, DEC_BATCH, w_buf, 2, G_B, DH_B)),
        'page_table': page_table,
        'c_prompt': nrm((BATCH, D_MODEL)),
        'c_sample': nrm((DEC_BATCH, D_MODEL)),
        'w_ada': nrm((DEPTH, D_MODEL, 6 * D_MODEL), 0.1 * D_MODEL ** -0.5),
        'b_ada': nrm((DEPTH, 6 * D_MODEL), 0.01),
        'w_in': nrm((DEPTH, D_MODEL, N_IN), D_MODEL ** -0.5),
        'conv_w': nrm((DEPTH, CONV_W, C_QKV), CONV_W ** -0.5),
        'a_log': a_log,
        'dt_bias': dt + jnp.log(-jnp.expm1(-dt)),
        'norm_w_a': 1.0 + nrm((DEPTH, DV_A), 0.02),
        'cmp_pos': nrm((DEPTH, 2, CMP_LEN, DH_B), 0.02),
        'cmp_w1': nrm((DEPTH, 2, CMP_LEN * DH_B, CMP_HID), (CMP_LEN * DH_B) ** -0.5),
        'cmp_w2': nrm((DEPTH, 2, CMP_HID, DH_B), CMP_HID ** -0.5),
        'w_up_a': nrm((DEPTH, H_A * DV_A, D_MODEL), BETA_INIT * (H_A * DV_A) ** -0.5),
        'w_up_b': nrm((DEPTH, H_B * DH_B, D_MODEL), BETA_INIT * (H_B * DH_B) ** -0.5),
        'w_out': nrm((DEPTH, D_MODEL, D_MODEL), BETA_INIT * D_MODEL ** -0.5),
        'ln_g': 1.0 + nrm((DEPTH, 2, D_MODEL), 0.02),
        'ln_b': nrm((DEPTH, 2, D_MODEL), 0.02),
        'ffn_w_gu': nrm((n_dense, D_MODEL, 2 * D_FF), D_MODEL ** -0.5),
        'ffn_w_down': nrm((n_dense, D_FF, D_MODEL), BETA_INIT * D_FF ** -0.5),
        'moe_router': nrm((n_moe, D_MODEL, N_EXP), D_MODEL ** -0.5),
        'moe_w_gu': nrm((n_moe, N_EXP, D_MODEL, 2 * D_FF_EXP), D_MODEL ** -0.5),
        'moe_w_down': nrm((n_moe, N_EXP, D_FF_EXP, D_MODEL), BETA_INIT * D_FF_EXP ** -0.5),
    }


def reference(x_prompt, x_sample, state_delta, state_conv, cache_cmp_kv, cache_slc_kv, state_win_kv,
              page_table, c_prompt, c_sample, w_ada, b_ada, w_in, conv_w, a_log, dt_bias, norm_w_a,
              cmp_pos, cmp_w1, cmp_w2, w_up_a, w_up_b, w_out, ln_g, ln_b, ffn_w_gu, ffn_w_down,
              moe_router, moe_w_gu, moe_w_down):
    def layer(l, x, c, conv_buf, s0, past_c, past_s, win_buf):
        mod = jax.nn.silu(c.astype(F32)) @ w_ada[l] + b_ada[l]
        sh_m, sc_m, gt_m, sh_f, sc_f, gt_f = jnp.split(mod[:, None, :], 6, axis=-1)
        h = _ln(x) * (1.0 + sc_m) + sh_m
        y, s_new, conv_new, rows_c, rows_s, win_new = _mixer(
            h, conv_buf, s0, past_c, past_s, win_buf, w_in[l], conv_w[l], a_log[l], dt_bias[l],
            norm_w_a[l], cmp_pos[l], cmp_w1[l], cmp_w2[l], w_up_a[l], w_up_b[l], w_out[l])
        x = _ln_affine(ALPHA * x + gt_m * y, ln_g[l, 0], ln_b[l, 0])
        h = _ln(x) * (1.0 + sc_f) + sh_f
        if l % 2 == 0:
            f = _swiglu(h, ffn_w_gu[l // 2], ffn_w_down[l // 2])
        else:
            f = _moe(h, moe_router[l // 2], moe_w_gu[l // 2], moe_w_down[l // 2])
        x = _ln_affine(ALPHA * x + gt_f * f, ln_g[l, 1], ln_b[l, 1])
        return x, (s_new, conv_new, rows_c, rows_s, win_new)

    bp = x_prompt.shape[0]
    db = x_sample.shape[0]
    xp, xs = x_prompt, x_sample
    st_p, st_s = [], []
    for l in range(DEPTH):
        empty = jnp.zeros((bp, 0, 2, G_B, DH_B), F32)
        xp, sp = layer(l, xp, c_prompt, jnp.zeros((bp, CONV_W - 1, C_QKV), F32),
                       jnp.zeros((bp, H_A, DK_A, DV_A), F32), empty, empty, empty)
        past_c = cache_cmp_kv[l][page_table].reshape(db, -1, 2, G_B, DH_B)
        past_s = cache_slc_kv[l][page_table].reshape(db, -1, 2, G_B, DH_B)
        xs, ss = layer(l, xs, c_sample, state_conv[l], state_delta[l], past_c, past_s, state_win_kv[l])
        st_p.append(sp)
        st_s.append(ss)
    new_delta_p = jnp.stack([s[0] for s in st_p])
    new_conv_p = jnp.stack([s[1] for s in st_p])
    new_cmp_p = jnp.stack([s[2] for s in st_p])
    new_slc_p = jnp.stack([s[3] for s in st_p])
    new_win_p = jnp.stack([s[4] for s in st_p])
    new_delta_s = jnp.stack([s[0] for s in st_s])
    new_conv_s = jnp.stack([s[1] for s in st_s])
    new_cmp_s = jnp.stack([s[2] for s in st_s])
    new_slc_s = jnp.stack([s[3] for s in st_s])
    new_win_s = jnp.stack([s[4] for s in st_s])
    return (xp, xs, new_delta_p, new_conv_p, new_cmp_p, new_slc_p, new_win_p,
            new_delta_s, new_conv_s, new_cmp_s, new_slc_s, new_win_s)
```

```cpp
#include <hip/hip_runtime.h>
#include <cstdio>
#include <cstdint>
namespace pg8 {
#define PG8_LAS __attribute__((address_space(3)))
typedef unsigned short bf16_t;
typedef short bf16x8 __attribute__((ext_vector_type(8)));
typedef float f32x4 __attribute__((ext_vector_type(4)));
typedef unsigned u32x4 __attribute__((ext_vector_type(4)));
constexpr int BM = 256, BK = 64, HALF = 128, HTB = HALF * BK * 2  , STAGE_BYTES = 8 * HTB, NXCD = 8, WGM = 8;

__host__ __device__ __forceinline__ int lds_byte(int r, int c) { const int st = (r >> 4) * 2 + (c >> 5), rr = r & 15, cc = c & 31, ob = rr * 64 + cc * 2; return st * 1024 + (ob ^ (((ob >> 9) & 1) << 5)); }
__host__ __device__ __forceinline__ void stage_rc(int b, int& R, int& C) { const int st = b / 1024, sb = b % 1024, swz = sb ^ (((sb >> 9) & 1) << 5); R = (st >> 1) * 16 + swz / 64; C = (st & 1) * 32 + (swz % 64) / 2; }
__host__ __device__ __forceinline__ int perm32(int rho) { const int n = rho >> 4, i = rho & 15; return 8 * (i >> 2) + 4 * n + (i & 3); }

struct Unit { int pm, pn, am, bn, am2, bn2; };
struct Gemm { const bf16_t* A; const bf16_t* Bt; int M, N, K; };

struct StaticOrder {
    int nM, nN, nwg, G, c;
    __host__ __device__ void init(int M, int N, int G_, int c_) { nM = M / BM; nN = N / BM; nwg = nM * nN; G = G_; c = c_; }
    __host__ __device__ bool next(int i, Unit& u) const {
        const long L = (long)i * G + c; if (L >= nwg) return false;
        int wgid = (int)L; { const int q = nwg / NXCD, r = nwg % NXCD, xcd = wgid % NXCD, off = wgid / NXCD; wgid = (xcd < r ? xcd * (q + 1) : r * (q + 1) + (xcd - r) * q) + off; }
        const int nig = WGM * nN, gid = wgid / nig, fm = gid * WGM, gsz = (nM - fm) < WGM ? (nM - fm) : WGM;
        u.pm = fm + ((wgid % nig) % gsz); u.pn = (wgid % nig) / gsz; u.am = u.pm; u.bn = u.pn; u.am2 = 0; u.bn2 = 0; return true;
    }
    __device__ __forceinline__ void a_ready(const Unit&) const {}
    __device__ __forceinline__ void done(const Unit&) const {}
};

template <class Epi, class Sched, bool ALIGN_EPI = false, bool SP2 = false>
__device__ __forceinline__ void gemm_phase(PG8_LAS unsigned char* lds, const Gemm g, const Sched& S, const Epi& E, int tid_in) {
    int tid_ = tid_in; asm volatile("" : "+v"(tid_));
    const int tid = tid_, wid = __builtin_amdgcn_readfirstlane(tid >> 6), lane = tid & 63, wr = wid >> 2, wc = wid & 3, fr = lane & 15, fq = lane >> 4;
    const int K = g.K, nt = K / BK, ntot = Epi::CHAIN ? 2 * nt : nt;
    unsigned voffA[2], voffB[2];
#pragma unroll
    for (int i = 0; i < 2; ++i) { int R, C; stage_rc(tid * 16 + i * 8192, R, C); const int Rb = Epi::PERM ? ((R & ~31) + perm32(R & 31)) : R;
        voffA[i] = (unsigned)(R * K + C) * 2u; voffB[i] = (unsigned)(Rb * K + C) * 2u; }
    const size_t kstep = (size_t)(BK * 2);
    const size_t hstep = (size_t)HALF * K * 2;
    const size_t tstep = 2 * hstep;
    const unsigned ldsw = (unsigned)wid * 1024u;
    const int aoff = lds_byte(wr * 64 + fr, fq * 8), boff = lds_byte(wc * 32 + fr, fq * 8);
#define PG8_SA(b, h) (((b) * 2 + (h)) * HTB)
#define PG8_SB(b, h) ((4 + (b) * 2 + (h)) * HTB)
#define PG8_STAGE(bufoff, gbase, voff) do { _Pragma("unroll") for (int _i = 0; _i < 2; ++_i) \
        __builtin_amdgcn_global_load_lds((const unsigned*)((const char*)(gbase) + (voff)[_i]), (PG8_LAS unsigned*)(lds + (bufoff) + ldsw + _i * 8192), 16, 0, 0); } while (0)
#define PG8_LDA(dst, b, h) do { _Pragma("unroll") for (int m = 0; m < 4; ++m) _Pragma("unroll") for (int k = 0; k < 2; ++k) dst[m][k] = *(const PG8_LAS bf16x8*)(lds + PG8_SA(b, h) + aoff + m * 2048 + k * 1024); } while (0)
#define PG8_LDB(dst, b, h) do { _Pragma("unroll") for (int n = 0; n < 2; ++n) _Pragma("unroll") for (int k = 0; k < 2; ++k) dst[n][k] = *(const PG8_LAS bf16x8*)(lds + PG8_SB(b, h) + boff + n * 2048 + k * 1024); } while (0)
#define PG8_MMA(ai, bj, At, Bt) do { __builtin_amdgcn_s_setprio(1); _Pragma("unroll") for (int m = 0; m < 4; ++m) _Pragma("unroll") for (int n = 0; n < 2; ++n) _Pragma("unroll") for (int k = 0; k < 2; ++k) \
        acc[ai][bj][m][n] = __builtin_amdgcn_mfma_f32_16x16x32_bf16(Bt[n][k], At[m][k], acc[ai][bj][m][n], 0, 0, 0); __builtin_amdgcn_s_setprio(0); } while (0)
#define PG8_WAIT_V(n) asm volatile("s_waitcnt vmcnt(" #n ")" ::: "memory")
#define PG8_WAIT_L(n) asm volatile("s_waitcnt lgkmcnt(" #n ")" ::: "memory")
#define PG8_BAR __builtin_amdgcn_s_barrier()
#define PG8_SCHED __builtin_amdgcn_sched_barrier(0)
    Unit cur, nxt; int ui = 0;
    if (!S.next(0, cur)) return;
    f32x4 acc[2][2][4][2];
#pragma unroll
    for (int a = 0; a < 2; ++a)
#pragma unroll
        for (int b = 0; b < 2; ++b)
#pragma unroll
            for (int m = 0; m < 4; ++m)
#pragma unroll
                for (int n = 0; n < 2; ++n) acc[a][b][m][n] = (f32x4){0.f, 0.f, 0.f, 0.f};
    bf16x8 At[4][2], B0[2][2], B1[2][2];
    const char* cA = (const char*)g.A + (size_t)cur.am * tstep; const char* cB = (const char*)g.Bt + (size_t)cur.bn * tstep;
    const char* cA2 = cA; const char* cB2 = cB; if constexpr (Epi::CHAIN) { cA2 = (const char*)g.A + (size_t)cur.am2 * tstep; cB2 = (const char*)g.Bt + (size_t)cur.bn2 * tstep; }
#define PG8_TA(x) ((Epi::CHAIN && (x) >= nt) ? cA2 + (size_t)((x) - nt) * kstep : cA + (size_t)(x) * kstep)
#define PG8_TB(x) ((Epi::CHAIN && (x) >= nt) ? cB2 + (size_t)((x) - nt) * kstep : cB + (size_t)(x) * kstep)
    S.a_ready(cur);
    if constexpr (SP2) {
        PG8_STAGE(PG8_SB(0, 0), cB, voffB); PG8_STAGE(PG8_SB(0, 1), cB + hstep, voffB); PG8_STAGE(PG8_SA(0, 0), cA, voffA); PG8_STAGE(PG8_SA(0, 1), cA + hstep, voffA);
        if (wr == 1) PG8_BAR;
        PG8_WAIT_V(2); PG8_BAR;
        PG8_STAGE(PG8_SB(1, 0), cB + kstep, voffB); PG8_STAGE(PG8_SA(1, 0), cA + kstep, voffA); PG8_STAGE(PG8_SB(1, 1), cB + hstep + kstep, voffB);
        PG8_WAIT_V(6); PG8_BAR;
    } else {
        PG8_STAGE(PG8_SB(0, 0), cB, voffB); PG8_STAGE(PG8_SA(0, 0), cA, voffA); PG8_STAGE(PG8_SB(0, 1), cB + hstep, voffB); PG8_STAGE(PG8_SA(0, 1), cA + hstep, voffA);
        if (wr == 1) PG8_BAR;
        PG8_WAIT_V(4); PG8_BAR;
        PG8_STAGE(PG8_SB(1, 0), cB + kstep, voffB); PG8_STAGE(PG8_SA(1, 0), cA + kstep, voffA); PG8_STAGE(PG8_SB(1, 1), cB + hstep + kstep, voffB);
        PG8_WAIT_V(6); PG8_BAR;
    }
    for (;;) {
        const bool has_next = S.next(ui + 1, nxt);
        const char* nA = has_next ? (const char*)g.A + (size_t)nxt.am * tstep : cA; const char* nB = has_next ? (const char*)g.Bt + (size_t)nxt.bn * tstep : cB;
        for (int t = 0; t < ntot; t += 2) {
            if constexpr (Epi::CHAIN) { if (t == nt) E.mid(acc, cur, wr, wc, fr, fq); }
            const bool last = (t == ntot - 2);
            const char* a1 = PG8_TA(t + 1);
            const char* a2 = last ? nA : PG8_TA(t + 2); const char* b2 = last ? nB : PG8_TB(t + 2);
            const char* a3 = a2 + kstep; const char* b3 = b2 + kstep;
            if (last && has_next) S.a_ready(nxt);
            if constexpr (SP2) {
            PG8_LDB(B0, 0, 0); PG8_LDB(B1, 0, 1); PG8_SCHED; PG8_LDA(At, 0, 0); PG8_STAGE(PG8_SA(1, 1), a1 + hstep, voffA);
            PG8_WAIT_V(8); PG8_WAIT_L(0); PG8_BAR; PG8_MMA(0, 0, At, B0); PG8_MMA(0, 1, At, B1); PG8_BAR; PG8_SCHED;
            PG8_LDA(At, 0, 1); PG8_STAGE(PG8_SB(0, 0), b2, voffB); PG8_STAGE(PG8_SB(0, 1), b2 + hstep, voffB); PG8_STAGE(PG8_SA(0, 0), a2, voffA);
            PG8_WAIT_V(8); PG8_WAIT_L(0); PG8_BAR; PG8_MMA(1, 0, At, B0); PG8_MMA(1, 1, At, B1); PG8_BAR; PG8_SCHED;
            PG8_LDB(B0, 1, 0); PG8_LDB(B1, 1, 1); PG8_SCHED; PG8_LDA(At, 1, 0); PG8_STAGE(PG8_SA(0, 1), a2 + hstep, voffA);
            PG8_WAIT_V(8); PG8_WAIT_L(0); PG8_BAR; PG8_MMA(0, 0, At, B0); PG8_MMA(0, 1, At, B1); PG8_BAR; PG8_SCHED;
            PG8_LDA(At, 1, 1); PG8_STAGE(PG8_SB(1, 0), b3, voffB); PG8_STAGE(PG8_SB(1, 1), b3 + hstep, voffB); PG8_STAGE(PG8_SA(1, 0), a3, voffA);
            PG8_WAIT_V(8); PG8_WAIT_L(0); PG8_BAR; PG8_MMA(1, 0, At, B0); PG8_MMA(1, 1, At, B1); PG8_BAR; PG8_SCHED;
            } else {
            PG8_LDB(B0, 0, 0); PG8_SCHED; PG8_LDA(At, 0, 0); PG8_STAGE(PG8_SA(1, 1), a1 + hstep, voffA);
            PG8_WAIT_L(8); PG8_BAR; PG8_WAIT_L(0); PG8_MMA(0, 0, At, B0); PG8_BAR; PG8_SCHED;
            PG8_LDB(B1, 0, 1); PG8_STAGE(PG8_SB(0, 0), b2, voffB);
            PG8_BAR; PG8_WAIT_L(0); PG8_MMA(0, 1, At, B1); PG8_BAR;
            PG8_LDA(At, 0, 1); PG8_STAGE(PG8_SA(0, 0), a2, voffA);
            PG8_BAR; PG8_WAIT_L(0); PG8_MMA(1, 0, At, B0); PG8_BAR; PG8_SCHED;
            PG8_STAGE(PG8_SB(0, 1), b2 + hstep, voffB);
            PG8_WAIT_V(6); PG8_BAR; PG8_MMA(1, 1, At, B1); PG8_BAR;
            PG8_LDB(B0, 1, 0); PG8_SCHED; PG8_LDA(At, 1, 0); PG8_STAGE(PG8_SA(0, 1), a2 + hstep, voffA);
            PG8_WAIT_L(8); PG8_BAR; PG8_WAIT_L(0); PG8_MMA(0, 0, At, B0); PG8_BAR; PG8_SCHED;
            PG8_LDB(B1, 1, 1); PG8_STAGE(PG8_SB(1, 0), b3, voffB);
            PG8_BAR; PG8_WAIT_L(0); PG8_MMA(0, 1, At, B1); PG8_BAR;
            PG8_LDA(At, 1, 1); PG8_STAGE(PG8_SA(1, 0), a3, voffA);
            PG8_BAR; PG8_WAIT_L(0); PG8_MMA(1, 0, At, B0); PG8_BAR; PG8_SCHED;
            PG8_STAGE(PG8_SB(1, 1), b3 + hstep, voffB);
            PG8_WAIT_V(6); PG8_BAR; PG8_MMA(1, 1, At, B1); PG8_BAR;
            }
        }
        if constexpr (ALIGN_EPI) { if (wr == 0) PG8_BAR; }
        if constexpr (!Epi::AFTER_DRAIN) { E(acc, cur, wr, wc, fr, fq); S.done(cur); }
        if (!has_next) break;
#pragma unroll
        for (int a = 0; a < 2; ++a)
#pragma unroll
            for (int b = 0; b < 2; ++b)
#pragma unroll
                for (int m = 0; m < 4; ++m)
#pragma unroll
                    for (int n = 0; n < 2; ++n) acc[a][b][m][n] = (f32x4){0.f, 0.f, 0.f, 0.f};
        cur = nxt; cA = nA; cB = nB; ++ui;
        if constexpr (Epi::CHAIN) { cA2 = (const char*)g.A + (size_t)cur.am2 * tstep; cB2 = (const char*)g.Bt + (size_t)cur.bn2 * tstep; }
        if constexpr (ALIGN_EPI) { if (wr == 1) PG8_BAR; }
    }
    PG8_WAIT_V(0);
    if constexpr (!ALIGN_EPI) { if (wr == 0) PG8_BAR; }
    PG8_BAR;
    if constexpr (Epi::AFTER_DRAIN) { E.fused(acc, cur, wr, wc, fr, fq, lds, wid, lane); S.done(cur); }
#undef PG8_SA
#undef PG8_SB
#undef PG8_STAGE
#undef PG8_LDA
#undef PG8_LDB
#undef PG8_MMA
#undef PG8_WAIT_V
#undef PG8_WAIT_L
#undef PG8_BAR
#undef PG8_SCHED
#undef PG8_TA
#undef PG8_TB
}
}
#define GAS __attribute__((address_space(1)))
#define LAS __attribute__((address_space(3)))
typedef unsigned short bf16;
typedef unsigned v4u __attribute__((ext_vector_type(4)));
typedef unsigned v2u __attribute__((ext_vector_type(2)));
typedef float f32x4 __attribute__((ext_vector_type(4)));
typedef float f32x2 __attribute__((ext_vector_type(2)));
typedef short bf16x8 __attribute__((ext_vector_type(8)));
typedef short bf16x4 __attribute__((ext_vector_type(4)));
typedef GAS unsigned gu32;
#define RLX_AGENT __ATOMIC_RELAXED, __HIP_MEMORY_SCOPE_AGENT
#define LDS_WAIT() asm volatile("s_waitcnt lgkmcnt(0)" ::: "memory")
#define VM_WAIT() asm volatile("s_waitcnt vmcnt(0)" ::: "memory")

constexpr int NWAVES = 8, NTHR = 512;
constexpr int D = 1024, SEQ = 8192, NB = 2, MP = NB * SEQ, MS = 32, MT = 16640, NTILE_M = MT / 256, MREAL = MP + MS;
constexpr int H_A = 4, DK = 128, DV = 128, CQKV = 1536, CHUNK = 64, NCHUNK = SEQ / CHUNK;
constexpr int H_B = 8, G_B = 2, DH = 64, KVW = 256;
constexpr int NCMP = 511, NSLC = 128, NSEL = 16, WINDOW = 512;
constexpr int DFF = 2816, NEXP = 8;
constexpr int NIN = 5408, NINP = 5632;
constexpr int PAST = 8192, PAGE = 128, NPAGES = 64, NPOOL = 2560;
constexpr float ALPHA = 1.4142135623730951f;
constexpr float LN_EPS = 1e-5f;
constexpr int PC_QKV = 0, PC_Z = 1536, PC_QB = 2048, PC_KVC = 2560, PC_KVS = 2816, PC_KVW = 3072, PC_GM = 3328, PC_SM = 5376;

constexpr size_t O_YP = 0, O_YS = O_YP + (size_t)MP * D, O_DELTA_P = O_YS + (size_t)MS * D, O_CONV_P = O_DELTA_P + 2ull * 2 * 4 * 128 * 128,
    O_CMP_P = O_CONV_P + 2ull * 2 * 3 * 1536, O_SLC_P = O_CMP_P + 2ull * 2 * 8192 * 256, O_WIN_P = O_SLC_P + 2ull * 2 * 8192 * 256,
    O_DELTA_S = O_WIN_P + 2ull * 2 * 512 * 256, O_CONV_S = O_DELTA_S + 2ull * 32 * 4 * 128 * 128, O_CMP_S = O_CONV_S + 2ull * 32 * 3 * 1536,
    O_SLC_S = O_CMP_S + 2ull * 32 * 256, O_WIN_S = O_SLC_S + 2ull * 32 * 256, O_END = O_WIN_S + 2ull * 32 * 512 * 256;

enum { I_XP = 0, I_XS, I_SDELTA, I_SCONV, I_CCMP, I_CSLC, I_SWIN, I_PT, I_CP, I_CS, I_WADA, I_BADA, I_WIN, I_CONVW, I_ALOG, I_DTB, I_NORMW,
       I_CPOS, I_CW1, I_CW2, I_WUPA, I_WUPB, I_WOUT, I_LNG, I_LNB, I_FGU, I_FDN, I_MR, I_MGU, I_MDN, N_INPUTS };

constexpr size_t MiB = 1u << 20;
constexpr size_t WS_CTL = 0, WS_MOD = 1 * MiB, ZERO_BYTES = 4 * MiB;
constexpr size_t WS_WIN_T = 4 * MiB, WS_WUP_T = 26 * MiB, WS_WOUT_T = 30 * MiB, WS_WGU_T = 34 * MiB, WS_WDN_T = 45 * MiB, WS_MGU_T = 51 * MiB, WS_MDN_T = 139 * MiB, WS_CW1_T = 183 * MiB;
constexpr size_t WS_XN = 192 * MiB, WS_P = 225 * MiB, WS_SC = 404 * MiB, WS_XA = 407 * MiB, WS_XB = 472 * MiB, WS_Y = 537 * MiB, WS_OAB = 674 * MiB, WS_U = 707 * MiB,
    WS_ACT = 740 * MiB, WS_APERM = 929 * MiB, WS_MOE = 998 * MiB;
constexpr size_t WS_GDN = 1000 * MiB, WS_NSA = 1110 * MiB, WS_SMP = 1150 * MiB, WS_END = 1560 * MiB;
constexpr int CW_TMO = 0, CW_BAR = 4096;
constexpr int MODROWS = 34, MODW = 6144;

constexpr int RING_OFF = 0, RING_BYTES = 131072;
constexpr int LDSCTL_OFF = RING_BYTES, MISC_OFF = LDSCTL_OFF + 320;
constexpr int LDS_BYTES = 147456;

__device__ __forceinline__ unsigned f2bf(float f) { unsigned u = __builtin_bit_cast(unsigned, f); return (u + 0x7fffu + ((u >> 16) & 1u)) >> 16; }
__device__ __forceinline__ unsigned pk2(float lo, float hi) { return f2bf(lo) | (f2bf(hi) << 16); }
__device__ __forceinline__ float bf2f(unsigned short b) { return __builtin_bit_cast(float, (unsigned)b << 16); }
__device__ __forceinline__ float bflo(unsigned w) { return __builtin_bit_cast(float, w << 16); }
__device__ __forceinline__ float bfhi(unsigned w) { return __builtin_bit_cast(float, w & 0xffff0000u); }
__device__ __forceinline__ float add1(float e) { float one = 1.f; asm volatile("" : "+v"(one)); return e + one; }
__device__ __forceinline__ float sigmoidf_(float x) { return __builtin_amdgcn_rcpf(add1(__expf(-x))); }
__device__ __forceinline__ float siluf_(float x) { return x * __builtin_amdgcn_rcpf(add1(__expf(-x))); }
__device__ __forceinline__ float softplusf_(float x) { const float e = __expf(x); return x > 20.f ? x : (e < 0.01f ? e * (1.f - e * (0.5f - e * 0.33333334f)) : __logf(1.f + e)); }
__device__ __forceinline__ int my_lane() { int l = (int)__builtin_amdgcn_mbcnt_hi(~0u, __builtin_amdgcn_mbcnt_lo(~0u, 0u)); asm volatile("" : "+v"(l)); return l; }
__device__ __forceinline__ float bperm(float v, int srclane) { return __builtin_bit_cast(float, __builtin_amdgcn_ds_bpermute(srclane << 2, __builtin_bit_cast(int, v))); }
template <int O> __device__ __forceinline__ float shx(float v) { return bperm(v, my_lane() ^ O); }
__device__ __forceinline__ float wave_sum(float v) { v += shx<1>(v); v += shx<2>(v); v += shx<4>(v); v += shx<8>(v); v += shx<16>(v); v += shx<32>(v); return v; }
__device__ __forceinline__ float wave_max(float v) { v = fmaxf(v, shx<1>(v)); v = fmaxf(v, shx<2>(v)); v = fmaxf(v, shx<4>(v)); v = fmaxf(v, shx<8>(v)); v = fmaxf(v, shx<16>(v)); v = fmaxf(v, shx<32>(v)); return v; }
#define XB_TMO      128
#define XB_XCNT(j)  (256  + 64 * (j))
#define XB_XSUB(j)  (1280 + 64 * (j))
#define XB_XGEN(j)  (2304 + 64 * (j))
#define XB_TOP      3328
#define XB_TOPGEN   3392
#define XCD_BAR_WORDS 3456
#define XB_SPIN_CAP (1u << 18)

__device__ __forceinline__ unsigned xb_ld(unsigned* p)              { return __hip_atomic_load(p, __ATOMIC_RELAXED, __HIP_MEMORY_SCOPE_AGENT); }
__device__ __forceinline__ unsigned xb_add(unsigned* p, unsigned v) { return __hip_atomic_fetch_add(p, v, __ATOMIC_RELAXED, __HIP_MEMORY_SCOPE_AGENT); }
__device__ __forceinline__ unsigned xb_xcc_id() { return (unsigned)__builtin_amdgcn_s_getreg((3 << 11) | 20) & 0xFu; }
#define XB_SPIN(cond, bar) do { unsigned _sp = 0; while (cond) { __builtin_amdgcn_s_sleep(1); \
    if ((++_sp & 255u) == 0u) { if (xb_ld(&(bar)[XB_TMO])) break; if (_sp > XB_SPIN_CAP) { atomicAdd(&(bar)[XB_TMO], 1u); break; } } } } while (0)

struct XcdBarrier {
    unsigned* bar; unsigned x;
    volatile LAS unsigned* st;
};

__device__ __forceinline__ XcdBarrier xcd_barrier_post(unsigned* bar, volatile LAS unsigned* st) {
    XcdBarrier b; b.bar = bar; b.x = xb_xcc_id(); b.st = st;
    if (threadIdx.x == 0) (void)xb_add(&bar[XB_XCNT(b.x)], 1u);
    return b;
}
__device__ __forceinline__ void xcd_barrier_complete(unsigned* bar, unsigned x, unsigned& nloc, unsigned& nx) {
    const unsigned G = gridDim.x * gridDim.y * gridDim.z;
    unsigned sum, cnt, mine, sp = 0u;
    for (;;) {
        sum = 0u; cnt = 0u; mine = 0u;
#pragma unroll
        for (unsigned j = 0; j < 16; ++j) { const unsigned c = xb_ld(&bar[XB_XCNT(j)]); sum += c; cnt += (c > 0u) ? 1u : 0u; mine = (j == x) ? c : mine; }
        if (sum == G) break;
        __builtin_amdgcn_s_sleep(1);
        if ((++sp & 255u) == 0u) { if (xb_ld(&bar[XB_TMO])) break; if (sp > XB_SPIN_CAP) { atomicAdd(&bar[XB_TMO], 1u); break; } }
    }
    nloc = mine > 0u ? mine : 1u; nx = cnt > 0u ? cnt : 1u;
}

__device__ __forceinline__ void xcd_barrier(const XcdBarrier& b) {
    asm volatile("s_waitcnt vmcnt(0)" ::: "memory");
    __syncthreads();
    if (threadIdx.x == 0) {
        unsigned* bar = b.bar;
        __builtin_amdgcn_s_waitcnt(0);
        unsigned nloc = b.st[0], nx = b.st[1];
        if (nloc == 0u) { xcd_barrier_complete(bar, b.x, nloc, nx); b.st[0] = nloc; b.st[1] = nx; }
        const unsigned old = xb_add(&bar[XB_XSUB(b.x)], 1u);
        const unsigned gen = old / nloc;
        if (old + 1u == (gen + 1u) * nloc) {
            __builtin_amdgcn_fence(__ATOMIC_RELEASE, "agent");
            asm volatile("s_waitcnt vmcnt(0)" ::: "memory");
            const unsigned og = xb_add(&bar[XB_TOP], 1u);
            const unsigned tg = og / nx;
            if (og + 1u == (tg + 1u) * nx) xb_add(&bar[XB_TOPGEN], 1u);
            else XB_SPIN(xb_ld(&bar[XB_TOPGEN]) == tg, bar);
            __builtin_amdgcn_fence(__ATOMIC_ACQUIRE, "agent");
            xb_add(&bar[XB_XGEN(b.x)], 1u);
            asm volatile("s_waitcnt vmcnt(0)" ::: "memory");
        } else {
            XB_SPIN(xb_ld(&bar[XB_XGEN(b.x)]) == gen, bar);
            __builtin_amdgcn_fence(__ATOMIC_ACQUIRE, "agent");
            asm volatile("s_waitcnt vmcnt(0)" ::: "memory");
        }
    }
    __syncthreads();
}

struct Args { const void* in[30]; float* out; unsigned char* ws; int ph_lo, ph_hi; };
struct Frame {
    LAS unsigned char* lds;
    volatile LAS unsigned* MISC;
    gu32* ctl;
    int tid, lane, wave, G, bid;
};
__device__ __forceinline__ const void* ld_in(const Args& a, int i) { int z = 0; asm volatile("" : "+s"(z)); return a.in[i + z]; }
#define INP(T, i) ((const T*)ld_in(a, i))
__device__ __forceinline__ unsigned char* ws_base(const Args& a) { unsigned char* p = a.ws; asm volatile("" : "+s"(p)); return p; }
#define WSP(T, off) ((T*)(ws_base(a) + (off)))

constexpr int PH_PRO = 0, NPL = 14, NPH = 1 + 2 * NPL;
constexpr int LP_LNMOD = 0, LP_INPROJ = 1, LP_PREP = 2, LP_CMP1 = 3, LP_CMP2 = 4, LP_MIX = 5, LP_ONORM = 6, LP_UP = 7, LP_OUT = 8, LP_LN1 = 9, LP_MOEG = 10, LP_FFN1 = 11, LP_FFN2 = 12, LP_LN2 = 13;

template <int MAP> __device__ __forceinline__ int srccol(int n) {
    if (MAP == 0) return n;
    if (MAP == 1) {
        if (n < 2048) return n;
        if (n < 2560) return 2056 + (n - 2048);
        if (n < 3328) return 2568 + (n - 2560);
        if (n < 5376) { const int w = n - 3328; return 3360 + ((w >> 7) & 1) * 1024 + 128 * (w >> 8) + (w & 127); }
        if (n < 5384) return 2048 + (n - 5376);
        if (n < 5408) return 3336 + (n - 5384);
        return -1;
    }
    { const int pn = n >> 8, w = n & 255; return (w >> 7) * DFF + 128 * pn + (w & 127); }
}
template <int MAP> __device__ __forceinline__ void transpose_item(const float* W, int K, int Nsrc, bf16* WT, LAS float* scr, int kb, int nb, int lane) {
    const int k0 = 64 * kb, n0 = 32 * nb, sc = srccol<MAP>(n0 + (lane & 31));
#pragma unroll 8
    for (int i = 0; i < 32; ++i) { const int kk = 2 * i + (lane >> 5); scr[kk * 33 + (lane & 31)] = sc >= 0 ? W[(size_t)(k0 + kk) * Nsrc + sc] : 0.f; }
    LDS_WAIT(); asm volatile("" ::: "memory");
    const int c = lane & 7;
#pragma unroll
    for (int j = 0; j < 4; ++j) { const int n = (lane >> 3) + 8 * j; const LAS float* s = scr + (8 * c) * 33 + n;
        v4u o; o.x = pk2(s[0 * 33], s[1 * 33]); o.y = pk2(s[2 * 33], s[3 * 33]); o.z = pk2(s[4 * 33], s[5 * 33]); o.w = pk2(s[6 * 33], s[7 * 33]);
        *(GAS v4u*)(WT + (size_t)(n0 + n) * K + k0 + 8 * c) = o; }
    LDS_WAIT(); asm volatile("" ::: "memory");
}
template <int MAP> __device__ __forceinline__ void convert_matrix(Frame& F, const float* W, int K, int Nsrc, bf16* WT, int Ndest, int rot) {
    LAS float* scr = (LAS float*)(F.lds + RING_OFF + F.wave * 16384);
    const int NGW = F.G * NWAVES, gw = (F.bid * NWAVES + F.wave + rot) % NGW, nnb = Ndest / 32, nitems = (K / 64) * nnb;
    for (int it = gw; it < nitems; it += NGW) transpose_item<MAP>(W, K, Nsrc, WT, scr, it / nnb, it % nnb, F.lane);
}
__device__ __forceinline__ void mod_gemv(Frame& F, const Args& a) {
    LAS float* s = (LAS float*)(F.lds + RING_OFF);
    float* MOD = WSP(float, WS_MOD);
    for (int item = F.bid; item < 48; item += F.G) {
        const int l = item / 24, rg = (item % 24) / 12, cb = item % 12;
        for (int idx = F.tid; idx < 17 * 1024; idx += NTHR) { const int r = rg * 17 + (idx >> 10), k = idx & 1023;
            const float c = r < 2 ? INP(float, I_CP)[r * D + k] : INP(float, I_CS)[(r - 2) * D + k]; s[idx] = siluf_(c); }
        __syncthreads();
        const int col = cb * 512 + F.wave * 64 + F.lane;
        const float* W = INP(float, I_WADA) + (size_t)l * D * MODW + col;
        float acc[17];
#pragma unroll
        for (int r = 0; r < 17; ++r) acc[r] = 0.f;
        for (int k4 = 0; k4 < 256; ++k4) {
            const float w0 = W[(size_t)(4 * k4 + 0) * MODW], w1 = W[(size_t)(4 * k4 + 1) * MODW], w2 = W[(size_t)(4 * k4 + 2) * MODW], w3 = W[(size_t)(4 * k4 + 3) * MODW];
#pragma unroll
            for (int r = 0; r < 17; ++r) { const f32x4 f = *(const LAS f32x4*)(s + r * 1024 + 4 * k4); acc[r] += f.x * w0 + f.y * w1 + f.z * w2 + f.w * w3; }
        }
        const float bias = INP(float, I_BADA)[l * MODW + col];
#pragma unroll
        for (int r = 0; r < 17; ++r) MOD[(size_t)(l * MODROWS + rg * 17 + r) * MODW + col] = acc[r] + bias;
        __syncthreads();
    }
}
__device__ __forceinline__ void copy_f4(Frame& F, const float* src, float* dst, size_t n4) {
    const size_t stride = (size_t)F.G * NTHR;
    for (size_t i = (size_t)F.bid * NTHR + F.tid; i < n4; i += stride) ((GAS f32x4*)dst)[i] = ((const GAS f32x4*)src)[i];
}
__device__ __forceinline__ void nsa_prologue(Frame& F, const Args& a);
__device__ __forceinline__ void p0_prologue(Frame& F, const Args& a) {
    mod_gemv(F, a);
    nsa_prologue(F, a);
    for (int lb = 0; lb < 64; ++lb) {
        copy_f4(F, INP(float, I_SWIN) + ((size_t)lb * 512 + 1) * 256, a.out + O_WIN_S + (size_t)lb * 512 * 256, 511 * 256 / 4);
        copy_f4(F, INP(float, I_SCONV) + ((size_t)lb * 3 + 1) * 1536, a.out + O_CONV_S + (size_t)lb * 3 * 1536, 2 * 1536 / 4);
    }
    int rot = 0;
    for (int l = 0; l < 2; ++l) { convert_matrix<1>(F, INP(float, I_WIN) + (size_t)l * D * NIN, D, NIN, WSP(bf16, WS_WIN_T) + (size_t)l * NINP * D, NINP, rot); rot += 2816; }
    for (int l = 0; l < 2; ++l) {
        convert_matrix<0>(F, INP(float, I_WUPA) + (size_t)l * 512 * D, 512, D, WSP(bf16, WS_WUP_T) + (size_t)l * 2048 * 512, D, rot); rot += 256;
        convert_matrix<0>(F, INP(float, I_WUPB) + (size_t)l * 512 * D, 512, D, WSP(bf16, WS_WUP_T) + (size_t)l * 2048 * 512 + (size_t)1024 * 512, D, rot); rot += 256;
        convert_matrix<0>(F, INP(float, I_WOUT) + (size_t)l * D * D, D, D, WSP(bf16, WS_WOUT_T) + (size_t)l * D * D, D, rot); rot += 512;
    }
    convert_matrix<2>(F, INP(float, I_FGU), D, 2 * DFF, WSP(bf16, WS_WGU_T), 2 * DFF, rot); rot += 2816;
    convert_matrix<0>(F, INP(float, I_FDN), DFF, D, WSP(bf16, WS_WDN_T), D, rot); rot += 1408;
    for (int e = 0; e < NEXP; ++e) {
        convert_matrix<2>(F, INP(float, I_MGU) + (size_t)e * D * 2 * DFF, D, 2 * DFF, WSP(bf16, WS_MGU_T) + (size_t)e * 2 * DFF * D, 2 * DFF, rot); rot += 2816;
        convert_matrix<0>(F, INP(float, I_MDN) + (size_t)e * DFF * D, DFF, D, WSP(bf16, WS_MDN_T) + (size_t)e * D * DFF, D, rot); rot += 1408;
    }
    for (int q = 0; q < 8; ++q) {
        convert_matrix<0>(F, INP(float, I_CW1) + ((size_t)(q >> 1) * 2048 + (size_t)(q & 1) * 1024) * 256, 1024, 256, WSP(bf16, WS_CW1_T) + ((size_t)(q >> 1) * 512 + (size_t)(q & 1) * 256) * 1024, 256, rot); rot += 128;
    }
}

__device__ __forceinline__ const float* mod_row(const Args& a, int l, int row) { return WSP(float, WS_MOD) + (size_t)(l * MODROWS + (row < MP ? (row >> 13) : 2 + (row - MP))) * MODW; }
__device__ __forceinline__ const float* x_in_row(const Args& a, int row) { return row < MP ? INP(float, I_XP) + (size_t)row * D : INP(float, I_XS) + (size_t)(row - MP) * D; }
__device__ __forceinline__ void row_stats(const f32x4 (&v)[4], float& mean, float& rstd) {
    float s = 0.f;
#pragma unroll
    for (int j = 0; j < 4; ++j) s += (v[j].x + v[j].y) + (v[j].z + v[j].w);
    mean = wave_sum(s) * (1.f / D); float q = 0.f;
#pragma unroll
    for (int j = 0; j < 4; ++j) { const f32x4 d = v[j] - mean; q += (d.x * d.x + d.y * d.y) + (d.z * d.z + d.w * d.w); }
    rstd = 1.f / sqrtf(wave_sum(q) * (1.f / D) + LN_EPS);
}
__device__ __forceinline__ void mod_ln_store(const f32x4 (&v)[4], const float* sh, const float* sc, bf16* orow, int lane) {
    float mean, rstd; row_stats(v, mean, rstd);
#pragma unroll
    for (int j = 0; j < 4; ++j) { const int c = 256 * j + 4 * lane; const f32x4 s1 = *(const GAS f32x4*)(sc + c), s0 = *(const GAS f32x4*)(sh + c);
        const f32x4 xh = (v[j] - mean) * rstd; const f32x4 h = xh * s1 + (xh + s0); v2u o; o.x = pk2(h.x, h.y); o.y = pk2(h.z, h.w); *(GAS v2u*)(orow + c) = o; }
}
__device__ __forceinline__ void p_lnmod0(Frame& F, const Args& a) {
    const int gw = F.bid * NWAVES + F.wave, NGW = F.G * NWAVES; bf16* XN = WSP(bf16, WS_XN);
    for (int row = gw; row < MT; row += NGW) {
        if (row >= MREAL) { for (int j = 0; j < 4; ++j) *(GAS v2u*)(XN + (size_t)row * D + 256 * j + 4 * F.lane) = (v2u){0u, 0u}; continue; }
        const float* xr = x_in_row(a, row); f32x4 v[4];
#pragma unroll
        for (int j = 0; j < 4; ++j) v[j] = *(const GAS f32x4*)(xr + 256 * j + 4 * F.lane);
        const float* mr = mod_row(a, 0, row);
        mod_ln_store(v, mr, mr + D, XN + (size_t)row * D, F.lane);
    }
}
constexpr size_t MOE_META = WS_MOE, MOE_SLOT = WS_MOE + 64 * 1024, MOE_EPOS = WS_MOE + 256 * 1024, MOE_PROB = WS_MOE + 1 * MiB;
constexpr int CW_MOECNT = 2048;
template <int YMODE, bool ROUTE> __device__ __forceinline__ void p_lnpass(Frame& F, const Args& a, int l, int which, const float* xsrc, float* xdst, const float* Y) {
    const int gw = F.bid * NWAVES + F.wave, NGW = F.G * NWAVES; bf16* XN = WSP(bf16, WS_XN);
    const float* lg = INP(float, I_LNG) + (size_t)(l * 2 + which) * D; const float* lb = INP(float, I_LNB) + (size_t)(l * 2 + which) * D;
    const int* mslot = WSP(int, MOE_SLOT); float* mprob = WSP(float, MOE_PROB);
    for (int row = gw; row < MREAL; row += NGW) {
        const float* xr = xsrc ? xsrc + (size_t)row * D : x_in_row(a, row);
        const float* mr = mod_row(a, l, row); const float* gate = mr + (which ? 5 : 2) * D;
        f32x4 v[4];
#pragma unroll
        for (int j = 0; j < 4; ++j) { const int c = 256 * j + 4 * F.lane; f32x4 x = *(const GAS f32x4*)(xr + c) * ALPHA;
            if (YMODE == 1) { x += *(const GAS f32x4*)(gate + c) * *(const GAS f32x4*)(Y + (size_t)row * D + c); }
            if (YMODE == 2) { const int s0 = mslot[2 * row], s1 = mslot[2 * row + 1]; const float p0 = mprob[2 * row], p1 = mprob[2 * row + 1];
                x += *(const GAS f32x4*)(gate + c) * (*(const GAS f32x4*)(Y + (size_t)s0 * D + c) * p0 + *(const GAS f32x4*)(Y + (size_t)s1 * D + c) * p1); }
            v[j] = x; }
        float mean, rstd; row_stats(v, mean, rstd);
        float* xo = xdst ? xdst + (size_t)row * D : (row < MP ? a.out + O_YP + (size_t)row * D : a.out + O_YS + (size_t)(row - MP) * D);
#pragma unroll
        for (int j = 0; j < 4; ++j) { const int c = 256 * j + 4 * F.lane; v[j] = (v[j] - mean) * rstd * *(const GAS f32x4*)(lg + c) + *(const GAS f32x4*)(lb + c); *(GAS f32x4*)(xo + c) = v[j]; }
        const float* sh = nullptr; const float* sc = nullptr;
        if (which == 0) { sh = mr + 3 * D; sc = mr + 4 * D; } else if (l == 0) { const float* mr2 = mod_row(a, 1, row); sh = mr2; sc = mr2 + D; }
        if (sh) {
            row_stats(v, mean, rstd);
#pragma unroll
            for (int j = 0; j < 4; ++j) { const int c = 256 * j + 4 * F.lane; { const f32x4 xh = (v[j] - mean) * rstd; v[j] = xh * *(const GAS f32x4*)(sc + c) + (xh + *(const GAS f32x4*)(sh + c)); }
                v2u o; o.x = pk2(v[j].x, v[j].y); o.y = pk2(v[j].z, v[j].w); *(GAS v2u*)(XN + (size_t)row * D + c) = o; }
            if (ROUTE) {
                const float* Wr = INP(float, I_MR); float lgt[8];
#pragma unroll
                for (int e = 0; e < 8; ++e) lgt[e] = 0.f;
#pragma unroll
                for (int j = 0; j < 4; ++j)
#pragma unroll
                    for (int q = 0; q < 4; ++q) { const int c = 256 * j + 4 * F.lane + q; const f32x4 w0 = *(const GAS f32x4*)(Wr + (size_t)c * 8), w1 = *(const GAS f32x4*)(Wr + (size_t)c * 8 + 4); const float hv = v[j][q];
                        lgt[0] += hv * w0.x; lgt[1] += hv * w0.y; lgt[2] += hv * w0.z; lgt[3] += hv * w0.w; lgt[4] += hv * w1.x; lgt[5] += hv * w1.y; lgt[6] += hv * w1.z; lgt[7] += hv * w1.w; }
#pragma unroll
                for (int e = 0; e < 8; ++e) lgt[e] = wave_sum(lgt[e]);
                int e0 = 0; float l0 = lgt[0];
#pragma unroll
                for (int e = 1; e < 8; ++e) if (lgt[e] > l0) { l0 = lgt[e]; e0 = e; }
                int e1 = -1; float l1 = -3.0e38f;
#pragma unroll
                for (int e = 0; e < 8; ++e) if (e != e0 && lgt[e] > l1) { l1 = lgt[e]; e1 = e; }
                const float p0 = 1.f / (1.f + __expf(l1 - l0));
                if (F.lane == 0) { int* ep = WSP(int, MOE_EPOS) + 4 * row;
                    ep[0] = e0; ep[1] = e1; ep[2] = (int)atomicAdd((unsigned*)(F.ctl + CW_MOECNT + 64 * e0), 1u); ep[3] = (int)atomicAdd((unsigned*)(F.ctl + CW_MOECNT + 64 * e1), 1u);
                    mprob[2 * row] = p0; mprob[2 * row + 1] = 1.f - p0; }
            }
        }
    }
}
__device__ __forceinline__ void p_moe_gather(Frame& F, const Args& a) {
    int off[9]; off[0] = 0;
#pragma unroll
    for (int e = 0; e < 8; ++e) { const int c = (int)__hip_atomic_load(F.ctl + CW_MOECNT + 64 * e, RLX_AGENT); off[e + 1] = off[e] + ((c + 255) & ~255); }
    int* meta = WSP(int, MOE_META);
    if (F.bid == 0) { if (F.tid == 0) meta[0] = off[8] >> 8;
        for (int t = F.tid; t < (off[8] >> 8); t += NTHR) { int e = 0;
#pragma unroll
            for (int q = 1; q < 8; ++q) if (t * 256 >= off[q]) e = q;
            meta[16 + t] = e; } }
    const int gw = F.bid * NWAVES + F.wave, NGW = F.G * NWAVES; const bf16* XN = WSP(bf16, WS_XN); bf16* AP = WSP(bf16, WS_APERM); int* mslot = WSP(int, MOE_SLOT);
    for (int row = gw; row < MREAL; row += NGW) {
        const int* ep = WSP(int, MOE_EPOS) + 4 * row; const int e0 = ep[0], e1 = ep[1];
        int o0 = 0, o1 = 0;
#pragma unroll
        for (int q = 0; q < 8; ++q) { if (q == e0) o0 = off[q]; if (q == e1) o1 = off[q]; }
        const int s0 = o0 + ep[2], s1 = o1 + ep[3];
        if (F.lane == 0) { mslot[2 * row] = s0; mslot[2 * row + 1] = s1; }
        const v4u x0 = *(const GAS v4u*)(XN + (size_t)row * D + 8 * F.lane), x1 = *(const GAS v4u*)(XN + (size_t)row * D + 512 + 8 * F.lane);
        *(GAS v4u*)(AP + (size_t)s0 * D + 8 * F.lane) = x0; *(GAS v4u*)(AP + (size_t)s0 * D + 512 + 8 * F.lane) = x1;
        *(GAS v4u*)(AP + (size_t)s1 * D + 8 * F.lane) = x0; *(GAS v4u*)(AP + (size_t)s1 * D + 512 + 8 * F.lane) = x1;
    }
}

struct EpiIn {
    static constexpr bool PERM = true, AFTER_DRAIN = false, CHAIN = false;
    bf16* P; float* SC; float* out; int l;
    __device__ __forceinline__ void mid(const pg8::f32x4 (&)[2][2][4][2], const pg8::Unit&, int, int, int, int) const {}
    __device__ __forceinline__ void operator()(const pg8::f32x4 (&acc)[2][2][4][2], const pg8::Unit& u, int wr, int wc, int fr, int fq) const {
        asm volatile("" : "+v"(fr), "+v"(fq));
        const int pn = u.pn; const int colb = pn * 256 + wc * 32 + 8 * fq;
#pragma unroll
        for (int ai = 0; ai < 2; ++ai)
#pragma unroll
            for (int m = 0; m < 4; ++m) {
                const int row = u.pm * 256 + ai * 128 + wr * 64 + m * 16 + fr;
                if (pn >= 13 && pn <= 20) {
                    float r[8], sb[8];
#pragma unroll
                    for (int n = 0; n < 2; ++n)
#pragma unroll
                        for (int q = 0; q < 4; ++q) { const float ea = __expf(-acc[ai][0][m][n][q]), eb = __expf(-acc[ai][1][m][n][q]); sb[4 * n + q] = 1.f / (1.f + eb); r[4 * n + q] = (1.f + eb) / (1.f + ea); }
                    v4u w; w.x = pk2(r[0], r[1]); w.y = pk2(r[2], r[3]); w.z = pk2(r[4], r[5]); w.w = pk2(r[6], r[7]); *(GAS v4u*)(P + (size_t)row * NINP + colb) = w;
                    w.x = pk2(sb[0], sb[1]); w.y = pk2(sb[2], sb[3]); w.z = pk2(sb[4], sb[5]); w.w = pk2(sb[6], sb[7]); *(GAS v4u*)(P + (size_t)row * NINP + colb + 128) = w;
                    continue;
                }
#pragma unroll
                for (int bj = 0; bj < 2; ++bj) {
                    const int col = colb + bj * 128; const pg8::f32x4 v0 = acc[ai][bj][m][0], v1 = acc[ai][bj][m][1];
                    v4u w; w.x = pk2(v0[0], v0[1]); w.y = pk2(v0[2], v0[3]); w.z = pk2(v1[0], v1[1]); w.w = pk2(v1[2], v1[3]);
                    *(GAS v4u*)(P + (size_t)row * NINP + col) = w;
                    float* dst = nullptr;
                    if (pn >= 10 && pn <= 12) {
                        const int c = col - pn * 256;
                        if (pn == 12) { if (row < MP) { const int t = row & (SEQ - 1); if (t >= SEQ - WINDOW) dst = out + O_WIN_P + ((size_t)(l * 2 + (row >> 13)) * WINDOW + (t - (SEQ - WINDOW))) * KVW + c; }
                                        else if (row < MREAL) dst = out + O_WIN_S + ((size_t)(l * MS + (row - MP)) * WINDOW + (WINDOW - 1)) * KVW + c; }
                        else { const size_t op = pn == 10 ? O_CMP_P : O_SLC_P, os = pn == 10 ? O_CMP_S : O_SLC_S;
                               if (row < MP) dst = out + op + ((size_t)l * MP + row) * KVW + c; else if (row < MREAL) dst = out + os + (size_t)(l * MS + (row - MP)) * KVW + c; }
                    } else if (pn < 6) {
                        if (row < MP) { const int t = row & (SEQ - 1); if (t >= SEQ - 3) dst = out + O_CONV_P + ((size_t)(l * 2 + (row >> 13)) * 3 + (t - (SEQ - 3))) * CQKV + col; }
                        else if (row < MREAL) dst = out + O_CONV_S + ((size_t)(l * MS + (row - MP)) * 3 + 2) * CQKV + col;
                    } else if (pn == 21) {
                        if (wc == 0 && bj == 0) dst = SC + (size_t)row * 32 + 8 * fq;
                    }
                    if (dst) { *(GAS pg8::f32x4*)dst = v0; *(GAS pg8::f32x4*)(dst + 4) = v1; }
                }
            }
    }
};
constexpr size_t GDN_WN = WS_GDN, GDN_QD = WS_GDN + 16 * MiB, GDN_KDT = WS_GDN + 32 * MiB, GDN_QK = WS_GDN + 48 * MiB, GDN_UT = WS_GDN + 56 * MiB, GDN_OT = WS_GDN + 72 * MiB, GDN_GL = WS_GDN + 104 * MiB;
__device__ __forceinline__ int kperm(int k) { return (k & ~31) | (((k >> 2) & 3) << 3) | (((k >> 4) & 1) << 2) | (k & 3); }

__device__ __forceinline__ void gdn_prep(Frame& F, const Args& a, int l) {
    LAS float* kq = (LAS float*)(F.lds + RING_OFF);
    LAS float* qq = kq + 64 * 132;
    LAS float* vv = qq + 64 * 132;
    LAS float* Am = vv + 64 * 128;
    LAS float* sv = Am + 64 * 64;
    const bf16* P = WSP(bf16, WS_P); const float* SC = WSP(float, WS_SC);
    const float* cw = INP(float, I_CONVW) + (size_t)l * 4 * CQKV;
    const int tid = F.tid, lane = F.lane, wave = F.wave;
    for (int unit = F.bid; unit < 8 * NCHUNK; unit += F.G) {
        const int bh = unit >> 7, n = unit & 127, b = bh >> 2, h = bh & 3, t0 = n * CHUNK; const size_t row0 = (size_t)b * SEQ + t0;
        if (tid < 384) {
            const int part = tid >> 7, j = tid & 127;
            const int c = (part == 0 ? 1024 : part == 1 ? 512 : 0) + h * 128 + j;
            const float w0 = cw[c], w1 = cw[CQKV + c], w2 = cw[2 * CQKV + c], w3 = cw[3 * CQKV + c];
            const bf16* pc = P + row0 * NINP + PC_QKV + c;
            float xm3 = 0.f, xm2 = 0.f, xm1 = 0.f;
            if (n > 0) { xm3 = bf2f(*(pc - 3 * (ptrdiff_t)NINP)); xm2 = bf2f(*(pc - 2 * (ptrdiff_t)NINP)); xm1 = bf2f(*(pc - (ptrdiff_t)NINP)); }
            LAS float* dstp = part == 0 ? vv + j : part == 1 ? kq + j : qq + j; const int dpitch = part == 0 ? 128 : 132;
#pragma unroll 4
            for (int i = 0; i < 64; ++i) { const float x = bf2f(pc[(size_t)i * NINP]); const float y = siluf_(w0 * xm3 + w1 * xm2 + w2 * xm1 + w3 * x); xm3 = xm2; xm2 = xm1; xm1 = x;
                dstp[i * dpitch] = y; }
        } else if (tid < 448) {
            const int i = tid - 384; const float* sc = SC + (row0 + i) * 32;
            const float beta = sigmoidf_(sc[h]); const float g = -__expf(INP(float, I_ALOG)[l * 4 + h]) * softplusf_(sc[4 + h] + INP(float, I_DTB)[l * 4 + h]);
            float gc = g;
#pragma unroll
            for (int o = 1; o < 64; o <<= 1) { const float t = bperm(gc, lane - o); if (lane >= o) gc += t; }
            sv[i] = beta; sv[64 + i] = gc; sv[128 + i] = __expf(gc);
        }
        __syncthreads();
        for (int r = 0; r < 8; ++r) { const int i = wave * 8 + r;
            { const float x0 = kq[i * 132 + lane], x1 = kq[i * 132 + 64 + lane]; const float inv = 1.f / sqrtf(wave_sum(x0 * x0 + x1 * x1) + 1e-6f); kq[i * 132 + lane] = x0 * inv; kq[i * 132 + 64 + lane] = x1 * inv; }
            { const float x0 = qq[i * 132 + lane], x1 = qq[i * 132 + 64 + lane]; const float inv = 1.f / sqrtf(wave_sum(x0 * x0 + x1 * x1) + 1e-6f); qq[i * 132 + lane] = x0 * inv; qq[i * 132 + 64 + lane] = x1 * inv; } }
        __syncthreads();
        {
            const int t = tid & 255, ti = t >> 4, tj = t & 15; const bool isA = tid < 256; const LAS float* L = isA ? kq : qq;
            float acc[4][4];
#pragma unroll
            for (int x = 0; x < 4; ++x)
#pragma unroll
                for (int y = 0; y < 4; ++y) acc[x][y] = 0.f;
            if (tj <= ti) {
                for (int k4 = 0; k4 < 32; ++k4) { f32x4 ra[4], rb[4];
#pragma unroll
                    for (int x = 0; x < 4; ++x) { ra[x] = *(const LAS f32x4*)(L + (4 * ti + x) * 132 + 4 * k4); rb[x] = *(const LAS f32x4*)(kq + (4 * tj + x) * 132 + 4 * k4); }
#pragma unroll
                    for (int x = 0; x < 4; ++x)
#pragma unroll
                        for (int y = 0; y < 4; ++y) acc[x][y] += ra[x].x * rb[y].x + ra[x].y * rb[y].y + ra[x].z * rb[y].z + ra[x].w * rb[y].w; }
            }
            if (isA) {
#pragma unroll
                for (int x = 0; x < 4; ++x) { const int i = 4 * ti + x; f32x4 o;
#pragma unroll
                    for (int y = 0; y < 4; ++y) { const int j = 4 * tj + y; o[y] = (i > j) ? sv[i] * acc[x][y] * __expf(sv[64 + i] - sv[64 + j]) : 0.f; }
                    *(LAS f32x4*)(Am + i * 64 + 4 * tj) = o; }
            } else {
                bf16* QKg = WSP(bf16, GDN_QK) + (size_t)unit * 64 * 64;
#pragma unroll
                for (int x = 0; x < 4; ++x) { const int i = 4 * ti + x; float o[4];
#pragma unroll
                    for (int y = 0; y < 4; ++y) { const int j = 4 * tj + y; o[y] = (i >= j) ? acc[x][y] * __expf(sv[64 + i] - sv[64 + j]) * 0.08838834764831845f : 0.f; }
                    v2u w; w.x = pk2(o[0], o[1]); w.y = pk2(o[2], o[3]); *(GAS v2u*)(QKg + i * 64 + kperm(4 * tj)) = w; }
            }
        }
        __syncthreads();
        if (tid < 256) {
            float x[64]; int zv; asm volatile("v_mov_b32 %0, 0" : "=v"(zv));
            const LAS float* svz = sv + zv; const LAS float* Amz = Am + zv;
            if (tid < 128) {
#pragma unroll
                for (int i = 0; i < 64; ++i) x[i] = vv[i * 128 + tid] * svz[i];
            } else {
#pragma unroll
                for (int i = 0; i < 64; ++i) x[i] = kq[i * 132 + (tid - 128)] * svz[i] * svz[128 + i];
            }
#pragma unroll
            for (int i = 1; i < 64; ++i) { float s = x[i];
#pragma unroll
                for (int j4 = 0; j4 < (i + 3) / 4; ++j4) { const f32x4 av = *(const LAS f32x4*)(Amz + i * 64 + 4 * j4); s -= av.x * x[4 * j4] + av.y * x[4 * j4 + 1] + av.z * x[4 * j4 + 2] + av.w * x[4 * j4 + 3]; }
                x[i] = s; }
            if (tid < 128) { bf16* UT = WSP(bf16, GDN_UT) + ((size_t)unit * 128 + tid) * 64;
#pragma unroll
                for (int i8 = 0; i8 < 8; ++i8) { v4u w; w.x = pk2(x[8 * i8], x[8 * i8 + 1]); w.y = pk2(x[8 * i8 + 2], x[8 * i8 + 3]); w.z = pk2(x[8 * i8 + 4], x[8 * i8 + 5]); w.w = pk2(x[8 * i8 + 6], x[8 * i8 + 7]); *(GAS v4u*)(UT + 8 * i8) = w; }
            } else { bf16* WN = WSP(bf16, GDN_WN) + (size_t)unit * 64 * 128 + kperm(tid - 128);
#pragma unroll
                for (int i = 0; i < 64; ++i) WN[i * 128] = (bf16)f2bf(-x[i]);
            }
        } else {
            const int t = tid - 256; const float gl = sv[64 + 63];
            bf16* QD = WSP(bf16, GDN_QD) + (size_t)unit * 64 * 128; bf16* KDT = WSP(bf16, GDN_KDT) + (size_t)unit * 128 * 64;
            for (int it = t; it < 64 * 32; it += 256) { const int i = it >> 5, k4 = it & 31; const f32x4 q = *(const LAS f32x4*)(qq + i * 132 + 4 * k4) * (sv[128 + i] * 0.08838834764831845f);
                v2u w; w.x = pk2(q.x, q.y); w.y = pk2(q.z, q.w); *(GAS v2u*)(QD + i * 128 + kperm(4 * k4)) = w; }
            for (int it = t; it < 128 * 16; it += 256) { const int k = it & 127, c4 = it >> 7; float o[4];
#pragma unroll
                for (int y = 0; y < 4; ++y) { const int c = 4 * c4 + y; o[y] = kq[c * 132 + k] * __expf(gl - sv[64 + c]); }
                v2u w; w.x = pk2(o[0], o[1]); w.y = pk2(o[2], o[3]); *(GAS v2u*)(KDT + k * 64 + kperm(4 * c4)) = w; }
            if (t == 0) WSP(float, GDN_GL)[unit] = __expf(gl);
        }
        __syncthreads();
    }
}

__device__ __forceinline__ void gdn_scan(Frame& F, const Args& a, int l, int bh) {
    constexpr int PW = 272, PK = 144;
    constexpr int B_WN = 0, B_QD = 64 * PW, B_KDT = 2 * 64 * PW, B_QK = B_KDT + 128 * PK, BUFB = B_QK + 64 * PK;
    static_assert(2 * BUFB <= RING_BYTES, "scan LDS");
    const int tid = F.tid, lane = F.lane, wave = F.wave, fr = lane & 15, fq = lane >> 4;
    const bf16* WN = WSP(bf16, GDN_WN) + (size_t)bh * 128 * 8192; const bf16* QD = WSP(bf16, GDN_QD) + (size_t)bh * 128 * 8192;
    const bf16* KDT = WSP(bf16, GDN_KDT) + (size_t)bh * 128 * 8192; const bf16* QK = WSP(bf16, GDN_QK) + (size_t)bh * 128 * 4096;
    const bf16* UT = WSP(bf16, GDN_UT) + (size_t)bh * 128 * 8192; float* OT = WSP(float, GDN_OT) + (size_t)bh * 128 * 8192; const float* GL = WSP(float, GDN_GL) + bh * 128;
    f32x4 S[8];
#pragma unroll
    for (int T = 0; T < 8; ++T) S[T] = (f32x4){0.f, 0.f, 0.f, 0.f};
    v4u st[7];
#define GDN_LOAD(nn) do { const size_t o8 = (size_t)(nn) * 8192, o4 = (size_t)(nn) * 4096; \
        st[0] = *(const GAS v4u*)(WN + o8 + (size_t)tid * 8); st[1] = *(const GAS v4u*)(WN + o8 + (size_t)(tid + 512) * 8); \
        st[2] = *(const GAS v4u*)(QD + o8 + (size_t)tid * 8); st[3] = *(const GAS v4u*)(QD + o8 + (size_t)(tid + 512) * 8); \
        st[4] = *(const GAS v4u*)(KDT + o8 + (size_t)tid * 8); st[5] = *(const GAS v4u*)(KDT + o8 + (size_t)(tid + 512) * 8); \
        st[6] = *(const GAS v4u*)(QK + o4 + (size_t)tid * 8); } while (0)
#define GDN_STORE(buf) do { LAS unsigned char* bb = F.lds + RING_OFF + (buf) * BUFB; \
        *(LAS v4u*)(bb + B_WN + (tid >> 4) * PW + (tid & 15) * 16) = st[0]; *(LAS v4u*)(bb + B_WN + ((tid + 512) >> 4) * PW + (tid & 15) * 16) = st[1]; \
        *(LAS v4u*)(bb + B_QD + (tid >> 4) * PW + (tid & 15) * 16) = st[2]; *(LAS v4u*)(bb + B_QD + ((tid + 512) >> 4) * PW + (tid & 15) * 16) = st[3]; \
        *(LAS v4u*)(bb + B_KDT + (tid >> 3) * PK + (tid & 7) * 16) = st[4]; *(LAS v4u*)(bb + B_KDT + ((tid + 512) >> 3) * PK + (tid & 7) * 16) = st[5]; \
        *(LAS v4u*)(bb + B_QK + (tid >> 3) * PK + (tid & 7) * 16) = st[6]; } while (0)
    GDN_LOAD(0); GDN_STORE(0);
    __syncthreads();
    for (int n = 0; n < NCHUNK; ++n) {
        const int buf = n & 1; const LAS unsigned char* bb = F.lds + RING_OFF + buf * BUFB;
        if (n + 1 < NCHUNK) GDN_LOAD(n + 1);
        const float egl = GL[n];
        f32x4 av[4], ao[4];
        { const bf16* up = UT + ((size_t)n * 128 + wave * 16 + fr) * 64 + 4 * fq;
#pragma unroll
          for (int m = 0; m < 4; ++m) { const v2u w = *(const GAS v2u*)(up + 16 * m); av[m] = (f32x4){bflo(w.x), bfhi(w.x), bflo(w.y), bfhi(w.y)}; ao[m] = (f32x4){0.f, 0.f, 0.f, 0.f}; } }
        bf16x8 Bs[4];
#pragma unroll
        for (int kt = 0; kt < 4; ++kt) { v4u w; w.x = pk2(S[2 * kt][0], S[2 * kt][1]); w.y = pk2(S[2 * kt][2], S[2 * kt][3]); w.z = pk2(S[2 * kt + 1][0], S[2 * kt + 1][1]); w.w = pk2(S[2 * kt + 1][2], S[2 * kt + 1][3]); Bs[kt] = __builtin_bit_cast(bf16x8, w); }
#pragma unroll
        for (int kt = 0; kt < 4; ++kt)
#pragma unroll
            for (int m = 0; m < 4; ++m) {
                const bf16x8 aw = *(const LAS bf16x8*)(bb + B_WN + (16 * m + fr) * PW + (32 * kt + 8 * fq) * 2);
                const bf16x8 aq = *(const LAS bf16x8*)(bb + B_QD + (16 * m + fr) * PW + (32 * kt + 8 * fq) * 2);
                av[m] = __builtin_amdgcn_mfma_f32_16x16x32_bf16(aw, Bs[kt], av[m], 0, 0, 0);
                ao[m] = __builtin_amdgcn_mfma_f32_16x16x32_bf16(aq, Bs[kt], ao[m], 0, 0, 0);
            }
        bf16x8 Bv[2];
#pragma unroll
        for (int kc = 0; kc < 2; ++kc) { v4u w; w.x = pk2(av[2 * kc][0], av[2 * kc][1]); w.y = pk2(av[2 * kc][2], av[2 * kc][3]); w.z = pk2(av[2 * kc + 1][0], av[2 * kc + 1][1]); w.w = pk2(av[2 * kc + 1][2], av[2 * kc + 1][3]); Bv[kc] = __builtin_bit_cast(bf16x8, w); }
#pragma unroll
        for (int kc = 0; kc < 2; ++kc)
#pragma unroll
            for (int m = 0; m < 4; ++m) {
                const bf16x8 aqk = *(const LAS bf16x8*)(bb + B_QK + (16 * m + fr) * PK + (32 * kc + 8 * fq) * 2);
                ao[m] = __builtin_amdgcn_mfma_f32_16x16x32_bf16(aqk, Bv[kc], ao[m], 0, 0, 0);
            }
#pragma unroll
        for (int T = 0; T < 8; ++T) S[T] = S[T] * egl;
#pragma unroll
        for (int kc = 0; kc < 2; ++kc)
#pragma unroll
            for (int T = 0; T < 8; ++T) {
                const bf16x8 ak = *(const LAS bf16x8*)(bb + B_KDT + (16 * T + fr) * PK + (32 * kc + 8 * fq) * 2);
                S[T] = __builtin_amdgcn_mfma_f32_16x16x32_bf16(ak, Bv[kc], S[T], 0, 0, 0);
            }
        { float* op = OT + ((size_t)n * 128 + wave * 16 + fr) * 64 + 4 * fq;
#pragma unroll
          for (int m = 0; m < 4; ++m) *(GAS f32x4*)(op + 16 * m) = ao[m]; }
        if (n + 1 < NCHUNK) GDN_STORE(buf ^ 1);
        __syncthreads();
    }
#undef GDN_LOAD
#undef GDN_STORE
    float* od = a.out + O_DELTA_P + ((size_t)l * 8 + bh) * 128 * 128;
#pragma unroll
    for (int T = 0; T < 8; ++T)
#pragma unroll
        for (int i = 0; i < 4; ++i) od[(size_t)(16 * T + 4 * fq + i) * 128 + wave * 16 + fr] = S[T][i];
}

__device__ __forceinline__ void gdn_sample(Frame& F, const Args& a, int l, int unit) {
    LAS float* sq = (LAS float*)(F.lds + RING_OFF); LAS float* sk = sq + 128; LAS float* svv = sk + 128; LAS float* red = svv + 128;
    LAS float* misc = red + 512;
    const int tid = F.tid, b = unit >> 2, h = unit & 3; const size_t row = MP + b;
    const bf16* P = WSP(bf16, WS_P); const float* SC = WSP(float, WS_SC);
    if (tid < 384) {
        const int part = tid >> 7, j = tid & 127; const int c = (part == 0 ? 0 : part == 1 ? 512 : 1024) + h * 128 + j;
        const float* cw = INP(float, I_CONVW) + (size_t)l * 4 * CQKV; const float* sb = INP(float, I_SCONV) + ((size_t)(l * MS + b) * 3) * CQKV + c;
        const float y = siluf_(cw[c] * sb[0] + cw[CQKV + c] * sb[CQKV] + cw[2 * CQKV + c] * sb[2 * CQKV] + cw[3 * CQKV + c] * bf2f(P[row * NINP + PC_QKV + c]));
        (part == 0 ? sq : part == 1 ? sk : svv)[j] = y;
    }
    __syncthreads();
    if (F.wave < 2) { LAS float* p = F.wave == 0 ? sq : sk; const float x0 = p[F.lane], x1 = p[64 + F.lane]; const float inv = 1.f / sqrtf(wave_sum(x0 * x0 + x1 * x1) + 1e-6f); p[F.lane] = x0 * inv; p[64 + F.lane] = x1 * inv; }
    __syncthreads();
    const float beta = sigmoidf_(SC[row * 32 + h]); const float eg = __expf(-__expf(INP(float, I_ALOG)[l * 4 + h]) * softplusf_(SC[row * 32 + 4 + h] + INP(float, I_DTB)[l * 4 + h]));
    const int dv = tid & 127, ks = tid >> 7;
    const float* S0 = INP(float, I_SDELTA) + ((size_t)(l * MS + b) * 4 + h) * 128 * 128;
    float sreg[32]; float part = 0.f;
#pragma unroll
    for (int i = 0; i < 32; ++i) { sreg[i] = S0[(size_t)(ks * 32 + i) * 128 + dv]; part += sk[ks * 32 + i] * sreg[i]; }
    red[ks * 128 + dv] = part;
    __syncthreads();
    const float kS = red[dv] + red[128 + dv] + red[256 + dv] + red[384 + dv];
    const float vn = beta * (svv[dv] - eg * kS);
    __syncthreads();
    float* od = a.out + O_DELTA_S + ((size_t)(l * MS + b) * 4 + h) * 128 * 128; float po = 0.f;
#pragma unroll
    for (int i = 0; i < 32; ++i) { const float sn = eg * sreg[i] + sk[ks * 32 + i] * vn; od[(size_t)(ks * 32 + i) * 128 + dv] = sn; po += sq[ks * 32 + i] * sn; }
    red[ks * 128 + dv] = po;
    __syncthreads();
    if (tid < 128) { const float o = (red[dv] + red[128 + dv] + red[256 + dv] + red[384 + dv]) * 0.08838834764831845f; misc[dv] = o; }
    __syncthreads();
    if (F.wave == 0) { const float o0 = misc[F.lane], o1 = misc[64 + F.lane]; const float r = 1.f / sqrtf(wave_sum(o0 * o0 + o1 * o1) * (1.f / 128.f) + LN_EPS);
        bf16* OA = WSP(bf16, WS_OAB) + row * 512 + h * 128; const float* nw = INP(float, I_NORMW) + l * 128;
        const float z0 = bf2f(P[row * NINP + PC_Z + h * 128 + F.lane]), z1 = bf2f(P[row * NINP + PC_Z + h * 128 + 64 + F.lane]);
        OA[F.lane] = (bf16)f2bf(o0 * r * nw[F.lane] * siluf_(z0)); OA[64 + F.lane] = (bf16)f2bf(o1 * r * nw[64 + F.lane] * siluf_(z1)); }
    __syncthreads();
}

__device__ __forceinline__ void gdn_onorm(Frame& F, const Args& a, int l) {
    LAS float* tile = (LAS float*)(F.lds + RING_OFF);
    const bf16* P = WSP(bf16, WS_P); const float* nw = INP(float, I_NORMW) + l * 128;
    for (int unit = F.bid; unit < 8 * NCHUNK; unit += F.G) {
        const int bh = unit >> 7, n = unit & 127, b = bh >> 2, h = bh & 3; const size_t row0 = (size_t)b * SEQ + n * CHUNK;
        const float* src = WSP(float, GDN_OT) + (size_t)unit * 8192;
        for (int i = F.tid; i < 8192; i += NTHR) tile[(i >> 6) * 65 + (i & 63)] = src[i];
        __syncthreads();
        const int c = F.tid >> 3, part = F.tid & 7;
        float v[16]; float ss = 0.f;
#pragma unroll
        for (int i = 0; i < 16; ++i) { v[i] = tile[(part * 16 + i) * 65 + c]; ss += v[i] * v[i]; }
        ss += shx<1>(ss); ss += shx<2>(ss); ss += shx<4>(ss);
        const float r = 1.f / sqrtf(ss * (1.f / 128.f) + LN_EPS);
        const bf16* zp = P + (row0 + c) * NINP + PC_Z + h * 128 + part * 16; bf16* op = WSP(bf16, WS_OAB) + (row0 + c) * 512 + h * 128 + part * 16;
        const v4u z0 = *(const GAS v4u*)zp, z1 = *(const GAS v4u*)(zp + 8); const unsigned zz[8] = {z0.x, z0.y, z0.z, z0.w, z1.x, z1.y, z1.z, z1.w};
        unsigned o[8];
#pragma unroll
        for (int i = 0; i < 8; ++i) { const float a0 = v[2 * i] * r * nw[part * 16 + 2 * i] * siluf_(bflo(zz[i])), a1 = v[2 * i + 1] * r * nw[part * 16 + 2 * i + 1] * siluf_(bfhi(zz[i])); o[i] = pk2(a0, a1); }
        *(GAS v4u*)op = (v4u){o[0], o[1], o[2], o[3]}; *(GAS v4u*)(op + 8) = (v4u){o[4], o[5], o[6], o[7]};
        __syncthreads();
    }
}
struct EpiUp {
    static constexpr bool PERM = true, AFTER_DRAIN = false, CHAIN = true;
    const bf16* P; bf16* U;
    template <bool FINAL> __device__ __forceinline__ void run(pg8::f32x4 (&acc)[2][2][4][2], const pg8::Unit& u, int wr, int wc, int fr, int fq) const {
        asm volatile("" : "+v"(fr), "+v"(fq));
#pragma unroll
        for (int ai = 0; ai < 2; ++ai)
#pragma unroll
            for (int m = 0; m < 4; ++m) {
                const size_t row = (size_t)u.pm * 256 + ai * 128 + wr * 64 + m * 16 + fr;
#pragma unroll
                for (int bj = 0; bj < 2; ++bj) {
                    const int j = wc * 32 + 8 * fq;
                    const v4u g = *(const GAS v4u*)(P + row * NINP + PC_GM + 256 * (2 * u.pn + bj) + (FINAL ? 128 : 0) + j);
                    pg8::f32x4 v0 = acc[ai][bj][m][0], v1 = acc[ai][bj][m][1];
                    v0[0] *= bflo(g.x); v0[1] *= bfhi(g.x); v0[2] *= bflo(g.y); v0[3] *= bfhi(g.y); v1[0] *= bflo(g.z); v1[1] *= bfhi(g.z); v1[2] *= bflo(g.w); v1[3] *= bfhi(g.w);
                    if (FINAL) { v4u w; w.x = pk2(v0[0], v0[1]); w.y = pk2(v0[2], v0[3]); w.z = pk2(v1[0], v1[1]); w.w = pk2(v1[2], v1[3]); *(GAS v4u*)(U + row * D + u.pn * 256 + bj * 128 + j) = w; }
                    else { acc[ai][bj][m][0] = v0; acc[ai][bj][m][1] = v1; }
                }
                asm volatile("" ::: "memory");
            }
    }
    __device__ __forceinline__ void mid(pg8::f32x4 (&acc)[2][2][4][2], const pg8::Unit& u, int wr, int wc, int fr, int fq) const { run<false>(acc, u, wr, wc, fr, fq); }
    __device__ __forceinline__ void operator()(pg8::f32x4 (&acc)[2][2][4][2], const pg8::Unit& u, int wr, int wc, int fr, int fq) const { run<true>(acc, u, wr, wc, fr, fq); }
};
struct ChainOrder {
    int G, c;
    __device__ bool next(int i, pg8::Unit& u) const {
        const int L = i * G + c; if (L >= NTILE_M * 4) return false;
        u.pm = L % NTILE_M; u.pn = L / NTILE_M; u.am = u.pm; u.bn = u.pn; u.am2 = u.pm + NTILE_M; u.bn2 = u.pn + 4; return true;
    }
    __device__ __forceinline__ void a_ready(const pg8::Unit&) const {}
    __device__ __forceinline__ void done(const pg8::Unit&) const {}
};
struct EpiF32 {
    static constexpr bool PERM = true, AFTER_DRAIN = false, CHAIN = false;
    float* Y;
    __device__ __forceinline__ void mid(const pg8::f32x4 (&)[2][2][4][2], const pg8::Unit&, int, int, int, int) const {}
    __device__ __forceinline__ void operator()(const pg8::f32x4 (&acc)[2][2][4][2], const pg8::Unit& u, int wr, int wc, int fr, int fq) const {
        asm volatile("" : "+v"(fr), "+v"(fq));
        const int colb = u.pn * 256 + wc * 32 + 8 * fq;
#pragma unroll
        for (int ai = 0; ai < 2; ++ai)
#pragma unroll
            for (int m = 0; m < 4; ++m) { float* rp = Y + ((size_t)u.pm * 256 + ai * 128 + wr * 64 + m * 16 + fr) * D + colb;
#pragma unroll
                for (int bj = 0; bj < 2; ++bj) { *(GAS pg8::f32x4*)(rp + bj * 128) = acc[ai][bj][m][0]; *(GAS pg8::f32x4*)(rp + bj * 128 + 4) = acc[ai][bj][m][1]; } }
    }
};
struct EpiSwiglu {
    static constexpr bool PERM = true, AFTER_DRAIN = false, CHAIN = false;
    bf16* ACT;
    __device__ __forceinline__ void mid(const pg8::f32x4 (&)[2][2][4][2], const pg8::Unit&, int, int, int, int) const {}
    __device__ __forceinline__ void operator()(const pg8::f32x4 (&acc)[2][2][4][2], const pg8::Unit& u, int wr, int wc, int fr, int fq) const {
        asm volatile("" : "+v"(fr), "+v"(fq));
        const int col = u.pn * 128 + wc * 32 + 8 * fq;
#pragma unroll
        for (int ai = 0; ai < 2; ++ai)
#pragma unroll
            for (int m = 0; m < 4; ++m) { bf16* rp = ACT + ((size_t)u.pm * 256 + ai * 128 + wr * 64 + m * 16 + fr) * DFF + col;
                float o[8];
#pragma unroll
                for (int n = 0; n < 2; ++n)
#pragma unroll
                    for (int q = 0; q < 4; ++q) { const float g = acc[ai][0][m][n][q]; o[4 * n + q] = g / (1.f + __expf(-g)) * acc[ai][1][m][n][q]; }
                v4u w; w.x = pk2(o[0], o[1]); w.y = pk2(o[2], o[3]); w.z = pk2(o[4], o[5]); w.w = pk2(o[6], o[7]); *(GAS v4u*)rp = w; }
    }
};
template <int nN> struct MoeOrder {
    int G, c; const int* meta;
    __device__ bool next(int i, pg8::Unit& u) const {
        const int L = i * G + c, nt = __builtin_amdgcn_readfirstlane(meta[0]); if (L >= nt * nN) return false;
        u.pm = L / nN; u.pn = L % nN; u.am = u.pm; u.bn = __builtin_amdgcn_readfirstlane(meta[16 + u.pm]) * nN + u.pn; u.am2 = 0; u.bn2 = 0; return true;
    }
    __device__ __forceinline__ void a_ready(const pg8::Unit&) const {}
    __device__ __forceinline__ void done(const pg8::Unit&) const {}
};
constexpr size_t NSA_VSLT = WS_NSA, NSA_VWT = WS_NSA + 4 * MiB, NSA_KC = WS_NSA + 8 * MiB, NSA_VCT = WS_NSA + 9 * MiB, NSA_CVEC = WS_NSA + 10 * MiB;
constexpr size_t SMP_SEG = WS_SMP, SMP_HP = WS_SMP + 272 * MiB, SMP_KCS = WS_SMP + 340 * MiB, SMP_VCS = WS_SMP + 348 * MiB;
constexpr int SEGROWS = 34816, SEGTILES = 136;
static_assert(SMP_VCS + 8 * MiB <= WS_END, "ws map");
__device__ __forceinline__ int kperm_inv(int p) { return (p & ~31) | (((p >> 2) & 1) << 4) | (((p >> 3) & 3) << 2) | (p & 3); }

__device__ __forceinline__ void nsa_prologue(Frame& F, const Args& a) {
    const int NGW = F.G * NWAVES, gw = F.bid * NWAVES + F.wave;
    if (gw >= NGW - 16) { const int wv = NGW - 1 - gw, q = wv >> 2, col = (wv & 3) * 64 + F.lane;
        const float* pos = INP(float, I_CPOS) + (size_t)q * 2048; const float* w1 = INP(float, I_CW1) + (size_t)q * 2048 * 256 + col; float acc = 0.f;
        for (int i = 0; i < 2048; ++i) acc += pos[i] * w1[(size_t)i * 256];
        WSP(float, NSA_CVEC)[q * 256 + col] = acc; }
    const int* pt = INP(int, I_PT); const int kv = F.lane >> 5, g = (F.lane >> 4) & 1, d4 = F.lane & 15;
    for (int it = gw; it < 2 * MS * NPAGES * PAGE; it += NGW) {
        const int r = it & 127, p = (it >> 7) & 63, b = (it >> 13) & 31, l = it >> 18;
        const int page = pt[b * NPAGES + p];
        const f32x4 v = *(const GAS f32x4*)(INP(float, I_CCMP) + (((size_t)l * NPOOL + page) * PAGE + r) * KVW + 4 * F.lane);
        bf16* dst = WSP(bf16, SMP_SEG) + (((size_t)(l * 2 + kv) * SEGROWS) + 2048 + (size_t)(b * 2 + g) * 512 + p * 8 + (r >> 4)) * 1024 + (r & 15) * 64 + 4 * d4;
        v2u o; o.x = pk2(v.x, v.y); o.y = pk2(v.z, v.w); *(GAS v2u*)dst = o;
    }
}
__device__ __forceinline__ void nsa_prep(Frame& F, const Args& a, int l) {
    const int NGW = F.G * NWAVES, gw = F.bid * NWAVES + F.wave; const bf16* P = WSP(bf16, WS_P);
    { const int kv = F.lane >> 5, g = (F.lane >> 4) & 1, d4 = F.lane & 15;
      for (int row = gw; row < MP; row += NGW) { const int b = row >> 13, t = row & (SEQ - 1);
          const v2u v = *(const GAS v2u*)(P + (size_t)row * NINP + PC_KVC + 4 * F.lane);
          *(GAS v2u*)(WSP(bf16, SMP_SEG) + (((size_t)(l * 2 + kv) * SEGROWS) + (size_t)(b * 2 + g) * 512 + (t >> 4)) * 1024 + (t & 15) * 64 + 4 * d4) = v; } }
    LAS bf16* tile = (LAS bf16*)(F.lds + RING_OFF + F.wave * 16384);
    for (int unit = gw; unit < 2 * 4 * 128; unit += NGW) {
        const int tb = unit & 127, bg = (unit >> 7) & 3, kind = unit >> 9, b = bg >> 1, g = bg & 1;
        const bf16* src = P + ((size_t)b * SEQ + tb * 64 + F.lane) * NINP + (kind ? PC_KVW : PC_KVS) + 128 + g * 64;
#pragma unroll
        for (int q = 0; q < 8; ++q) *(LAS v4u*)(tile + F.lane * 72 + 8 * q) = *(const GAS v4u*)(src + 8 * q);
        LDS_WAIT(); asm volatile("" ::: "memory");
        bf16* dst = WSP(bf16, kind ? NSA_VWT : NSA_VSLT) + ((size_t)bg * 64) * SEQ + tb * 64 + F.lane; const int ts = kperm_inv(F.lane);
        for (int d = 0; d < 64; ++d) dst[(size_t)d * SEQ] = tile[ts * 72 + d];
        LDS_WAIT(); asm volatile("" ::: "memory");
    }
}
struct CmpOrder {
    int G, c;
    __device__ bool next(int i, pg8::Unit& u) const {
        const int L = i * G + c; if (L >= 2 * SEGTILES * 2) return false;
        const int kv = L / (SEGTILES * 2), rem = L % (SEGTILES * 2); u.pn = rem / SEGTILES; u.pm = kv * SEGTILES + rem % SEGTILES; u.am = u.pm; u.bn = kv * 2 + u.pn; u.am2 = 0; u.bn2 = 0; return true;
    }
    __device__ __forceinline__ void a_ready(const pg8::Unit&) const {}
    __device__ __forceinline__ void done(const pg8::Unit&) const {}
};
struct EpiBf16P {
    static constexpr bool PERM = true, AFTER_DRAIN = false, CHAIN = false;
    bf16* O; int ld;
    __device__ __forceinline__ void mid(const pg8::f32x4 (&)[2][2][4][2], const pg8::Unit&, int, int, int, int) const {}
    __device__ __forceinline__ void operator()(const pg8::f32x4 (&acc)[2][2][4][2], const pg8::Unit& u, int wr, int wc, int fr, int fq) const {
        asm volatile("" : "+v"(fr), "+v"(fq));
        const int colb = u.pn * 256 + wc * 32 + 8 * fq;
#pragma unroll
        for (int ai = 0; ai < 2; ++ai)
#pragma unroll
            for (int m = 0; m < 4; ++m) { bf16* rp = O + ((size_t)u.pm * 256 + ai * 128 + wr * 64 + m * 16 + fr) * ld + colb;
#pragma unroll
                for (int bj = 0; bj < 2; ++bj) { const pg8::f32x4 v0 = acc[ai][bj][m][0], v1 = acc[ai][bj][m][1];
                    v4u w; w.x = pk2(v0[0], v0[1]); w.y = pk2(v0[2], v0[3]); w.z = pk2(v1[0], v1[1]); w.w = pk2(v1[2], v1[3]); *(GAS v4u*)(rp + bj * 128) = w; } }
    }
};
__device__ __forceinline__ void nsa_cmp2(Frame& F, const Args& a, int l) {
    LAS float* hs = (LAS float*)(F.lds + RING_OFF);
    const bf16* HP = WSP(bf16, SMP_HP);
    for (int unit = F.bid; unit < 256 + 4096; unit += F.G) {
        int kv, bg, nb, smp;
        if (unit < 256) { smp = 0; nb = unit & 31; bg = (unit >> 5) & 3; kv = unit >> 7; } else { const int u2 = unit - 256; smp = 1; nb = u2 & 31; bg = (u2 >> 5) & 63; kv = u2 >> 11; }
        const size_t R0 = (size_t)kv * SEGROWS + (smp ? 2048 : 0) + (size_t)bg * 512 + nb * 16;
        const float* cv = WSP(float, NSA_CVEC) + (l * 2 + kv) * 256;
        for (int idx = F.tid; idx < 16 * 256; idx += NTHR) { const int i = idx >> 8, c = idx & 255;
            float h = 0.f; if (nb * 16 + i < NCMP) { h = bf2f(HP[(R0 + i) * 512 + c]) + bf2f(HP[(R0 + i + 1) * 512 + 256 + c]) + cv[c]; h = siluf_(h); }
            hs[idx] = h; }
        __syncthreads();
        const int i = F.tid >> 5, dq = F.tid & 31, n = nb * 16 + i; const float* w2 = INP(float, I_CW2) + (size_t)(l * 2 + kv) * 256 * 64 + 2 * dq;
        float o0 = 0.f, o1 = 0.f;
        for (int c = 0; c < 256; ++c) { const float h = hs[i * 256 + c]; const f32x2 w = *(const GAS f32x2*)(w2 + c * 64); o0 += h * w.x; o1 += h * w.y; }
        if (smp) { float* dst = WSP(float, kv ? SMP_VCS : SMP_KCS) + ((size_t)bg * 512 + n) * 64 + 2 * dq; *(GAS f32x2*)dst = (f32x2){o0, o1}; }
        else if (kv == 0) { *(GAS unsigned*)(WSP(bf16, NSA_KC) + ((size_t)bg * 512 + n) * 64 + 2 * dq) = pk2(o0, o1); }
        else { bf16* dst = WSP(bf16, NSA_VCT) + ((size_t)bg * 64 + 2 * dq) * 512 + kperm(n); dst[0] = (bf16)f2bf(o0); dst[512] = (bf16)f2bf(o1); }
        __syncthreads();
    }
}
constexpr int AT_KB = 9216, AT_SLOT = 2 * AT_KB;
constexpr int AT_IMP = 2 * AT_SLOT;
constexpr int AT_SEL = AT_IMP + 8 * 4096;
constexpr float AT_C2 = 0.125f * 1.4426950408889634f;
struct AtStg { v4u k, v; };
__device__ __forceinline__ void at_load(AtStg& s, const bf16* Kblk, size_t kpitch, const bf16* VTblk, size_t vpitch, int tid) {
    const int r = tid >> 3, c = (tid & 7) * 8;
    s.k = *(const GAS v4u*)(Kblk + (size_t)r * kpitch + c); s.v = *(const GAS v4u*)(VTblk + (size_t)r * vpitch + c);
}
__device__ __forceinline__ void at_store(const AtStg& s, LAS unsigned char* slot, int tid) {
    const int r = tid >> 3, c = (tid & 7) * 16;
    *(LAS v4u*)(slot + r * 144 + c) = s.k; *(LAS v4u*)(slot + AT_KB + r * 144 + c) = s.v;
}
__device__ __forceinline__ void at_qk(f32x4 (&sc)[4][2], const LAS unsigned char* slot, const bf16x8 (&Qb)[2][2], int fr, int fq) {
#pragma unroll
    for (int mt = 0; mt < 4; ++mt) { sc[mt][0] = (f32x4){0.f, 0.f, 0.f, 0.f}; sc[mt][1] = (f32x4){0.f, 0.f, 0.f, 0.f};
#pragma unroll
        for (int ks = 0; ks < 2; ++ks) { const bf16x8 ak = *(const LAS bf16x8*)(slot + (16 * mt + fr) * 144 + (32 * ks + 8 * fq) * 2);
            sc[mt][0] = __builtin_amdgcn_mfma_f32_16x16x32_bf16(ak, Qb[0][ks], sc[mt][0], 0, 0, 0); sc[mt][1] = __builtin_amdgcn_mfma_f32_16x16x32_bf16(ak, Qb[1][ks], sc[mt][1], 0, 0, 0); } }
}
__device__ __forceinline__ void at_pv(f32x4 (&oc)[4][2], const f32x4 (&p)[4][2], const LAS unsigned char* slot, int fr, int fq) {
    bf16x8 Bp[2][2];
#pragma unroll
    for (int nt = 0; nt < 2; ++nt)
#pragma unroll
        for (int kc = 0; kc < 2; ++kc) { v4u w; w.x = pk2(p[2 * kc][nt][0], p[2 * kc][nt][1]); w.y = pk2(p[2 * kc][nt][2], p[2 * kc][nt][3]); w.z = pk2(p[2 * kc + 1][nt][0], p[2 * kc + 1][nt][1]); w.w = pk2(p[2 * kc + 1][nt][2], p[2 * kc + 1][nt][3]); Bp[nt][kc] = __builtin_bit_cast(bf16x8, w); }
#pragma unroll
    for (int dt = 0; dt < 4; ++dt)
#pragma unroll
        for (int kc = 0; kc < 2; ++kc) { const bf16x8 av = *(const LAS bf16x8*)(slot + AT_KB + (16 * dt + fr) * 144 + (32 * kc + 8 * fq) * 2);
            oc[dt][0] = __builtin_amdgcn_mfma_f32_16x16x32_bf16(av, Bp[0][kc], oc[dt][0], 0, 0, 0); oc[dt][1] = __builtin_amdgcn_mfma_f32_16x16x32_bf16(av, Bp[1][kc], oc[dt][1], 0, 0, 0); }
}
__device__ __forceinline__ void at_online(f32x4 (&sc)[4][2], float (&m)[2], float (&l)[2], f32x4 (&oc)[4][2]) {
#pragma unroll
    for (int nt = 0; nt < 2; ++nt) {
        float mx = -INFINITY;
#pragma unroll
        for (int mt = 0; mt < 4; ++mt) mx = fmaxf(fmaxf(fmaxf(sc[mt][nt][0], sc[mt][nt][1]), fmaxf(sc[mt][nt][2], sc[mt][nt][3])), mx);
        mx = fmaxf(mx, shx<16>(mx)); mx = fmaxf(mx, shx<32>(mx));
        const float mn = fmaxf(m[nt], mx), ms = mn == -INFINITY ? 0.f : mn, alpha = exp2f(m[nt] - ms);
        float s = 0.f;
#pragma unroll
        for (int mt = 0; mt < 4; ++mt)
#pragma unroll
            for (int i = 0; i < 4; ++i) { const float e = exp2f(sc[mt][nt][i] - ms); sc[mt][nt][i] = e; s += e; }
        s += shx<16>(s); s += shx<32>(s);
        l[nt] = l[nt] * alpha + s; m[nt] = mn;
#pragma unroll
        for (int dt = 0; dt < 4; ++dt) oc[dt][nt] = oc[dt][nt] * alpha;
    }
}
#define AT_SYNC() __syncthreads()
__device__ __forceinline__ unsigned at_w4(const unsigned (&a)[4], int w) { return w == 0 ? a[0] : w == 1 ? a[1] : w == 2 ? a[2] : a[3]; }
#define AT_LOOP(nblk, PTRS, BODY) do { \
        AtStg stg_; const bf16* Kp_; const bf16* Vp_; \
        if ((nblk) > 0) { PTRS(0, Kp_, Vp_); at_load(stg_, Kp_, kpitch_, Vp_, vpitch_, tid); at_store(stg_, ring, tid); } \
        AT_SYNC(); \
        for (int i_ = 0; i_ < (nblk); ++i_) { \
            LAS unsigned char* slot = ring + (i_ & 1) * AT_SLOT; \
            if (i_ + 1 < (nblk)) { PTRS(i_ + 1, Kp_, Vp_); at_load(stg_, Kp_, kpitch_, Vp_, vpitch_, tid); } \
            BODY(i_); \
            if (i_ + 1 < (nblk)) at_store(stg_, ring + ((i_ + 1) & 1) * AT_SLOT, tid); \
            AT_SYNC(); \
        } } while (0)

__device__ __forceinline__ void nsa_attn_tile(Frame& F, const Args& a, int l, int b, int g, int tb) {
    LAS unsigned char* ring = F.lds + RING_OFF;
    int tid_l = F.tid, lane_l = F.lane; asm volatile("" : "+v"(tid_l), "+v"(lane_l));
    const int tid = tid_l, lane = lane_l, wave = F.wave, fr = lane & 15, fq = lane >> 4;
    LAS float* impw = (LAS float*)(F.lds + RING_OFF + AT_IMP + wave * 4096);
    LAS unsigned* selw = (LAS unsigned*)(F.lds + RING_OFF + AT_SEL + wave * 128);
    const bf16* P = WSP(bf16, WS_P); const float* SC = WSP(float, WS_SC);
    const int t0 = tb * 64, bg = b * 2 + g;
    int tt[2], head = fr & 3; size_t row[2];
#pragma unroll
    for (int nt = 0; nt < 2; ++nt) { tt[nt] = wave * 8 + 4 * nt + (fr >> 2); row[nt] = (size_t)b * SEQ + t0 + tt[nt]; }
    bf16x8 Qb[2][2];
#pragma unroll
    for (int nt = 0; nt < 2; ++nt)
#pragma unroll
        for (int ks = 0; ks < 2; ++ks) Qb[nt][ks] = *(const GAS bf16x8*)(P + row[nt] * NINP + PC_QB + (4 * g + head) * 64 + 32 * ks + 8 * fq);
    f32x4 outa[4][2];
#pragma unroll
    for (int dt = 0; dt < 4; ++dt) { outa[dt][0] = (f32x4){0.f, 0.f, 0.f, 0.f}; outa[dt][1] = (f32x4){0.f, 0.f, 0.f, 0.f}; }
    f32x4 sc[4][2], oc[4][2]; float m[2], lsum[2];
    size_t kpitch_, vpitch_;
#define AT_RESET() do { m[0] = m[1] = -INFINITY; lsum[0] = lsum[1] = 0.f; _Pragma("unroll") for (int dt = 0; dt < 4; ++dt) { oc[dt][0] = (f32x4){0.f, 0.f, 0.f, 0.f}; oc[dt][1] = (f32x4){0.f, 0.f, 0.f, 0.f}; } } while (0)
#define AT_ACCUM(br) do { _Pragma("unroll") for (int nt = 0; nt < 2; ++nt) { const float gt = sigmoidf_(SC[row[nt] * 32 + 8 + (4 * g + head) * 3 + (br)]); const float f = lsum[nt] > 0.f ? gt / lsum[nt] : 0.f; \
        _Pragma("unroll") for (int dt = 0; dt < 4; ++dt) outa[dt][nt] += oc[dt][nt] * f; } } while (0)

    const int nkb = (4 * tb + 3 + 63) >> 6;
    int ncmp[2];
#pragma unroll
    for (int nt = 0; nt < 2; ++nt) { const int t = t0 + tt[nt]; ncmp[nt] = t >= 31 ? (t - 15) >> 4 : 0; }
    const bf16* KC = WSP(bf16, NSA_KC) + (size_t)bg * 512 * 64; const bf16* VCT = WSP(bf16, NSA_VCT) + (size_t)bg * 64 * 512;
    kpitch_ = 64; vpitch_ = 512;
#define CMP_PTRS(i, Kp, Vp) do { Kp = KC + (size_t)(i) * 64 * 64; Vp = VCT + (i) * 64; } while (0)
#define CMP_MASK(i) do { _Pragma("unroll") for (int mt = 0; mt < 4; ++mt) _Pragma("unroll") for (int nt = 0; nt < 2; ++nt) _Pragma("unroll") for (int q = 0; q < 4; ++q) { \
        const int n = (i) * 64 + 16 * mt + 4 * fq + q; sc[mt][nt][q] = n < ncmp[nt] ? sc[mt][nt][q] * AT_C2 : -INFINITY; } } while (0)
    AT_RESET();
#define CMP_BODY1(i) do { at_qk(sc, slot, Qb, fr, fq); CMP_MASK(i); at_online(sc, m, lsum, oc); } while (0)
    AT_LOOP(nkb, CMP_PTRS, CMP_BODY1);
    for (int i = lane; i < 1024; i += 64) impw[i] = 0.f;
    float rinv[2], msafe[2], carry[2] = {0.f, 0.f};
#pragma unroll
    for (int nt = 0; nt < 2; ++nt) { rinv[nt] = lsum[nt] > 0.f ? 1.f / lsum[nt] : 0.f; msafe[nt] = m[nt] == -INFINITY ? 0.f : m[nt]; }
#define CMP_BODY2(i) do { at_qk(sc, slot, Qb, fr, fq); CMP_MASK(i); \
        _Pragma("unroll") for (int nt = 0; nt < 2; ++nt) { \
            _Pragma("unroll") for (int mt = 0; mt < 4; ++mt) _Pragma("unroll") for (int q = 0; q < 4; ++q) sc[mt][nt][q] = exp2f(sc[mt][nt][q] - msafe[nt]) * rinv[nt]; \
            float qd[4], p3[4]; \
            _Pragma("unroll") for (int mt = 0; mt < 4; ++mt) { float x = (sc[mt][nt][0] + sc[mt][nt][1]) + (sc[mt][nt][2] + sc[mt][nt][3]), y = sc[mt][nt][3]; \
                x += shx<1>(x); x += shx<2>(x); y += shx<1>(y); y += shx<2>(y); qd[mt] = x; p3[mt] = y; } \
            _Pragma("unroll") for (int mt = 0; mt < 4; ++mt) { const float up = bperm(p3[mt], (lane + 48) & 63); const float prevmt = mt == 0 ? carry[nt] : bperm(p3[mt == 0 ? 0 : mt - 1], (lane + 48) & 63); \
                const float c = fq > 0 ? up : prevmt; \
                if ((fr & 3) == 0) impw[(4 * nt + (fr >> 2)) * 128 + (i) * 16 + 4 * mt + fq] = qd[mt] + c; } \
            carry[nt] = bperm(p3[3], (lane + 48) & 63); } \
        at_pv(oc, sc, slot, fr, fq); } while (0)
    AT_RESET(); lsum[0] = lsum[1] = 1.f;
    AT_LOOP(nkb, CMP_PTRS, CMP_BODY2);
    AT_ACCUM(0);
    for (int tk = 0; tk < 8; ++tk) {
        LAS float* iv = impw + tk * 128;
        float v0 = iv[lane], v1 = iv[64 + lane];
        { const int j0 = lane, j1 = lane + 64; v0 = (j0 == 0 || j0 == tb) ? 1e9f : (j0 <= tb ? v0 : -1.f); v1 = (j1 == tb) ? 1e9f : (j1 <= tb ? v1 : -1.f); }
        iv[lane] = v0; iv[64 + lane] = v1;
        LDS_WAIT(); asm volatile("" ::: "memory");
        int c0 = 0, c1 = 0;
        for (int i4 = 0; i4 < 32; ++i4) { const f32x4 x = *(const LAS f32x4*)(iv + 4 * i4);
#pragma unroll
            for (int q = 0; q < 4; ++q) { const int i = 4 * i4 + q; const float xi = x[q];
                c0 += (xi > v0 || (xi == v0 && i < lane)) ? 1 : 0; c1 += (xi > v1 || (xi == v1 && i < lane + 64)) ? 1 : 0; } }
        const unsigned long long b0 = __builtin_amdgcn_ballot_w64(c0 < NSEL && lane <= tb), b1 = __builtin_amdgcn_ballot_w64(c1 < NSEL && lane + 64 <= tb);
        if (lane == 0) { selw[tk * 4 + 0] = (unsigned)b0; selw[tk * 4 + 1] = (unsigned)(b0 >> 32); selw[tk * 4 + 2] = (unsigned)b1; selw[tk * 4 + 3] = (unsigned)(b1 >> 32); }
    }
    LDS_WAIT(); asm volatile("" ::: "memory");
    unsigned mk[2][4], orm[4];
#pragma unroll
    for (int w4 = 0; w4 < 4; ++w4) { mk[0][w4] = selw[(fr >> 2) * 4 + w4]; mk[1][w4] = selw[(4 + (fr >> 2)) * 4 + w4];
        unsigned o = 0; for (int tk = 0; tk < 8; ++tk) o |= selw[tk * 4 + w4]; orm[w4] = __builtin_amdgcn_readfirstlane(o); }
    const bf16* KS = P + ((size_t)b * SEQ) * NINP + PC_KVS + g * 64; const bf16* VST = WSP(bf16, NSA_VSLT) + (size_t)bg * 64 * SEQ;
    kpitch_ = NINP; vpitch_ = SEQ;
#define SEL_PTRS(i, Kp, Vp) do { Kp = KS + (size_t)(i) * 64 * NINP; Vp = VST + (i) * 64; } while (0)
#define SEL_BODY(i) do { if ((at_w4(orm, (i) >> 5) >> ((i) & 31)) & 1u) { at_qk(sc, slot, Qb, fr, fq); \
        _Pragma("unroll") for (int nt = 0; nt < 2; ++nt) { const bool on = (at_w4(mk[nt], (i) >> 5) >> ((i) & 31)) & 1u; \
            _Pragma("unroll") for (int mt = 0; mt < 4; ++mt) _Pragma("unroll") for (int q = 0; q < 4; ++q) { const int kk = 16 * mt + 4 * fq + q; \
                sc[mt][nt][q] = (on && ((i) < tb || kk <= tt[nt])) ? sc[mt][nt][q] * AT_C2 : -INFINITY; } } \
        at_online(sc, m, lsum, oc); at_pv(oc, sc, slot, fr, fq); } } while (0)
    AT_RESET();
    AT_LOOP(tb + 1, SEL_PTRS, SEL_BODY);
    AT_ACCUM(1);
    const bf16* KW = P + ((size_t)b * SEQ) * NINP + PC_KVW + g * 64; const bf16* VWT_ = WSP(bf16, NSA_VWT) + (size_t)bg * 64 * SEQ;
    const int jw0 = tb >= 8 ? tb - 8 : 0, nwb = tb - jw0 + 1;
#define WIN_PTRS(i, Kp, Vp) do { Kp = KW + (size_t)(jw0 + (i)) * 64 * NINP; Vp = VWT_ + (jw0 + (i)) * 64; } while (0)
#define WIN_BODY(i) do { const int j = jw0 + (i); at_qk(sc, slot, Qb, fr, fq); \
        _Pragma("unroll") for (int nt = 0; nt < 2; ++nt) _Pragma("unroll") for (int mt = 0; mt < 4; ++mt) _Pragma("unroll") for (int q = 0; q < 4; ++q) { const int kk = 16 * mt + 4 * fq + q; \
            const bool ok = (j < tb || kk <= tt[nt]) && (j > tb - 8 || kk > tt[nt]); sc[mt][nt][q] = ok ? sc[mt][nt][q] * AT_C2 : -INFINITY; } \
        at_online(sc, m, lsum, oc); at_pv(oc, sc, slot, fr, fq); } while (0)
    AT_RESET();
    AT_LOOP(nwb, WIN_PTRS, WIN_BODY);
    AT_ACCUM(2);
    bf16* OB = WSP(bf16, WS_OAB) + (size_t)MT * 512;
#pragma unroll
    for (int nt = 0; nt < 2; ++nt)
#pragma unroll
        for (int dt = 0; dt < 4; ++dt) { v2u w; w.x = pk2(outa[dt][nt][0], outa[dt][nt][1]); w.y = pk2(outa[dt][nt][2], outa[dt][nt][3]); *(GAS v2u*)(OB + row[nt] * 512 + (4 * g + head) * 64 + 16 * dt + 4 * fq) = w; }
    AT_SYNC();
#undef AT_RESET
#undef AT_ACCUM
#undef CMP_PTRS
#undef CMP_MASK
#undef CMP_BODY1
#undef CMP_BODY2
#undef SEL_PTRS
#undef SEL_BODY
#undef WIN_PTRS
#undef WIN_BODY
}

__device__ __forceinline__ void nsa_sample_softmax(LAS float* sc, int nkeys, int pitch, LAS float* red, int tid, int lane, int wave) {
    if (wave < 4) { LAS float* s = sc + wave * pitch; float mx = -INFINITY;
        for (int i = lane; i < nkeys; i += 64) mx = fmaxf(mx, s[i]);
        mx = wave_max(mx); const float ms = mx == -INFINITY ? 0.f : mx; float sum = 0.f;
        for (int i = lane; i < nkeys; i += 64) { const float e = __expf(s[i] - ms); s[i] = e; sum += e; }
        sum = wave_sum(sum); const float inv = sum > 0.f ? 1.f / fmaxf(sum, 1e-30f) : 0.f;
        for (int i = lane; i < nkeys; i += 64) s[i] *= inv; }
    (void)red; (void)tid;
}
__device__ __forceinline__ float dot64(const float* kr, const LAS float* q) {
    float acc = 0.f;
#pragma unroll
    for (int c = 0; c < 16; ++c) { const f32x4 k = *(const GAS f32x4*)(kr + 4 * c); const f32x4 qq = *(const LAS f32x4*)(q + 4 * c); acc += (k.x * qq.x + k.y * qq.y) + (k.z * qq.z + k.w * qq.w); }
    return acc;
}
__device__ __forceinline__ void nsa_attn_sample(Frame& F, const Args& a, int l, int unit) {
    constexpr int SP = 1152;
    LAS float* qs = (LAS float*)(F.lds + RING_OFF);
    LAS float* sc = qs + 256;
    LAS float* impv = sc + 4 * SP;
    LAS float* red = impv + 192;
    LAS int* list = (LAS int*)(red + 512);
    LAS int* flag = list + 16;
    const int tid = F.tid, lane = F.lane, wave = F.wave, bs = unit >> 1, g = unit & 1; const size_t row = MP + bs;
    const bf16* P = WSP(bf16, WS_P); const float* SC = WSP(float, WS_SC); const int* pt = INP(int, I_PT) + bs * NPAGES;
    if (tid < 256) qs[tid] = 0.125f * bf2f(P[row * NINP + PC_QB + (4 * g + (tid >> 6)) * 64 + (tid & 63)]);
    float oacc = 0.f;
    const int r_ = (tid >> 6) & 3, d_ = tid & 63, half = tid >> 8;
    __syncthreads();
    const float* KCS = WSP(float, SMP_KCS) + (size_t)unit * 512 * 64; const float* VCS = WSP(float, SMP_VCS) + (size_t)unit * 512 * 64;
    if (tid < NCMP) { const float* kr = KCS + (size_t)tid * 64;
#pragma unroll
        for (int r = 0; r < 4; ++r) sc[r * SP + tid] = dot64(kr, qs + r * 64); }
    __syncthreads();
    nsa_sample_softmax(sc, NCMP, SP, red, tid, lane, wave);
    __syncthreads();
    if (tid < 129) { float v = 0.f;
        if (tid < 128) { for (int r = 0; r < 4; ++r) { const LAS float* p = sc + r * SP; for (int q = -1; q < 4; ++q) { const int n = 4 * tid + q; if (n >= 0 && n < NCMP) v += p[n]; } } }
        impv[tid] = (tid == 0 || tid == 128) ? 1e9f : v; }
    { float part = 0.f; const LAS float* p = sc + r_ * SP; const int n0 = half * 256, n1 = half ? NCMP : 256;
      for (int n = n0; n < n1; ++n) part += p[n] * VCS[(size_t)n * 64 + d_];
      red[half * 256 + (tid & 255)] = part; }
    __syncthreads();
    if (tid < 256) oacc += sigmoidf_(SC[row * 32 + 8 + (4 * g + r_) * 3 + 0]) * (red[tid] + red[256 + tid]);
    if (tid < 129) { const float v = impv[tid]; int c = 0; for (int i = 0; i < 129; ++i) { const float x = impv[i]; c += (x > v || (x == v && i < tid)) ? 1 : 0; } flag[tid] = c < NSEL ? 1 : 0; }
    __syncthreads();
    if (tid == 0) { int n = 0; for (int j = 0; j < 129; ++j) if (flag[j] && n < NSEL) list[n++] = j; for (; n < NSEL; ++n) list[n] = -1; }
    __syncthreads();
    const float* CS = INP(float, I_CSLC) + (size_t)l * NPOOL * PAGE * KVW; const float* newslc = a.out + O_SLC_S + (size_t)(l * MS + bs) * KVW;
    for (int pr = tid; pr < 1024; pr += NTHR) { const int jb = list[pr >> 6], kk = pr & 63; const float* kr = nullptr;
        if (jb >= 0 && jb < 128) { const int pos = jb * 64 + kk; kr = CS + ((size_t)pt[pos >> 7] * PAGE + (pos & 127)) * KVW + g * 64; }
        else if (jb == 128 && kk == 0) kr = newslc + g * 64;
#pragma unroll
        for (int r = 0; r < 4; ++r) sc[r * SP + pr] = kr ? dot64(kr, qs + r * 64) : -INFINITY; }
    __syncthreads();
    nsa_sample_softmax(sc, 1024, SP, red, tid, lane, wave);
    __syncthreads();
    { float part = 0.f; const LAS float* p = sc + r_ * SP;
      for (int pr = half * 512; pr < half * 512 + 512; ++pr) { const int jb = list[pr >> 6], kk = pr & 63; const float* vr = nullptr;
          if (jb >= 0 && jb < 128) { const int pos = jb * 64 + kk; vr = CS + ((size_t)pt[pos >> 7] * PAGE + (pos & 127)) * KVW + 128 + g * 64; }
          else if (jb == 128 && kk == 0) vr = newslc + 128 + g * 64;
          if (vr) part += p[pr] * vr[d_]; }
      red[half * 256 + (tid & 255)] = part; }
    __syncthreads();
    if (tid < 256) oacc += sigmoidf_(SC[row * 32 + 8 + (4 * g + r_) * 3 + 1]) * (red[tid] + red[256 + tid]);
    __syncthreads();
    const float* WB = INP(float, I_SWIN) + ((size_t)(l * MS + bs) * WINDOW) * KVW; const float* newwin = a.out + O_WIN_S + ((size_t)(l * MS + bs) * WINDOW + (WINDOW - 1)) * KVW;
    { const float* kr = tid < 511 ? WB + (size_t)(tid + 1) * KVW + g * 64 : newwin + g * 64;
#pragma unroll
      for (int r = 0; r < 4; ++r) sc[r * SP + tid] = dot64(kr, qs + r * 64); }
    __syncthreads();
    nsa_sample_softmax(sc, 512, SP, red, tid, lane, wave);
    __syncthreads();
    { float part = 0.f; const LAS float* p = sc + r_ * SP;
      for (int w = half * 256; w < half * 256 + 256; ++w) { const float* vr = w < 511 ? WB + (size_t)(w + 1) * KVW + 128 + g * 64 : newwin + 128 + g * 64; part += p[w] * vr[d_]; }
      red[half * 256 + (tid & 255)] = part; }
    __syncthreads();
    if (tid < 256) { oacc += sigmoidf_(SC[row * 32 + 8 + (4 * g + r_) * 3 + 2]) * (red[tid] + red[256 + tid]);
        (WSP(bf16, WS_OAB) + (size_t)MT * 512)[row * 512 + (4 * g + r_) * 64 + d_] = (bf16)f2bf(oacc); }
    __syncthreads();
}
__device__ __forceinline__ void fresh(Frame& F) { F.lane = my_lane(); F.tid = F.wave * 64 + F.lane; }
#ifndef MK_FUSED
#define MK_FUSED 0
#endif
__global__ void __launch_bounds__(NTHR, 2) mega(Args a) {
    extern __shared__ __attribute__((aligned(16))) unsigned char lds_raw[];
    Frame F;
    F.lds = (LAS unsigned char*)lds_raw;
    F.MISC = (volatile LAS unsigned*)(F.lds + MISC_OFF);
    F.wave = __builtin_amdgcn_readfirstlane((int)threadIdx.x >> 6); F.lane = my_lane(); F.tid = F.wave * 64 + F.lane;
    F.G = gridDim.x; F.bid = blockIdx.x;
    F.ctl = (gu32*)(a.ws + WS_CTL);
    for (int u = F.tid; u < (LDS_BYTES - LDSCTL_OFF) / 4; u += NTHR) ((LAS unsigned*)(F.lds + LDSCTL_OFF))[u] = 0u;
    __syncthreads();
    XcdBarrier bar; bar.bar = (unsigned*)(F.ctl + CW_BAR); bar.x = 0; bar.st = nullptr;
    if (MK_FUSED) bar = xcd_barrier_post((unsigned*)(F.ctl + CW_BAR), F.MISC + 8);
    const int lo = a.ph_lo, hi = a.ph_hi;
#define IN(k) (fresh(F), lo <= (k) && (k) < hi)
#define SEAM(k) do { if (MK_FUSED && IN(k) && IN((k) + 1)) xcd_barrier(bar); } while (0)

    if (IN(PH_PRO)) { p0_prologue(F, a); }
    SEAM(PH_PRO);
#pragma unroll
    for (int l = 0; l < 2; ++l) {
        const int pb = 1 + l * NPL;
        if (IN(pb + LP_LNMOD)) { if (l == 0) p_lnmod0(F, a); }
        SEAM(pb + LP_LNMOD);
        if (IN(pb + LP_INPROJ)) {
            pg8::Gemm g{WSP(bf16, WS_XN), WSP(bf16, WS_WIN_T) + (size_t)l * NINP * D, MT, NINP, D}; pg8::StaticOrder S; S.init(MT, NINP, F.G, F.bid);
            EpiIn E{WSP(bf16, WS_P), WSP(float, WS_SC), a.out, l};
            pg8::gemm_phase<EpiIn, pg8::StaticOrder, true, true>(F.lds + RING_OFF, g, S, E, F.tid);
        }
        SEAM(pb + LP_INPROJ);
        if (IN(pb + LP_PREP)) { gdn_prep(F, a, l); nsa_prep(F, a, l); }
        SEAM(pb + LP_PREP);
        if (IN(pb + LP_CMP1)) {
            pg8::Gemm g{WSP(bf16, SMP_SEG) + (size_t)l * 2 * SEGROWS * 1024, WSP(bf16, WS_CW1_T) + (size_t)l * 1024 * 1024, 2 * SEGROWS, 512, 1024}; CmpOrder S{F.G, F.bid};
            EpiBf16P E{WSP(bf16, SMP_HP), 512};
            pg8::gemm_phase<EpiBf16P, CmpOrder, true, true>(F.lds + RING_OFF, g, S, E, F.tid);
        }
        SEAM(pb + LP_CMP1);
        if (IN(pb + LP_CMP2)) { nsa_cmp2(F, a, l); }
        SEAM(pb + LP_CMP2);
        if (IN(pb + LP_MIX)) {
            if (F.bid < 8) gdn_scan(F, a, l, F.bid);
            else {
                const int wb = F.bid - 8, nwb_ = F.G - 8;
                for (int idx = wb; idx < 128; idx += nwb_) gdn_sample(F, a, l, idx);
                fresh(F);
                for (int idx = wb - 128; idx < 64; idx += nwb_) { if (idx >= 0) nsa_attn_sample(F, a, l, idx); }
                fresh(F);
                for (int L = wb; L < 512; L += nwb_) nsa_attn_tile(F, a, l, (L >> 1) & 1, L & 1, 127 - (L >> 2));
            }
        }
        SEAM(pb + LP_MIX);
        if (IN(pb + LP_ONORM)) { gdn_onorm(F, a, l); }
        SEAM(pb + LP_ONORM);
        if (IN(pb + LP_UP)) {
            pg8::Gemm g{WSP(bf16, WS_OAB), WSP(bf16, WS_WUP_T) + (size_t)l * 2048 * 512, MT, 1024, 512}; ChainOrder S{F.G, F.bid};
            EpiUp E{WSP(bf16, WS_P), WSP(bf16, WS_U)};
            pg8::gemm_phase<EpiUp, ChainOrder, true, true>(F.lds + RING_OFF, g, S, E, F.tid);
        }
        SEAM(pb + LP_UP);
        if (IN(pb + LP_OUT)) {
            pg8::Gemm g{WSP(bf16, WS_U), WSP(bf16, WS_WOUT_T) + (size_t)l * D * D, MT, D, D}; pg8::StaticOrder S; S.init(MT, D, F.G, F.bid);
            EpiF32 E{WSP(float, WS_Y)};
            pg8::gemm_phase<EpiF32, pg8::StaticOrder, true, true>(F.lds + RING_OFF, g, S, E, F.tid);
        }
        SEAM(pb + LP_OUT);
        if (IN(pb + LP_LN1)) {
            if (l == 0) p_lnpass<1, false>(F, a, 0, 0, nullptr, WSP(float, WS_XA), WSP(float, WS_Y));
            else        p_lnpass<1, true>(F, a, 1, 0, WSP(float, WS_XB), WSP(float, WS_XA), WSP(float, WS_Y));
        }
        SEAM(pb + LP_LN1);
        if (IN(pb + LP_MOEG)) { if (l == 1) p_moe_gather(F, a); }
        SEAM(pb + LP_MOEG);
        if (IN(pb + LP_FFN1)) {
            EpiSwiglu E{WSP(bf16, WS_ACT)};
            if (l == 0) { pg8::Gemm g{WSP(bf16, WS_XN), WSP(bf16, WS_WGU_T), MT, 2 * DFF, D}; pg8::StaticOrder S; S.init(MT, 2 * DFF, F.G, F.bid);
                pg8::gemm_phase<EpiSwiglu, pg8::StaticOrder, true, true>(F.lds + RING_OFF, g, S, E, F.tid); }
            else { pg8::Gemm g{WSP(bf16, WS_APERM), WSP(bf16, WS_MGU_T), MT, 2 * DFF, D}; MoeOrder<22> S{F.G, F.bid, WSP(int, MOE_META)};
                pg8::gemm_phase<EpiSwiglu, MoeOrder<22>, true, true>(F.lds + RING_OFF, g, S, E, F.tid); }
        }
        SEAM(pb + LP_FFN1);
        if (IN(pb + LP_FFN2)) {
            EpiF32 E{WSP(float, WS_Y)};
            if (l == 0) { pg8::Gemm g{WSP(bf16, WS_ACT), WSP(bf16, WS_WDN_T), MT, D, DFF}; pg8::StaticOrder S; S.init(MT, D, F.G, F.bid);
                pg8::gemm_phase<EpiF32, pg8::StaticOrder, true, true>(F.lds + RING_OFF, g, S, E, F.tid); }
            else { pg8::Gemm g{WSP(bf16, WS_ACT), WSP(bf16, WS_MDN_T), MT, D, DFF}; MoeOrder<4> S{F.G, F.bid, WSP(int, MOE_META)};
                pg8::gemm_phase<EpiF32, MoeOrder<4>, true, true>(F.lds + RING_OFF, g, S, E, F.tid); }
        }
        SEAM(pb + LP_FFN2);
        if (IN(pb + LP_LN2)) {
            if (l == 0) p_lnpass<1, false>(F, a, 0, 1, WSP(float, WS_XA), WSP(float, WS_XB), WSP(float, WS_Y));
            else        p_lnpass<2, false>(F, a, 1, 1, WSP(float, WS_XA), nullptr, WSP(float, WS_Y));
        }
        SEAM(pb + LP_LN2);
    }
#undef IN
#undef SEAM
}

extern "C" void kernel_launch(void* const* d_in, const int* in_sizes, int n_in, void* d_out, int out_size, void* d_ws, size_t ws_size, hipStream_t stream) {
    static int grid = 0;
    if (grid == 0) {
        if (n_in != N_INPUTS || (size_t)out_size != O_END || ws_size < WS_END) { fprintf(stderr, "kernel_launch: unexpected shapes: n_in %d out %d ws %zu (need %zu)\n", n_in, out_size, ws_size, (size_t)WS_END); grid = -1; return; }
        int dev = 0, cus = 0, per_cu = 0;
        if (hipGetDevice(&dev) != hipSuccess || hipDeviceGetAttribute(&cus, hipDeviceAttributeMultiprocessorCount, dev) != hipSuccess) { grid = -1; return; }
        if (hipFuncSetAttribute((const void*)mega, hipFuncAttributeMaxDynamicSharedMemorySize, LDS_BYTES) != hipSuccess) { fprintf(stderr, "kernel_launch: hipFuncSetAttribute failed\n"); grid = -1; return; }
        if (hipOccupancyMaxActiveBlocksPerMultiprocessor(&per_cu, (const void*)mega, NTHR, LDS_BYTES) != hipSuccess || per_cu < 1) fprintf(stderr, "kernel_launch: occupancy query says %d\n", per_cu);
        (void)hipGetLastError();
        grid = cus;
    }
    if (grid < 0) return;
    if (hipMemsetAsync((char*)d_ws + WS_CTL, 0, ZERO_BYTES, stream) != hipSuccess) return;
    Args a{};
    for (int i = 0; i < N_INPUTS; ++i) a.in[i] = d_in[i];
    a.out = (float*)d_out; a.ws = (unsigned char*)d_ws;
#if MK_FUSED
    a.ph_lo = 0; a.ph_hi = NPH;
    hipLaunchKernelGGL(mega, dim3(grid), dim3(NTHR), LDS_BYTES, stream, a);
#else
    for (int ph = 0; ph < NPH; ++ph) {
        const int lp = ph == 0 ? -1 : (ph - 1) % NPL, l = ph == 0 ? 0 : (ph - 1) / NPL;
        const bool active = ph == 0 || (lp == LP_LNMOD && l == 0) || lp == LP_INPROJ || lp == LP_PREP || lp == LP_CMP1 || lp == LP_CMP2 || lp == LP_MIX || lp == LP_ONORM || lp == LP_UP || lp == LP_OUT || lp == LP_LN1 || (lp == LP_MOEG && l == 1) || lp == LP_FFN1 || lp == LP_FFN2 || lp == LP_LN2;
        if (!active) continue;
        a.ph_lo = ph; a.ph_hi = ph + 1;
        hipLaunchKernelGGL(mega, dim3(grid), dim3(NTHR), LDS_BYTES, stream, a);
    }
#endif
}
```

```cpp
#include <hip/hip_runtime.h>
#include <cstdio>
#include <cstdint>
namespace pg8 {
#define PG8_LAS __attribute__((address_space(3)))
typedef unsigned short bf16_t;
typedef short bf16x8 __attribute__((ext_vector_type(8)));
typedef float f32x4 __attribute__((ext_vector_type(4)));
typedef unsigned u32x4 __attribute__((ext_vector_type(4)));
constexpr int BM = 256, BK = 64, HALF = 128, HTB = HALF * BK * 2  , STAGE_BYTES = 8 * HTB, NXCD = 8, WGM = 8;

__host__ __device__ __forceinline__ int lds_byte(int r, int c) { const int st = (r >> 4) * 2 + (c >> 5), rr = r & 15, cc = c & 31, ob = rr * 64 + cc * 2; return st * 1024 + (ob ^ (((ob >> 9) & 1) << 5)); }
__host__ __device__ __forceinline__ void stage_rc(int b, int& R, int& C) { const int st = b / 1024, sb = b % 1024, swz = sb ^ (((sb >> 9) & 1) << 5); R = (st >> 1) * 16 + swz / 64; C = (st & 1) * 32 + (swz % 64) / 2; }
__host__ __device__ __forceinline__ int perm32(int rho) { const int n = rho >> 4, i = rho & 15; return 8 * (i >> 2) + 4 * n + (i & 3); }

struct Unit { int pm, pn, am, bn, am2, bn2; };
struct Gemm { const bf16_t* A; const bf16_t* Bt; int M, N, K; };

struct StaticOrder {
    int nM, nN, nwg, G, c;
    __host__ __device__ void init(int M, int N, int G_, int c_) { nM = M / BM; nN = N / BM; nwg = nM * nN; G = G_; c = c_; }
    __host__ __device__ bool next(int i, Unit& u) const {
        const long L = (long)i * G + c; if (L >= nwg) return false;
        int wgid = (int)L; { const int q = nwg / NXCD, r = nwg % NXCD, xcd = wgid % NXCD, off = wgid / NXCD; wgid = (xcd < r ? xcd * (q + 1) : r * (q + 1) + (xcd - r) * q) + off; }
        const int nig = WGM * nN, gid = wgid / nig, fm = gid * WGM, gsz = (nM - fm) < WGM ? (nM - fm) : WGM;
        u.pm = fm + ((wgid % nig) % gsz); u.pn = (wgid % nig) / gsz; u.am = u.pm; u.bn = u.pn; u.am2 = 0; u.bn2 = 0; return true;
    }
    __device__ __forceinline__ void a_ready(const Unit&) const {}
    __device__ __forceinline__ void done(const Unit&) const {}
};

template <class Epi, class Sched, bool ALIGN_EPI = false, bool SP2 = false>
__device__ __forceinline__ void gemm_phase(PG8_LAS unsigned char* lds, const Gemm g, const Sched& S, const Epi& E, int tid_in) {
    int tid_ = tid_in; asm volatile("" : "+v"(tid_));
    const int tid = tid_, wid = __builtin_amdgcn_readfirstlane(tid >> 6), lane = tid & 63, wr = wid >> 2, wc = wid & 3, fr = lane & 15, fq = lane >> 4;
    const int K = g.K, nt = K / BK, ntot = Epi::CHAIN ? 2 * nt : nt;
    unsigned voffA[2], voffB[2];
#pragma unroll
    for (int i = 0; i < 2; ++i) { int R, C; stage_rc(tid * 16 + i * 8192, R, C); const int Rb = Epi::PERM ? ((R & ~31) + perm32(R & 31)) : R;
        voffA[i] = (unsigned)(R * K + C) * 2u; voffB[i] = (unsigned)(Rb * K + C) * 2u; }
    const size_t kstep = (size_t)(BK * 2);
    const size_t hstep = (size_t)HALF * K * 2;
    const size_t tstep = 2 * hstep;
    const unsigned ldsw = (unsigned)wid * 1024u;
    const int aoff = lds_byte(wr * 64 + fr, fq * 8), boff = lds_byte(wc * 32 + fr, fq * 8);
#define PG8_SA(b, h) (((b) * 2 + (h)) * HTB)
#define PG8_SB(b, h) ((4 + (b) * 2 + (h)) * HTB)
#define PG8_STAGE(bufoff, gbase, voff) do { _Pragma("unroll") for (int _i = 0; _i < 2; ++_i) \
        __builtin_amdgcn_global_load_lds((const unsigned*)((const char*)(gbase) + (voff)[_i]), (PG8_LAS unsigned*)(lds + (bufoff) + ldsw + _i * 8192), 16, 0, 0); } while (0)
#define PG8_LDA(dst, b, h) do { _Pragma("unroll") for (int m = 0; m < 4; ++m) _Pragma("unroll") for (int k = 0; k < 2; ++k) dst[m][k] = *(const PG8_LAS bf16x8*)(lds + PG8_SA(b, h) + aoff + m * 2048 + k * 1024); } while (0)
#define PG8_LDB(dst, b, h) do { _Pragma("unroll") for (int n = 0; n < 2; ++n) _Pragma("unroll") for (int k = 0; k < 2; ++k) dst[n][k] = *(const PG8_LAS bf16x8*)(lds + PG8_SB(b, h) + boff + n * 2048 + k * 1024); } while (0)
#define PG8_MMA(ai, bj, At, Bt) do { __builtin_amdgcn_s_setprio(1); _Pragma("unroll") for (int m = 0; m < 4; ++m) _Pragma("unroll") for (int n = 0; n < 2; ++n) _Pragma("unroll") for (int k = 0; k < 2; ++k) \
        acc[ai][bj][m][n] = __builtin_amdgcn_mfma_f32_16x16x32_bf16(Bt[n][k], At[m][k], acc[ai][bj][m][n], 0, 0, 0); __builtin_amdgcn_s_setprio(0); } while (0)
#define PG8_WAIT_V(n) asm volatile("s_waitcnt vmcnt(" #n ")" ::: "memory")
#define PG8_WAIT_L(n) asm volatile("s_waitcnt lgkmcnt(" #n ")" ::: "memory")
#define PG8_BAR __builtin_amdgcn_s_barrier()
#define PG8_SCHED __builtin_amdgcn_sched_barrier(0)
    Unit cur, nxt; int ui = 0;
    if (!S.next(0, cur)) return;
    f32x4 acc[2][2][4][2];
#pragma unroll
    for (int a = 0; a < 2; ++a)
#pragma unroll
        for (int b = 0; b < 2; ++b)
#pragma unroll
            for (int m = 0; m < 4; ++m)
#pragma unroll
                for (int n = 0; n < 2; ++n) acc[a][b][m][n] = (f32x4){0.f, 0.f, 0.f, 0.f};
    bf16x8 At[4][2], B0[2][2], B1[2][2];
    const char* cA = (const char*)g.A + (size_t)cur.am * tstep; const char* cB = (const char*)g.Bt + (size_t)cur.bn * tstep;
    const char* cA2 = cA; const char* cB2 = cB; if constexpr (Epi::CHAIN) { cA2 = (const char*)g.A + (size_t)cur.am2 * tstep; cB2 = (const char*)g.Bt + (size_t)cur.bn2 * tstep; }
#define PG8_TA(x) ((Epi::CHAIN && (x) >= nt) ? cA2 + (size_t)((x) - nt) * kstep : cA + (size_t)(x) * kstep)
#define PG8_TB(x) ((Epi::CHAIN && (x) >= nt) ? cB2 + (size_t)((x) - nt) * kstep : cB + (size_t)(x) * kstep)
    S.a_ready(cur);
    if constexpr (SP2) {
        PG8_STAGE(PG8_SB(0, 0), cB, voffB); PG8_STAGE(PG8_SB(0, 1), cB + hstep, voffB); PG8_STAGE(PG8_SA(0, 0), cA, voffA); PG8_STAGE(PG8_SA(0, 1), cA + hstep, voffA);
        if (wr == 1) PG8_BAR;
        PG8_WAIT_V(2); PG8_BAR;
        PG8_STAGE(PG8_SB(1, 0), cB + kstep, voffB); PG8_STAGE(PG8_SA(1, 0), cA + kstep, voffA); PG8_STAGE(PG8_SB(1, 1), cB + hstep + kstep, voffB);
        PG8_WAIT_V(6); PG8_BAR;
    } else {
        PG8_STAGE(PG8_SB(0, 0), cB, voffB); PG8_STAGE(PG8_SA(0, 0), cA, voffA); PG8_STAGE(PG8_SB(0, 1), cB + hstep, voffB); PG8_STAGE(PG8_SA(0, 1), cA + hstep, voffA);
        if (wr == 1) PG8_BAR;
        PG8_WAIT_V(4); PG8_BAR;
        PG8_STAGE(PG8_SB(1, 0), cB + kstep, voffB); PG8_STAGE(PG8_SA(1, 0), cA + kstep, voffA); PG8_STAGE(PG8_SB(1, 1), cB + hstep + kstep, voffB);
        PG8_WAIT_V(6); PG8_BAR;
    }
    for (;;) {
        const bool has_next = S.next(ui + 1, nxt);
        const char* nA = has_next ? (const char*)g.A + (size_t)nxt.am * tstep : cA; const char* nB = has_next ? (const char*)g.Bt + (size_t)nxt.bn * tstep : cB;
        for (int t = 0; t < ntot; t += 2) {
            if constexpr (Epi::CHAIN) { if (t == nt) E.mid(acc, cur, wr, wc, fr, fq); }
            const bool last = (t == ntot - 2);
            const char* a1 = PG8_TA(t + 1);
            const char* a2 = last ? nA : PG8_TA(t + 2); const char* b2 = last ? nB : PG8_TB(t + 2);
            const char* a3 = a2 + kstep; const char* b3 = b2 + kstep;
            if (last && has_next) S.a_ready(nxt);
            if constexpr (SP2) {
            PG8_LDB(B0, 0, 0); PG8_LDB(B1, 0, 1); PG8_SCHED; PG8_LDA(At, 0, 0); PG8_STAGE(PG8_SA(1, 1), a1 + hstep, voffA);
            PG8_WAIT_V(8); PG8_WAIT_L(0); PG8_BAR; PG8_MMA(0, 0, At, B0); PG8_MMA(0, 1, At, B1); PG8_BAR; PG8_SCHED;
            PG8_LDA(At, 0, 1); PG8_STAGE(PG8_SB(0, 0), b2, voffB); PG8_STAGE(PG8_SB(0, 1), b2 + hstep, voffB); PG8_STAGE(PG8_SA(0, 0), a2, voffA);
            PG8_WAIT_V(8); PG8_WAIT_L(0); PG8_BAR; PG8_MMA(1, 0, At, B0); PG8_MMA(1, 1, At, B1); PG8_BAR; PG8_SCHED;
            PG8_LDB(B0, 1, 0); PG8_LDB(B1, 1, 1); PG8_SCHED; PG8_LDA(At, 1, 0); PG8_STAGE(PG8_SA(0, 1), a2 + hstep, voffA);
            PG8_WAIT_V(8); PG8_WAIT_L(0); PG8_BAR; PG8_MMA(0, 0, At, B0); PG8_MMA(0, 1, At, B1); PG8_BAR; PG8_SCHED;
            PG8_LDA(At, 1, 1); PG8_STAGE(PG8_SB(1, 0), b3, voffB); PG8_STAGE(PG8_SB(1, 1), b3 + hstep, voffB); PG8_STAGE(PG8_SA(1, 0), a3, voffA);
            PG8_WAIT_V(8); PG8_WAIT_L(0); PG8_BAR; PG8_MMA(1, 0, At, B0); PG8_MMA(1, 1, At, B1); PG8_BAR; PG8_SCHED;
            } else {
            PG8_LDB(B0, 0, 0); PG8_SCHED; PG8_LDA(At, 0, 0); PG8_STAGE(PG8_SA(1, 1), a1 + hstep, voffA);
            PG8_WAIT_L(8); PG8_BAR; PG8_WAIT_L(0); PG8_MMA(0, 0, At, B0); PG8_BAR; PG8_SCHED;
            PG8_LDB(B1, 0, 1); PG8_STAGE(PG8_SB(0, 0), b2, voffB);
            PG8_BAR; PG8_WAIT_L(0); PG8_MMA(0, 1, At, B1); PG8_BAR;
            PG8_LDA(At, 0, 1); PG8_STAGE(PG8_SA(0, 0), a2, voffA);
            PG8_BAR; PG8_WAIT_L(0); PG8_MMA(1, 0, At, B0); PG8_BAR; PG8_SCHED;
            PG8_STAGE(PG8_SB(0, 1), b2 + hstep, voffB);
            PG8_WAIT_V(6); PG8_BAR; PG8_MMA(1, 1, At, B1); PG8_BAR;
            PG8_LDB(B0, 1, 0); PG8_SCHED; PG8_LDA(At, 1, 0); PG8_STAGE(PG8_SA(0, 1), a2 + hstep, voffA);
            PG8_WAIT_L(8); PG8_BAR; PG8_WAIT_L(0); PG8_MMA(0, 0, At, B0); PG8_BAR; PG8_SCHED;
            PG8_LDB(B1, 1, 1); PG8_STAGE(PG8_SB(1, 0), b3, voffB);
            PG8_BAR; PG8_WAIT_L(0); PG8_MMA(0, 1, At, B1); PG8_BAR;
            PG8_LDA(At, 1, 1); PG8_STAGE(PG8_SA(1, 0), a3, voffA);
            PG8_BAR; PG8_WAIT_L(0); PG8_MMA(1, 0, At, B0); PG8_BAR; PG8_SCHED;
            PG8_STAGE(PG8_SB(1, 1), b3 + hstep, voffB);
            PG8_WAIT_V(6); PG8_BAR; PG8_MMA(1, 1, At, B1); PG8_BAR;
            }
        }
        if constexpr (ALIGN_EPI) { if (wr == 0) PG8_BAR; }
        if constexpr (!Epi::AFTER_DRAIN) { E(acc, cur, wr, wc, fr, fq); S.done(cur); }
        if (!has_next) break;
#pragma unroll
        for (int a = 0; a < 2; ++a)
#pragma unroll
            for (int b = 0; b < 2; ++b)
#pragma unroll
                for (int m = 0; m < 4; ++m)
#pragma unroll
                    for (int n = 0; n < 2; ++n) acc[a][b][m][n] = (f32x4){0.f, 0.f, 0.f, 0.f};
        cur = nxt; cA = nA; cB = nB; ++ui;
        if constexpr (Epi::CHAIN) { cA2 = (const char*)g.A + (size_t)cur.am2 * tstep; cB2 = (const char*)g.Bt + (size_t)cur.bn2 * tstep; }
        if constexpr (ALIGN_EPI) { if (wr == 1) PG8_BAR; }
    }
    PG8_WAIT_V(0);
    if constexpr (!ALIGN_EPI) { if (wr == 0) PG8_BAR; }
    PG8_BAR;
    if constexpr (Epi::AFTER_DRAIN) { E.fused(acc, cur, wr, wc, fr, fq, lds, wid, lane); S.done(cur); }
#undef PG8_SA
#undef PG8_SB
#undef PG8_STAGE
#undef PG8_LDA
#undef PG8_LDB
#undef PG8_MMA
#undef PG8_WAIT_V
#undef PG8_WAIT_L
#undef PG8_BAR
#undef PG8_SCHED
#undef PG8_TA
#undef PG8_TB
}
}
#define GAS __attribute__((address_space(1)))
#define LAS __attribute__((address_space(3)))
typedef unsigned short bf16;
typedef unsigned v4u __attribute__((ext_vector_type(4)));
typedef unsigned v2u __attribute__((ext_vector_type(2)));
typedef float f32x4 __attribute__((ext_vector_type(4)));
typedef float f32x2 __attribute__((ext_vector_type(2)));
typedef short bf16x8 __attribute__((ext_vector_type(8)));
typedef short bf16x4 __attribute__((ext_vector_type(4)));
typedef GAS unsigned gu32;
#define RLX_AGENT __ATOMIC_RELAXED, __HIP_MEMORY_SCOPE_AGENT
#define LDS_WAIT() asm volatile("s_waitcnt lgkmcnt(0)" ::: "memory")
#define VM_WAIT() asm volatile("s_waitcnt vmcnt(0)" ::: "memory")

constexpr int NWAVES = 8, NTHR = 512;
constexpr int D = 1024, SEQ = 8192, NB = 2, MP = NB * SEQ, MS = 32, MT = 16640, NTILE_M = MT / 256, MREAL = MP + MS;
constexpr int H_A = 4, DK = 128, DV = 128, CQKV = 1536, CHUNK = 64, NCHUNK = SEQ / CHUNK;
constexpr int H_B = 8, G_B = 2, DH = 64, KVW = 256;
constexpr int NCMP = 511, NSLC = 128, NSEL = 16, WINDOW = 512;
constexpr int DFF = 2816, NEXP = 8;
constexpr int NIN = 5408, NINP = 5632;
constexpr int PAST = 8192, PAGE = 128, NPAGES = 64, NPOOL = 2560;
constexpr float ALPHA = 1.4142135623730951f;
constexpr float LN_EPS = 1e-5f;
constexpr int PC_QKV = 0, PC_Z = 1536, PC_QB = 2048, PC_KVC = 2560, PC_KVS = 2816, PC_KVW = 3072, PC_GM = 3328, PC_SM = 5376;

constexpr size_t O_YP = 0, O_YS = O_YP + (size_t)MP * D, O_DELTA_P = O_YS + (size_t)MS * D, O_CONV_P = O_DELTA_P + 2ull * 2 * 4 * 128 * 128,
    O_CMP_P = O_CONV_P + 2ull * 2 * 3 * 1536, O_SLC_P = O_CMP_P + 2ull * 2 * 8192 * 256, O_WIN_P = O_SLC_P + 2ull * 2 * 8192 * 256,
    O_DELTA_S = O_WIN_P + 2ull * 2 * 512 * 256, O_CONV_S = O_DELTA_S + 2ull * 32 * 4 * 128 * 128, O_CMP_S = O_CONV_S + 2ull * 32 * 3 * 1536,
    O_SLC_S = O_CMP_S + 2ull * 32 * 256, O_WIN_S = O_SLC_S + 2ull * 32 * 256, O_END = O_WIN_S + 2ull * 32 * 512 * 256;

enum { I_XP = 0, I_XS, I_SDELTA, I_SCONV, I_CCMP, I_CSLC, I_SWIN, I_PT, I_CP, I_CS, I_WADA, I_BADA, I_WIN, I_CONVW, I_ALOG, I_DTB, I_NORMW,
       I_CPOS, I_CW1, I_CW2, I_WUPA, I_WUPB, I_WOUT, I_LNG, I_LNB, I_FGU, I_FDN, I_MR, I_MGU, I_MDN, N_INPUTS };

constexpr size_t MiB = 1u << 20;
constexpr size_t WS_CTL = 0, WS_MOD = 1 * MiB, ZERO_BYTES = 4 * MiB;
constexpr size_t WS_WIN_T = 4 * MiB, WS_WUP_T = 26 * MiB, WS_WOUT_T = 30 * MiB, WS_WGU_T = 34 * MiB, WS_WDN_T = 45 * MiB, WS_MGU_T = 51 * MiB, WS_MDN_T = 139 * MiB, WS_CW1_T = 183 * MiB;
constexpr size_t WS_XN = 192 * MiB, WS_P = 225 * MiB, WS_SC = 404 * MiB, WS_XA = 407 * MiB, WS_XB = 472 * MiB, WS_Y = 537 * MiB, WS_OAB = 674 * MiB, WS_U = 707 * MiB,
    WS_ACT = 740 * MiB, WS_APERM = 929 * MiB, WS_MOE = 998 * MiB;
constexpr size_t WS_GDN = 1000 * MiB, WS_NSA = 1110 * MiB, WS_SMP = 1150 * MiB, WS_END = 1560 * MiB;
constexpr int CW_TMO = 0, CW_BAR = 4096;
constexpr int MODROWS = 34, MODW = 6144;

constexpr int RING_OFF = 0, RING_BYTES = 131072;
constexpr int LDSCTL_OFF = RING_BYTES, MISC_OFF = LDSCTL_OFF + 320;
constexpr int LDS_BYTES = 147456;

__device__ __forceinline__ unsigned f2bf(float f) { unsigned u = __builtin_bit_cast(unsigned, f); return (u + 0x7fffu + ((u >> 16) & 1u)) >> 16; }
__device__ __forceinline__ unsigned pk2(float lo, float hi) { return f2bf(lo) | (f2bf(hi) << 16); }
__device__ __forceinline__ float bf2f(unsigned short b) { return __builtin_bit_cast(float, (unsigned)b << 16); }
__device__ __forceinline__ float bflo(unsigned w) { return __builtin_bit_cast(float, w << 16); }
__device__ __forceinline__ float bfhi(unsigned w) { return __builtin_bit_cast(float, w & 0xffff0000u); }
__device__ __forceinline__ float add1(float e) { float one = 1.f; asm volatile("" : "+v"(one)); return e + one; }
__device__ __forceinline__ float sigmoidf_(float x) { return __builtin_amdgcn_rcpf(add1(__expf(-x))); }
__device__ __forceinline__ float siluf_(float x) { return x * __builtin_amdgcn_rcpf(add1(__expf(-x))); }
__device__ __forceinline__ float softplusf_(float x) { const float e = __expf(x); return x > 20.f ? x : (e < 0.01f ? e * (1.f - e * (0.5f - e * 0.33333334f)) : __logf(1.f + e)); }
__device__ __forceinline__ int my_lane() { int l = (int)__builtin_amdgcn_mbcnt_hi(~0u, __builtin_amdgcn_mbcnt_lo(~0u, 0u)); asm volatile("" : "+v"(l)); return l; }
__device__ __forceinline__ float bperm(float v, int srclane) { return __builtin_bit_cast(float, __builtin_amdgcn_ds_bpermute(srclane << 2, __builtin_bit_cast(int, v))); }
template <int O> __device__ __forceinline__ float shx(float v) { return bperm(v, my_lane() ^ O); }
__device__ __forceinline__ float wave_sum(float v) { v += shx<1>(v); v += shx<2>(v); v += shx<4>(v); v += shx<8>(v); v += shx<16>(v); v += shx<32>(v); return v; }
__device__ __forceinline__ float wave_max(float v) { v = fmaxf(v, shx<1>(v)); v = fmaxf(v, shx<2>(v)); v = fmaxf(v, shx<4>(v)); v = fmaxf(v, shx<8>(v)); v = fmaxf(v, shx<16>(v)); v = fmaxf(v, shx<32>(v)); return v; }
#define XB_TMO      128
#define XB_XCNT(j)  (256  + 64 * (j))
#define XB_XSUB(j)  (1280 + 64 * (j))
#define XB_XGEN(j)  (2304 + 64 * (j))
#define XB_TOP      3328
#define XB_TOPGEN   3392
#define XCD_BAR_WORDS 3456
#define XB_SPIN_CAP (1u << 18)

__device__ __forceinline__ unsigned xb_ld(unsigned* p)              { return __hip_atomic_load(p, __ATOMIC_RELAXED, __HIP_MEMORY_SCOPE_AGENT); }
__device__ __forceinline__ unsigned xb_add(unsigned* p, unsigned v) { return __hip_atomic_fetch_add(p, v, __ATOMIC_RELAXED, __HIP_MEMORY_SCOPE_AGENT); }
__device__ __forceinline__ unsigned xb_xcc_id() { return (unsigned)__builtin_amdgcn_s_getreg((3 << 11) | 20) & 0xFu; }
#define XB_SPIN(cond, bar) do { unsigned _sp = 0; while (cond) { __builtin_amdgcn_s_sleep(1); \
    if ((++_sp & 255u) == 0u) { if (xb_ld(&(bar)[XB_TMO])) break; if (_sp > XB_SPIN_CAP) { atomicAdd(&(bar)[XB_TMO], 1u); break; } } } } while (0)

struct XcdBarrier {
    unsigned* bar; unsigned x;
    volatile LAS unsigned* st;
};

__device__ __forceinline__ XcdBarrier xcd_barrier_post(unsigned* bar, volatile LAS unsigned* st) {
    XcdBarrier b; b.bar = bar; b.x = xb_xcc_id(); b.st = st;
    if (threadIdx.x == 0) (void)xb_add(&bar[XB_XCNT(b.x)], 1u);
    return b;
}
__device__ __forceinline__ void xcd_barrier_complete(unsigned* bar, unsigned x, unsigned& nloc, unsigned& nx) {
    const unsigned G = gridDim.x * gridDim.y * gridDim.z;
    unsigned sum, cnt, mine, sp = 0u;
    for (;;) {
        sum = 0u; cnt = 0u; mine = 0u;
#pragma unroll
        for (unsigned j = 0; j < 16; ++j) { const unsigned c = xb_ld(&bar[XB_XCNT(j)]); sum += c; cnt += (c > 0u) ? 1u : 0u; mine = (j == x) ? c : mine; }
        if (sum == G) break;
        __builtin_amdgcn_s_sleep(1);
        if ((++sp & 255u) == 0u) { if (xb_ld(&bar[XB_TMO])) break; if (sp > XB_SPIN_CAP) { atomicAdd(&bar[XB_TMO], 1u); break; } }
    }
    nloc = mine > 0u ? mine : 1u; nx = cnt > 0u ? cnt : 1u;
}

__device__ __forceinline__ void xcd_barrier(const XcdBarrier& b) {
    asm volatile("s_waitcnt vmcnt(0)" ::: "memory");
    __syncthreads();
    if (threadIdx.x == 0) {
        unsigned* bar = b.bar;
        __builtin_amdgcn_s_waitcnt(0);
        unsigned nloc = b.st[0], nx = b.st[1];
        if (nloc == 0u) { xcd_barrier_complete(bar, b.x, nloc, nx); b.st[0] = nloc; b.st[1] = nx; }
        const unsigned old = xb_add(&bar[XB_XSUB(b.x)], 1u);
        const unsigned gen = old / nloc;
        if (old + 1u == (gen + 1u) * nloc) {
            __builtin_amdgcn_fence(__ATOMIC_RELEASE, "agent");
            asm volatile("s_waitcnt vmcnt(0)" ::: "memory");
            const unsigned og = xb_add(&bar[XB_TOP], 1u);
            const unsigned tg = og / nx;
            if (og + 1u == (tg + 1u) * nx) xb_add(&bar[XB_TOPGEN], 1u);
            else XB_SPIN(xb_ld(&bar[XB_TOPGEN]) == tg, bar);
            __builtin_amdgcn_fence(__ATOMIC_ACQUIRE, "agent");
            xb_add(&bar[XB_XGEN(b.x)], 1u);
            asm volatile("s_waitcnt vmcnt(0)" ::: "memory");
        } else {
            XB_SPIN(xb_ld(&bar[XB_XGEN(b.x)]) == gen, bar);
            __builtin_amdgcn_fence(__ATOMIC_ACQUIRE, "agent");
            asm volatile("s_waitcnt vmcnt(0)" ::: "memory");
        }
    }
    __syncthreads();
}

struct Args { const void* in[30]; float* out; unsigned char* ws; int ph_lo, ph_hi; };
struct Frame {
    LAS unsigned char* lds;
    volatile LAS unsigned* MISC;
    gu32* ctl;
    int tid, lane, wave, G, bid;
};
__device__ __forceinline__ const void* ld_in(const Args& a, int i) { int z = 0; asm volatile("" : "+s"(z)); return a.in[i + z]; }
#define INP(T, i) ((const T*)ld_in(a, i))
__device__ __forceinline__ unsigned char* ws_base(const Args& a) { unsigned char* p = a.ws; asm volatile("" : "+s"(p)); return p; }
#define WSP(T, off) ((T*)(ws_base(a) + (off)))

constexpr int PH_PRO = 0, NPL = 14, NPH = 1 + 2 * NPL;
constexpr int LP_LNMOD = 0, LP_INPROJ = 1, LP_PREP = 2, LP_CMP1 = 3, LP_CMP2 = 4, LP_MIX = 5, LP_ONORM = 6, LP_UP = 7, LP_OUT = 8, LP_LN1 = 9, LP_MOEG = 10, LP_FFN1 = 11, LP_FFN2 = 12, LP_LN2 = 13;

template <int MAP> __device__ __forceinline__ int srccol(int n) {
    if (MAP == 0) return n;
    if (MAP == 1) {
        if (n < 2048) return n;
        if (n < 2560) return 2056 + (n - 2048);
        if (n < 3328) return 2568 + (n - 2560);
        if (n < 5376) { const int w = n - 3328; return 3360 + ((w >> 7) & 1) * 1024 + 128 * (w >> 8) + (w & 127); }
        if (n < 5384) return 2048 + (n - 5376);
        if (n < 5408) return 3336 + (n - 5384);
        return -1;
    }
    { const int pn = n >> 8, w = n & 255; return (w >> 7) * DFF + 128 * pn + (w & 127); }
}
template <int MAP> __device__ __forceinline__ void transpose_item(const float* W, int K, int Nsrc, bf16* WT, LAS float* scr, int kb, int nb, int lane) {
    const int k0 = 64 * kb, n0 = 32 * nb, sc = srccol<MAP>(n0 + (lane & 31));
#pragma unroll 8
    for (int i = 0; i < 32; ++i) { const int kk = 2 * i + (lane >> 5); scr[kk * 33 + (lane & 31)] = sc >= 0 ? W[(size_t)(k0 + kk) * Nsrc + sc] : 0.f; }
    LDS_WAIT(); asm volatile("" ::: "memory");
    const int c = lane & 7;
#pragma unroll
    for (int j = 0; j < 4; ++j) { const int n = (lane >> 3) + 8 * j; const LAS float* s = scr + (8 * c) * 33 + n;
        v4u o; o.x = pk2(s[0 * 33], s[1 * 33]); o.y = pk2(s[2 * 33], s[3 * 33]); o.z = pk2(s[4 * 33], s[5 * 33]); o.w = pk2(s[6 * 33], s[7 * 33]);
        *(GAS v4u*)(WT + (size_t)(n0 + n) * K + k0 + 8 * c) = o; }
    LDS_WAIT(); asm volatile("" ::: "memory");
}
template <int MAP> __device__ __forceinline__ void convert_matrix(Frame& F, const float* W, int K, int Nsrc, bf16* WT, int Ndest, int rot) {
    LAS float* scr = (LAS float*)(F.lds + RING_OFF + F.wave * 16384);
    const int NGW = F.G * NWAVES, gw = (F.bid * NWAVES + F.wave + rot) % NGW, nnb = Ndest / 32, nitems = (K / 64) * nnb;
    for (int it = gw; it < nitems; it += NGW) transpose_item<MAP>(W, K, Nsrc, WT, scr, it / nnb, it % nnb, F.lane);
}
__device__ __forceinline__ void mod_gemv(Frame& F, const Args& a) {
    LAS float* s = (LAS float*)(F.lds + RING_OFF);
    float* MOD = WSP(float, WS_MOD);
    for (int item = F.bid; item < 48; item += F.G) {
        const int l = item / 24, rg = (item % 24) / 12, cb = item % 12;
        for (int idx = F.tid; idx < 17 * 1024; idx += NTHR) { const int r = rg * 17 + (idx >> 10), k = idx & 1023;
            const float c = r < 2 ? INP(float, I_CP)[r * D + k] : INP(float, I_CS)[(r - 2) * D + k]; s[idx] = siluf_(c); }
        __syncthreads();
        const int col = cb * 512 + F.wave * 64 + F.lane;
        const float* W = INP(float, I_WADA) + (size_t)l * D * MODW + col;
        float acc[17];
#pragma unroll
        for (int r = 0; r < 17; ++r) acc[r] = 0.f;
        for (int k4 = 0; k4 < 256; ++k4) {
            const float w0 = W[(size_t)(4 * k4 + 0) * MODW], w1 = W[(size_t)(4 * k4 + 1) * MODW], w2 = W[(size_t)(4 * k4 + 2) * MODW], w3 = W[(size_t)(4 * k4 + 3) * MODW];
#pragma unroll
            for (int r = 0; r < 17; ++r) { const f32x4 f = *(const LAS f32x4*)(s + r * 1024 + 4 * k4); acc[r] += f.x * w0 + f.y * w1 + f.z * w2 + f.w * w3; }
        }
        const float bias = INP(float, I_BADA)[l * MODW + col];
#pragma unroll
        for (int r = 0; r < 17; ++r) MOD[(size_t)(l * MODROWS + rg * 17 + r) * MODW + col] = acc[r] + bias;
        __syncthreads();
    }
}
__device__ __forceinline__ void copy_f4(Frame& F, const float* src, float* dst, size_t n4) {
    const size_t stride = (size_t)F.G * NTHR;
    for (size_t i = (size_t)F.bid * NTHR + F.tid; i < n4; i += stride) ((GAS f32x4*)dst)[i] = ((const GAS f32x4*)src)[i];
}
__device__ __forceinline__ void nsa_prologue(Frame& F, const Args& a);
__device__ __forceinline__ void p0_prologue(Frame& F, const Args& a) {
    mod_gemv(F, a);
    nsa_prologue(F, a);
    for (int lb = 0; lb < 64; ++lb) {
        copy_f4(F, INP(float, I_SWIN) + ((size_t)lb * 512 + 1) * 256, a.out + O_WIN_S + (size_t)lb * 512 * 256, 511 * 256 / 4);
        copy_f4(F, INP(float, I_SCONV) + ((size_t)lb * 3 + 1) * 1536, a.out + O_CONV_S + (size_t)lb * 3 * 1536, 2 * 1536 / 4);
    }
    int rot = 0;
    for (int l = 0; l < 2; ++l) { convert_matrix<1>(F, INP(float, I_WIN) + (size_t)l * D * NIN, D, NIN, WSP(bf16, WS_WIN_T) + (size_t)l * NINP * D, NINP, rot); rot += 2816; }
    for (int l = 0; l < 2; ++l) {
        convert_matrix<0>(F, INP(float, I_WUPA) + (size_t)l * 512 * D, 512, D, WSP(bf16, WS_WUP_T) + (size_t)l * 2048 * 512, D, rot); rot += 256;
        convert_matrix<0>(F, INP(float, I_WUPB) + (size_t)l * 512 * D, 512, D, WSP(bf16, WS_WUP_T) + (size_t)l * 2048 * 512 + (size_t)1024 * 512, D, rot); rot += 256;
        convert_matrix<0>(F, INP(float, I_WOUT) + (size_t)l * D * D, D, D, WSP(bf16, WS_WOUT_T) + (size_t)l * D * D, D, rot); rot += 512;
    }
    convert_matrix<2>(F, INP(float, I_FGU), D, 2 * DFF, WSP(bf16, WS_WGU_T), 2 * DFF, rot); rot += 2816;
    convert_matrix<0>(F, INP(float, I_FDN), DFF, D, WSP(bf16, WS_WDN_T), D, rot); rot += 1408;
    for (int e = 0; e < NEXP; ++e) {
        convert_matrix<2>(F, INP(float, I_MGU) + (size_t)e * D * 2 * DFF, D, 2 * DFF, WSP(bf16, WS_MGU_T) + (size_t)e * 2 * DFF * D, 2 * DFF, rot); rot += 2816;
        convert_matrix<0>(F, INP(float, I_MDN) + (size_t)e * DFF * D, DFF, D, WSP(bf16, WS_MDN_T) + (size_t)e * D * DFF, D, rot); rot += 1408;
    }
    for (int q = 0; q < 8; ++q) {
        convert_matrix<0>(F, INP(float, I_CW1) + ((size_t)(q >> 1) * 2048 + (size_t)(q & 1) * 1024) * 256, 1024, 256, WSP(bf16, WS_CW1_T) + ((size_t)(q >> 1) * 512 + (size_t)(q & 1) * 256) * 1024, 256, rot); rot += 128;
    }
}

__device__ __forceinline__ const float* mod_row(const Args& a, int l, int row) { return WSP(float, WS_MOD) + (size_t)(l * MODROWS + (row < MP ? (row >> 13) : 2 + (row - MP))) * MODW; }
__device__ __forceinline__ const float* x_in_row(const Args& a, int row) { return row < MP ? INP(float, I_XP) + (size_t)row * D : INP(float, I_XS) + (size_t)(row - MP) * D; }
__device__ __forceinline__ void row_stats(const f32x4 (&v)[4], float& mean, float& rstd) {
    float s = 0.f;
#pragma unroll
    for (int j = 0; j < 4; ++j) s += (v[j].x + v[j].y) + (v[j].z + v[j].w);
    mean = wave_sum(s) * (1.f / D); float q = 0.f;
#pragma unroll
    for (int j = 0; j < 4; ++j) { const f32x4 d = v[j] - mean; q += (d.x * d.x + d.y * d.y) + (d.z * d.z + d.w * d.w); }
    rstd = 1.f / sqrtf(wave_sum(q) * (1.f / D) + LN_EPS);
}
__device__ __forceinline__ void mod_ln_store(const f32x4 (&v)[4], const float* sh, const float* sc, bf16* orow, int lane) {
    float mean, rstd; row_stats(v, mean, rstd);
#pragma unroll
    for (int j = 0; j < 4; ++j) { const int c = 256 * j + 4 * lane; const f32x4 s1 = *(const GAS f32x4*)(sc + c), s0 = *(const GAS f32x4*)(sh + c);
        const f32x4 xh = (v[j] - mean) * rstd; const f32x4 h = xh * s1 + (xh + s0); v2u o; o.x = pk2(h.x, h.y); o.y = pk2(h.z, h.w); *(GAS v2u*)(orow + c) = o; }
}
__device__ __forceinline__ void p_lnmod0(Frame& F, const Args& a) {
    const int gw = F.bid * NWAVES + F.wave, NGW = F.G * NWAVES; bf16* XN = WSP(bf16, WS_XN);
    for (int row = gw; row < MT; row += NGW) {
        if (row >= MREAL) { for (int j = 0; j < 4; ++j) *(GAS v2u*)(XN + (size_t)row * D + 256 * j + 4 * F.lane) = (v2u){0u, 0u}; continue; }
        const float* xr = x_in_row(a, row); f32x4 v[4];
#pragma unroll
        for (int j = 0; j < 4; ++j) v[j] = *(const GAS f32x4*)(xr + 256 * j + 4 * F.lane);
        const float* mr = mod_row(a, 0, row);
        mod_ln_store(v, mr, mr + D, XN + (size_t)row * D, F.lane);
    }
}
constexpr size_t MOE_META = WS_MOE, MOE_SLOT = WS_MOE + 64 * 1024, MOE_EPOS = WS_MOE + 256 * 1024, MOE_PROB = WS_MOE + 1 * MiB;
constexpr int CW_MOECNT = 2048;
template <int YMODE, bool ROUTE> __device__ __forceinline__ void p_lnpass(Frame& F, const Args& a, int l, int which, const float* xsrc, float* xdst, const float* Y) {
    const int gw = F.bid * NWAVES + F.wave, NGW = F.G * NWAVES; bf16* XN = WSP(bf16, WS_XN);
    const float* lg = INP(float, I_LNG) + (size_t)(l * 2 + which) * D; const float* lb = INP(float, I_LNB) + (size_t)(l * 2 + which) * D;
    const int* mslot = WSP(int, MOE_SLOT); float* mprob = WSP(float, MOE_PROB);
    for (int row = gw; row < MREAL; row += NGW) {
        const float* xr = xsrc ? xsrc + (size_t)row * D : x_in_row(a, row);
        const float* mr = mod_row(a, l, row); const float* gate = mr + (which ? 5 : 2) * D;
        f32x4 v[4];
#pragma unroll
        for (int j = 0; j < 4; ++j) { const int c = 256 * j + 4 * F.lane; f32x4 x = *(const GAS f32x4*)(xr + c) * ALPHA;
            if (YMODE == 1) { x += *(const GAS f32x4*)(gate + c) * *(const GAS f32x4*)(Y + (size_t)row * D + c); }
            if (YMODE == 2) { const int s0 = mslot[2 * row], s1 = mslot[2 * row + 1]; const float p0 = mprob[2 * row], p1 = mprob[2 * row + 1];
                x += *(const GAS f32x4*)(gate + c) * (*(const GAS f32x4*)(Y + (size_t)s0 * D + c) * p0 + *(const GAS f32x4*)(Y + (size_t)s1 * D + c) * p1); }
            v[j] = x; }
        float mean, rstd; row_stats(v, mean, rstd);
        float* xo = xdst ? xdst + (size_t)row * D : (row < MP ? a.out + O_YP + (size_t)row * D : a.out + O_YS + (size_t)(row - MP) * D);
#pragma unroll
        for (int j = 0; j < 4; ++j) { const int c = 256 * j + 4 * F.lane; v[j] = (v[j] - mean) * rstd * *(const GAS f32x4*)(lg + c) + *(const GAS f32x4*)(lb + c); *(GAS f32x4*)(xo + c) = v[j]; }
        const float* sh = nullptr; const float* sc = nullptr;
        if (which == 0) { sh = mr + 3 * D; sc = mr + 4 * D; } else if (l == 0) { const float* mr2 = mod_row(a, 1, row); sh = mr2; sc = mr2 + D; }
        if (sh) {
            row_stats(v, mean, rstd);
#pragma unroll
            for (int j = 0; j < 4; ++j) { const int c = 256 * j + 4 * F.lane; { const f32x4 xh = (v[j] - mean) * rstd; v[j] = xh * *(const GAS f32x4*)(sc + c) + (xh + *(const GAS f32x4*)(sh + c)); }
                v2u o; o.x = pk2(v[j].x, v[j].y); o.y = pk2(v[j].z, v[j].w); *(GAS v2u*)(XN + (size_t)row * D + c) = o; }
            if (ROUTE) {
                const float* Wr = INP(float, I_MR); float lgt[8];
#pragma unroll
                for (int e = 0; e < 8; ++e) lgt[e] = 0.f;
#pragma unroll
                for (int j = 0; j < 4; ++j)
#pragma unroll
                    for (int q = 0; q < 4; ++q) { const int c = 256 * j + 4 * F.lane + q; const f32x4 w0 = *(const GAS f32x4*)(Wr + (size_t)c * 8), w1 = *(const GAS f32x4*)(Wr + (size_t)c * 8 + 4); const float hv = v[j][q];
                        lgt[0] += hv * w0.x; lgt[1] += hv * w0.y; lgt[2] += hv * w0.z; lgt[3] += hv * w0.w; lgt[4] += hv * w1.x; lgt[5] += hv * w1.y; lgt[6] += hv * w1.z; lgt[7] += hv * w1.w; }
#pragma unroll
                for (int e = 0; e < 8; ++e) lgt[e] = wave_sum(lgt[e]);
                int e0 = 0; float l0 = lgt[0];
#pragma unroll
                for (int e = 1; e < 8; ++e) if (lgt[e] > l0) { l0 = lgt[e]; e0 = e; }
                int e1 = -1; float l1 = -3.0e38f;
#pragma unroll
                for (int e = 0; e < 8; ++e) if (e != e0 && lgt[e] > l1) { l1 = lgt[e]; e1 = e; }
                const float p0 = 1.f / (1.f + __expf(l1 - l0));
                if (F.lane == 0) { int* ep = WSP(int, MOE_EPOS) + 4 * row;
                    ep[0] = e0; ep[1] = e1; ep[2] = (int)atomicAdd((unsigned*)(F.ctl + CW_MOECNT + 64 * e0), 1u); ep[3] = (int)atomicAdd((unsigned*)(F.ctl + CW_MOECNT + 64 * e1), 1u);
                    mprob[2 * row] = p0; mprob[2 * row + 1] = 1.f - p0; }
            }
        }
    }
}
__device__ __forceinline__ void p_moe_gather(Frame& F, const Args& a) {
    int off[9]; off[0] = 0;
#pragma unroll
    for (int e = 0; e < 8; ++e) { const int c = (int)__hip_atomic_load(F.ctl + CW_MOECNT + 64 * e, RLX_AGENT); off[e + 1] = off[e] + ((c + 255) & ~255); }
    int* meta = WSP(int, MOE_META);
    if (F.bid == 0) { if (F.tid == 0) meta[0] = off[8] >> 8;
        for (int t = F.tid; t < (off[8] >> 8); t += NTHR) { int e = 0;
#pragma unroll
            for (int q = 1; q < 8; ++q) if (t * 256 >= off[q]) e = q;
            meta[16 + t] = e; } }
    const int gw = F.bid * NWAVES + F.wave, NGW = F.G * NWAVES; const bf16* XN = WSP(bf16, WS_XN); bf16* AP = WSP(bf16, WS_APERM); int* mslot = WSP(int, MOE_SLOT);
    for (int row = gw; row < MREAL; row += NGW) {
        const int* ep = WSP(int, MOE_EPOS) + 4 * row; const int e0 = ep[0], e1 = ep[1];
        int o0 = 0, o1 = 0;
#pragma unroll
        for (int q = 0; q < 8; ++q) { if (q == e0) o0 = off[q]; if (q == e1) o1 = off[q]; }
        const int s0 = o0 + ep[2], s1 = o1 + ep[3];
        if (F.lane == 0) { mslot[2 * row] = s0; mslot[2 * row + 1] = s1; }
        const v4u x0 = *(const GAS v4u*)(XN + (size_t)row * D + 8 * F.lane), x1 = *(const GAS v4u*)(XN + (size_t)row * D + 512 + 8 * F.lane);
        *(GAS v4u*)(AP + (size_t)s0 * D + 8 * F.lane) = x0; *(GAS v4u*)(AP + (size_t)s0 * D + 512 + 8 * F.lane) = x1;
        *(GAS v4u*)(AP + (size_t)s1 * D + 8 * F.lane) = x0; *(GAS v4u*)(AP + (size_t)s1 * D + 512 + 8 * F.lane) = x1;
    }
}

struct EpiIn {
    static constexpr bool PERM = true, AFTER_DRAIN = false, CHAIN = false;
    bf16* P; float* SC; float* out; int l;
    __device__ __forceinline__ void mid(const pg8::f32x4 (&)[2][2][4][2], const pg8::Unit&, int, int, int, int) const {}
    __device__ __forceinline__ void operator()(const pg8::f32x4 (&acc)[2][2][4][2], const pg8::Unit& u, int wr, int wc, int fr, int fq) const {
        asm volatile("" : "+v"(fr), "+v"(fq));
        const int pn = u.pn; const int colb = pn * 256 + wc * 32 + 8 * fq;
#pragma unroll
        for (int ai = 0; ai < 2; ++ai)
#pragma unroll
            for (int m = 0; m < 4; ++m) {
                const int row = u.pm * 256 + ai * 128 + wr * 64 + m * 16 + fr;
                if (pn >= 13 && pn <= 20) {
                    float r[8], sb[8];
#pragma unroll
                    for (int n = 0; n < 2; ++n)
#pragma unroll
                        for (int q = 0; q < 4; ++q) { const float ea = __expf(-acc[ai][0][m][n][q]), eb = __expf(-acc[ai][1][m][n][q]); sb[4 * n + q] = 1.f / (1.f + eb); r[4 * n + q] = (1.f + eb) / (1.f + ea); }
                    v4u w; w.x = pk2(r[0], r[1]); w.y = pk2(r[2], r[3]); w.z = pk2(r[4], r[5]); w.w = pk2(r[6], r[7]); *(GAS v4u*)(P + (size_t)row * NINP + colb) = w;
                    w.x = pk2(sb[0], sb[1]); w.y = pk2(sb[2], sb[3]); w.z = pk2(sb[4], sb[5]); w.w = pk2(sb[6], sb[7]); *(GAS v4u*)(P + (size_t)row * NINP + colb + 128) = w;
                    continue;
                }
#pragma unroll
                for (int bj = 0; bj < 2; ++bj) {
                    const int col = colb + bj * 128; const pg8::f32x4 v0 = acc[ai][bj][m][0], v1 = acc[ai][bj][m][1];
                    v4u w; w.x = pk2(v0[0], v0[1]); w.y = pk2(v0[2], v0[3]); w.z = pk2(v1[0], v1[1]); w.w = pk2(v1[2], v1[3]);
                    *(GAS v4u*)(P + (size_t)row * NINP + col) = w;
                    float* dst = nullptr;
                    if (pn >= 10 && pn <= 12) {
                        const int c = col - pn * 256;
                        if (pn == 12) { if (row < MP) { const int t = row & (SEQ - 1); if (t >= SEQ - WINDOW) dst = out + O_WIN_P + ((size_t)(l * 2 + (row >> 13)) * WINDOW + (t - (SEQ - WINDOW))) * KVW + c; }
                                        else if (row < MREAL) dst = out + O_WIN_S + ((size_t)(l * MS + (row - MP)) * WINDOW + (WINDOW - 1)) * KVW + c; }
                        else { const size_t op = pn == 10 ? O_CMP_P : O_SLC_P, os = pn == 10 ? O_CMP_S : O_SLC_S;
                               if (row < MP) dst = out + op + ((size_t)l * MP + row) * KVW + c; else if (row < MREAL) dst = out + os + (size_t)(l * MS + (row - MP)) * KVW + c; }
                    } else if (pn < 6) {
                        if (row < MP) { const int t = row & (SEQ - 1); if (t >= SEQ - 3) dst = out + O_CONV_P + ((size_t)(l * 2 + (row >> 13)) * 3 + (t - (SEQ - 3))) * CQKV + col; }
                        else if (row < MREAL) dst = out + O_CONV_S + ((size_t)(l * MS + (row - MP)) * 3 + 2) * CQKV + col;
                    } else if (pn == 21) {
                        if (wc == 0 && bj == 0) dst = SC + (size_t)row * 32 + 8 * fq;
                    }
                    if (dst) { *(GAS pg8::f32x4*)dst = v0; *(GAS pg8::f32x4*)(dst + 4) = v1; }
                }
            }
    }
};
constexpr size_t GDN_WN = WS_GDN, GDN_QD = WS_GDN + 16 * MiB, GDN_KDT = WS_GDN + 32 * MiB, GDN_QK = WS_GDN + 48 * MiB, GDN_UT = WS_GDN + 56 * MiB, GDN_OT = WS_GDN + 72 * MiB, GDN_GL = WS_GDN + 104 * MiB;
__device__ __forceinline__ int kperm(int k) { return (k & ~31) | (((k >> 2) & 3) << 3) | (((k >> 4) & 1) << 2) | (k & 3); }

__device__ __forceinline__ void gdn_prep(Frame& F, const Args& a, int l) {
    LAS float* kq = (LAS float*)(F.lds + RING_OFF);
    LAS float* qq = kq + 64 * 132;
    LAS float* vv = qq + 64 * 132;
    LAS float* Am = vv + 64 * 128;
    LAS float* sv = Am + 64 * 64;
    const bf16* P = WSP(bf16, WS_P); const float* SC = WSP(float, WS_SC);
    const float* cw = INP(float, I_CONVW) + (size_t)l * 4 * CQKV;
    const int tid = F.tid, lane = F.lane, wave = F.wave;
    for (int unit = F.bid; unit < 8 * NCHUNK; unit += F.G) {
        const int bh = unit >> 7, n = unit & 127, b = bh >> 2, h = bh & 3, t0 = n * CHUNK; const size_t row0 = (size_t)b * SEQ + t0;
        if (tid < 384) {
            const int part = tid >> 7, j = tid & 127;
            const int c = (part == 0 ? 1024 : part == 1 ? 512 : 0) + h * 128 + j;
            const float w0 = cw[c], w1 = cw[CQKV + c], w2 = cw[2 * CQKV + c], w3 = cw[3 * CQKV + c];
            const bf16* pc = P + row0 * NINP + PC_QKV + c;
            float xm3 = 0.f, xm2 = 0.f, xm1 = 0.f;
            if (n > 0) { xm3 = bf2f(*(pc - 3 * (ptrdiff_t)NINP)); xm2 = bf2f(*(pc - 2 * (ptrdiff_t)NINP)); xm1 = bf2f(*(pc - (ptrdiff_t)NINP)); }
            LAS float* dstp = part == 0 ? vv + j : part == 1 ? kq + j : qq + j; const int dpitch = part == 0 ? 128 : 132;
#pragma unroll 4
            for (int i = 0; i < 64; ++i) { const float x = bf2f(pc[(size_t)i * NINP]); const float y = siluf_(w0 * xm3 + w1 * xm2 + w2 * xm1 + w3 * x); xm3 = xm2; xm2 = xm1; xm1 = x;
                dstp[i * dpitch] = y; }
        } else if (tid < 448) {
            const int i = tid - 384; const float* sc = SC + (row0 + i) * 32;
            const float beta = sigmoidf_(sc[h]); const float g = -__expf(INP(float, I_ALOG)[l * 4 + h]) * softplusf_(sc[4 + h] + INP(float, I_DTB)[l * 4 + h]);
            float gc = g;
#pragma unroll
            for (int o = 1; o < 64; o <<= 1) { const float t = bperm(gc, lane - o); if (lane >= o) gc += t; }
            sv[i] = beta; sv[64 + i] = gc; sv[128 + i] = __expf(gc);
        }
        __syncthreads();
        for (int r = 0; r < 8; ++r) { const int i = wave * 8 + r;
            { const float x0 = kq[i * 132 + lane], x1 = kq[i * 132 + 64 + lane]; const float inv = 1.f / sqrtf(wave_sum(x0 * x0 + x1 * x1) + 1e-6f); kq[i * 132 + lane] = x0 * inv; kq[i * 132 + 64 + lane] = x1 * inv; }
            { const float x0 = qq[i * 132 + lane], x1 = qq[i * 132 + 64 + lane]; const float inv = 1.f / sqrtf(wave_sum(x0 * x0 + x1 * x1) + 1e-6f); qq[i * 132 + lane] = x0 * inv; qq[i * 132 + 64 + lane] = x1 * inv; } }
        __syncthreads();
        {
            const int t = tid & 255, ti = t >> 4, tj = t & 15; const bool isA = tid < 256; const LAS float* L = isA ? kq : qq;
            float acc[4][4];
#pragma unroll
            for (int x = 0; x < 4; ++x)
#pragma unroll
                for (int y = 0; y < 4; ++y) acc[x][y] = 0.f;
            if (tj <= ti) {
                for (int k4 = 0; k4 < 32; ++k4) { f32x4 ra[4], rb[4];
#pragma unroll
                    for (int x = 0; x < 4; ++x) { ra[x] = *(const LAS f32x4*)(L + (4 * ti + x) * 132 + 4 * k4); rb[x] = *(const LAS f32x4*)(kq + (4 * tj + x) * 132 + 4 * k4); }
#pragma unroll
                    for (int x = 0; x < 4; ++x)
#pragma unroll
                        for (int y = 0; y < 4; ++y) acc[x][y] += ra[x].x * rb[y].x + ra[x].y * rb[y].y + ra[x].z * rb[y].z + ra[x].w * rb[y].w; }
            }
            if (isA) {
#pragma unroll
                for (int x = 0; x < 4; ++x) { const int i = 4 * ti + x; f32x4 o;
#pragma unroll
                    for (int y = 0; y < 4; ++y) { const int j = 4 * tj + y; o[y] = (i > j) ? sv[i] * acc[x][y] * __expf(sv[64 + i] - sv[64 + j]) : 0.f; }
                    *(LAS f32x4*)(Am + i * 64 + 4 * tj) = o; }
            } else {
                bf16* QKg = WSP(bf16, GDN_QK) + (size_t)unit * 64 * 64;
#pragma unroll
                for (int x = 0; x < 4; ++x) { const int i = 4 * ti + x; float o[4];
#pragma unroll
                    for (int y = 0; y < 4; ++y) { const int j = 4 * tj + y; o[y] = (i >= j) ? acc[x][y] * __expf(sv[64 + i] - sv[64 + j]) * 0.08838834764831845f : 0.f; }
                    v2u w; w.x = pk2(o[0], o[1]); w.y = pk2(o[2], o[3]); *(GAS v2u*)(QKg + i * 64 + kperm(4 * tj)) = w; }
            }
        }
        __syncthreads();
        if (tid < 256) {
            float x[64]; int zv; asm volatile("v_mov_b32 %0, 0" : "=v"(zv));
            const LAS float* svz = sv + zv; const LAS float* Amz = Am + zv;
            if (tid < 128) {
#pragma unroll
                for (int i = 0; i < 64; ++i) x[i] = vv[i * 128 + tid] * svz[i];
            } else {
#pragma unroll
                for (int i = 0; i < 64; ++i) x[i] = kq[i * 132 + (tid - 128)] * svz[i] * svz[128 + i];
            }
#pragma unroll
            for (int i = 1; i < 64; ++i) { float s = x[i];
#pragma unroll
                for (int j4 = 0; j4 < (i + 3) / 4; ++j4) { const f32x4 av = *(const LAS f32x4*)(Amz + i * 64 + 4 * j4); s -= av.x * x[4 * j4] + av.y * x[4 * j4 + 1] + av.z * x[4 * j4 + 2] + av.w * x[4 * j4 + 3]; }
                x[i] = s; }
            if (tid < 128) { bf16* UT = WSP(bf16, GDN_UT) + ((size_t)unit * 128 + tid) * 64;
#pragma unroll
                for (int i8 = 0; i8 < 8; ++i8) { v4u w; w.x = pk2(x[8 * i8], x[8 * i8 + 1]); w.y = pk2(x[8 * i8 + 2], x[8 * i8 + 3]); w.z = pk2(x[8 * i8 + 4], x[8 * i8 + 5]); w.w = pk2(x[8 * i8 + 6], x[8 * i8 + 7]); *(GAS v4u*)(UT + 8 * i8) = w; }
            } else { bf16* WN = WSP(bf16, GDN_WN) + (size_t)unit * 64 * 128 + kperm(tid - 128);
#pragma unroll
                for (int i = 0; i < 64; ++i) WN[i * 128] = (bf16)f2bf(-x[i]);
            }
        } else {
            const int t = tid - 256; const float gl = sv[64 + 63];
            bf16* QD = WSP(bf16, GDN_QD) + (size_t)unit * 64 * 128; bf16* KDT = WSP(bf16, GDN_KDT) + (size_t)unit * 128 * 64;
            for (int it = t; it < 64 * 32; it += 256) { const int i = it >> 5, k4 = it & 31; const f32x4 q = *(const LAS f32x4*)(qq + i * 132 + 4 * k4) * (sv[128 + i] * 0.08838834764831845f);
                v2u w; w.x = pk2(q.x, q.y); w.y = pk2(q.z, q.w); *(GAS v2u*)(QD + i * 128 + kperm(4 * k4)) = w; }
            for (int it = t; it < 128 * 16; it += 256) { const int k = it & 127, c4 = it >> 7; float o[4];
#pragma unroll
                for (int y = 0; y < 4; ++y) { const int c = 4 * c4 + y; o[y] = kq[c * 132 + k] * __expf(gl - sv[64 + c]); }
                v2u w; w.x = pk2(o[0], o[1]); w.y = pk2(o[2], o[3]); *(GAS v2u*)(KDT + k * 64 + kperm(4 * c4)) = w; }
            if (t == 0) WSP(float, GDN_GL)[unit] = __expf(gl);
        }
        __syncthreads();
    }
}

__device__ __forceinline__ void gdn_scan(Frame& F, const Args& a, int l, int bh) {
    constexpr int PW = 272, PK = 144;
    constexpr int B_WN = 0, B_QD = 64 * PW, B_KDT = 2 * 64 * PW, B_QK = B_KDT + 128 * PK, BUFB = B_QK + 64 * PK;
    static_assert(2 * BUFB <= RING_BYTES, "scan LDS");
    const int tid = F.tid, lane = F.lane, wave = F.wave, fr = lane & 15, fq = lane >> 4;
    const bf16* WN = WSP(bf16, GDN_WN) + (size_t)bh * 128 * 8192; const bf16* QD = WSP(bf16, GDN_QD) + (size_t)bh * 128 * 8192;
    const bf16* KDT = WSP(bf16, GDN_KDT) + (size_t)bh * 128 * 8192; const bf16* QK = WSP(bf16, GDN_QK) + (size_t)bh * 128 * 4096;
    const bf16* UT = WSP(bf16, GDN_UT) + (size_t)bh * 128 * 8192; float* OT = WSP(float, GDN_OT) + (size_t)bh * 128 * 8192; const float* GL = WSP(float, GDN_GL) + bh * 128;
    f32x4 S[8];
#pragma unroll
    for (int T = 0; T < 8; ++T) S[T] = (f32x4){0.f, 0.f, 0.f, 0.f};
    v4u st[7];
#define GDN_LOAD(nn) do { const size_t o8 = (size_t)(nn) * 8192, o4 = (size_t)(nn) * 4096; \
        st[0] = *(const GAS v4u*)(WN + o8 + (size_t)tid * 8); st[1] = *(const GAS v4u*)(WN + o8 + (size_t)(tid + 512) * 8); \
        st[2] = *(const GAS v4u*)(QD + o8 + (size_t)tid * 8); st[3] = *(const GAS v4u*)(QD + o8 + (size_t)(tid + 512) * 8); \
        st[4] = *(const GAS v4u*)(KDT + o8 + (size_t)tid * 8); st[5] = *(const GAS v4u*)(KDT + o8 + (size_t)(tid + 512) * 8); \
        st[6] = *(const GAS v4u*)(QK + o4 + (size_t)tid * 8); } while (0)
#define GDN_STORE(buf) do { LAS unsigned char* bb = F.lds + RING_OFF + (buf) * BUFB; \
        *(LAS v4u*)(bb + B_WN + (tid >> 4) * PW + (tid & 15) * 16) = st[0]; *(LAS v4u*)(bb + B_WN + ((tid + 512) >> 4) * PW + (tid & 15) * 16) = st[1]; \
        *(LAS v4u*)(bb + B_QD + (tid >> 4) * PW + (tid & 15) * 16) = st[2]; *(LAS v4u*)(bb + B_QD + ((tid + 512) >> 4) * PW + (tid & 15) * 16) = st[3]; \
        *(LAS v4u*)(bb + B_KDT + (tid >> 3) * PK + (tid & 7) * 16) = st[4]; *(LAS v4u*)(bb + B_KDT + ((tid + 512) >> 3) * PK + (tid & 7) * 16) = st[5]; \
        *(LAS v4u*)(bb + B_QK + (tid >> 3) * PK + (tid & 7) * 16) = st[6]; } while (0)
    GDN_LOAD(0); GDN_STORE(0);
    __syncthreads();
    for (int n = 0; n < NCHUNK; ++n) {
        const int buf = n & 1; const LAS unsigned char* bb = F.lds + RING_OFF + buf * BUFB;
        if (n + 1 < NCHUNK) GDN_LOAD(n + 1);
        const float egl = GL[n];
        f32x4 av[4], ao[4];
        { const bf16* up = UT + ((size_t)n * 128 + wave * 16 + fr) * 64 + 4 * fq;
#pragma unroll
          for (int m = 0; m < 4; ++m) { const v2u w = *(const GAS v2u*)(up + 16 * m); av[m] = (f32x4){bflo(w.x), bfhi(w.x), bflo(w.y), bfhi(w.y)}; ao[m] = (f32x4){0.f, 0.f, 0.f, 0.f}; } }
        bf16x8 Bs[4];
#pragma unroll
        for (int kt = 0; kt < 4; ++kt) { v4u w; w.x = pk2(S[2 * kt][0], S[2 * kt][1]); w.y = pk2(S[2 * kt][2], S[2 * kt][3]); w.z = pk2(S[2 * kt + 1][0], S[2 * kt + 1][1]); w.w = pk2(S[2 * kt + 1][2], S[2 * kt + 1][3]); Bs[kt] = __builtin_bit_cast(bf16x8, w); }
#pragma unroll
        for (int kt = 0; kt < 4; ++kt)
#pragma unroll
            for (int m = 0; m < 4; ++m) {
                const bf16x8 aw = *(const LAS bf16x8*)(bb + B_WN + (16 * m + fr) * PW + (32 * kt + 8 * fq) * 2);
                const bf16x8 aq = *(const LAS bf16x8*)(bb + B_QD + (16 * m + fr) * PW + (32 * kt + 8 * fq) * 2);
                av[m] = __builtin_amdgcn_mfma_f32_16x16x32_bf16(aw, Bs[kt], av[m], 0, 0, 0);
                ao[m] = __builtin_amdgcn_mfma_f32_16x16x32_bf16(aq, Bs[kt], ao[m], 0, 0, 0);
            }
        bf16x8 Bv[2];
#pragma unroll
        for (int kc = 0; kc < 2; ++kc) { v4u w; w.x = pk2(av[2 * kc][0], av[2 * kc][1]); w.y = pk2(av[2 * kc][2], av[2 * kc][3]); w.z = pk2(av[2 * kc + 1][0], av[2 * kc + 1][1]); w.w = pk2(av[2 * kc + 1][2], av[2 * kc + 1][3]); Bv[kc] = __builtin_bit_cast(bf16x8, w); }
#pragma unroll
        for (int kc = 0; kc < 2; ++kc)
#pragma unroll
            for (int m = 0; m < 4; ++m) {
                const bf16x8 aqk = *(const LAS bf16x8*)(bb + B_QK + (16 * m + fr) * PK + (32 * kc + 8 * fq) * 2);
                ao[m] = __builtin_amdgcn_mfma_f32_16x16x32_bf16(aqk, Bv[kc], ao[m], 0, 0, 0);
            }
#pragma unroll
        for (int T = 0; T < 8; ++T) S[T] = S[T] * egl;
#pragma unroll
        for (int kc = 0; kc < 2; ++kc)
#pragma unroll
            for (int T = 0; T < 8; ++T) {
                const bf16x8 ak = *(const LAS bf16x8*)(bb + B_KDT + (16 * T + fr) * PK + (32 * kc + 8 * fq) * 2);
                S[T] = __builtin_amdgcn_mfma_f32_16x16x32_bf16(ak, Bv[kc], S[T], 0, 0, 0);
            }
        { float* op = OT + ((size_t)n * 128 + wave * 16 + fr) * 64 + 4 * fq;
#pragma unroll
          for (int m = 0; m < 4; ++m) *(GAS f32x4*)(op + 16 * m) = ao[m]; }
        if (n + 1 < NCHUNK) GDN_STORE(buf ^ 1);
        __syncthreads();
    }
#undef GDN_LOAD
#undef GDN_STORE
    float* od = a.out + O_DELTA_P + ((size_t)l * 8 + bh) * 128 * 128;
#pragma unroll
    for (int T = 0; T < 8; ++T)
#pragma unroll
        for (int i = 0; i < 4; ++i) od[(size_t)(16 * T + 4 * fq + i) * 128 + wave * 16 + fr] = S[T][i];
}

__device__ __forceinline__ void gdn_sample(Frame& F, const Args& a, int l, int unit) {
    LAS float* sq = (LAS float*)(F.lds + RING_OFF); LAS float* sk = sq + 128; LAS float* svv = sk + 128; LAS float* red = svv + 128;
    LAS float* misc = red + 512;
    const int tid = F.tid, b = unit >> 2, h = unit & 3; const size_t row = MP + b;
    const bf16* P = WSP(bf16, WS_P); const float* SC = WSP(float, WS_SC);
    if (tid < 384) {
        const int part = tid >> 7, j = tid & 127; const int c = (part == 0 ? 0 : part == 1 ? 512 : 1024) + h * 128 + j;
        const float* cw = INP(float, I_CONVW) + (size_t)l * 4 * CQKV; const float* sb = INP(float, I_SCONV) + ((size_t)(l * MS + b) * 3) * CQKV + c;
        const float y = siluf_(cw[c] * sb[0] + cw[CQKV + c] * sb[CQKV] + cw[2 * CQKV + c] * sb[2 * CQKV] + cw[3 * CQKV + c] * bf2f(P[row * NINP + PC_QKV + c]));
        (part == 0 ? sq : part == 1 ? sk : svv)[j] = y;
    }
    __syncthreads();
    if (F.wave < 2) { LAS float* p = F.wave == 0 ? sq : sk; const float x0 = p[F.lane], x1 = p[64 + F.lane]; const float inv = 1.f / sqrtf(wave_sum(x0 * x0 + x1 * x1) + 1e-6f); p[F.lane] = x0 * inv; p[64 + F.lane] = x1 * inv; }
    __syncthreads();
    const float beta = sigmoidf_(SC[row * 32 + h]); const float eg = __expf(-__expf(INP(float, I_ALOG)[l * 4 + h]) * softplusf_(SC[row * 32 + 4 + h] + INP(float, I_DTB)[l * 4 + h]));
    const int dv = tid & 127, ks = tid >> 7;
    const float* S0 = INP(float, I_SDELTA) + ((size_t)(l * MS + b) * 4 + h) * 128 * 128;
    float sreg[32]; float part = 0.f;
#pragma unroll
    for (int i = 0; i < 32; ++i) { sreg[i] = S0[(size_t)(ks * 32 + i) * 128 + dv]; part += sk[ks * 32 + i] * sreg[i]; }
    red[ks * 128 + dv] = part;
    __syncthreads();
    const float kS = red[dv] + red[128 + dv] + red[256 + dv] + red[384 + dv];
    const float vn = beta * (svv[dv] - eg * kS);
    __syncthreads();
    float* od = a.out + O_DELTA_S + ((size_t)(l * MS + b) * 4 + h) * 128 * 128; float po = 0.f;
#pragma unroll
    for (int i = 0; i < 32; ++i) { const float sn = eg * sreg[i] + sk[ks * 32 + i] * vn; od[(size_t)(ks * 32 + i) * 128 + dv] = sn; po += sq[ks * 32 + i] * sn; }
    red[ks * 128 + dv] = po;
    __syncthreads();
    if (tid < 128) { const float o = (red[dv] + red[128 + dv] + red[256 + dv] + red[384 + dv]) * 0.08838834764831845f; misc[dv] = o; }
    __syncthreads();
    if (F.wave == 0) { const float o0 = misc[F.lane], o1 = misc[64 + F.lane]; const float r = 1.f / sqrtf(wave_sum(o0 * o0 + o1 * o1) * (1.f / 128.f) + LN_EPS);
        bf16* OA = WSP(bf16, WS_OAB) + row * 512 + h * 128; const float* nw = INP(float, I_NORMW) + l * 128;
        const float z0 = bf2f(P[row * NINP + PC_Z + h * 128 + F.lane]), z1 = bf2f(P[row * NINP + PC_Z + h * 128 + 64 + F.lane]);
        OA[F.lane] = (bf16)f2bf(o0 * r * nw[F.lane] * siluf_(z0)); OA[64 + F.lane] = (bf16)f2bf(o1 * r * nw[64 + F.lane] * siluf_(z1)); }
    __syncthreads();
}

__device__ __forceinline__ void gdn_onorm(Frame& F, const Args& a, int l) {
    LAS float* tile = (LAS float*)(F.lds + RING_OFF);
    const bf16* P = WSP(bf16, WS_P); const float* nw = INP(float, I_NORMW) + l * 128;
    for (int unit = F.bid; unit < 8 * NCHUNK; unit += F.G) {
        const int bh = unit >> 7, n = unit & 127, b = bh >> 2, h = bh & 3; const size_t row0 = (size_t)b * SEQ + n * CHUNK;
        const float* src = WSP(float, GDN_OT) + (size_t)unit * 8192;
        for (int i = F.tid; i < 8192; i += NTHR) tile[(i >> 6) * 65 + (i & 63)] = src[i];
        __syncthreads();
        const int c = F.tid >> 3, part = F.tid & 7;
        float v[16]; float ss = 0.f;
#pragma unroll
        for (int i = 0; i < 16; ++i) { v[i] = tile[(part * 16 + i) * 65 + c]; ss += v[i] * v[i]; }
        ss += shx<1>(ss); ss += shx<2>(ss); ss += shx<4>(ss);
        const float r = 1.f / sqrtf(ss * (1.f / 128.f) + LN_EPS);
        const bf16* zp = P + (row0 + c) * NINP + PC_Z + h * 128 + part * 16; bf16* op = WSP(bf16, WS_OAB) + (row0 + c) * 512 + h * 128 + part * 16;
        const v4u z0 = *(const GAS v4u*)zp, z1 = *(const GAS v4u*)(zp + 8); const unsigned zz[8] = {z0.x, z0.y, z0.z, z0.w, z1.x, z1.y, z1.z, z1.w};
        unsigned o[8];
#pragma unroll
        for (int i = 0; i < 8; ++i) { const float a0 = v[2 * i] * r * nw[part * 16 + 2 * i] * siluf_(bflo(zz[i])), a1 = v[2 * i + 1] * r * nw[part * 16 + 2 * i + 1] * siluf_(bfhi(zz[i])); o[i] = pk2(a0, a1); }
        *(GAS v4u*)op = (v4u){o[0], o[1], o[2], o[3]}; *(GAS v4u*)(op + 8) = (v4u){o[4], o[5], o[6], o[7]};
        __syncthreads();
    }
}
struct EpiUp {
    static constexpr bool PERM = true, AFTER_DRAIN = false, CHAIN = true;
    const bf16* P; bf16* U;
    template <bool FINAL> __device__ __forceinline__ void run(pg8::f32x4 (&acc)[2][2][4][2], const pg8::Unit& u, int wr, int wc, int fr, int fq) const {
        asm volatile("" : "+v"(fr), "+v"(fq));
#pragma unroll
        for (int ai = 0; ai < 2; ++ai)
#pragma unroll
            for (int m = 0; m < 4; ++m) {
                const size_t row = (size_t)u.pm * 256 + ai * 128 + wr * 64 + m * 16 + fr;
#pragma unroll
                for (int bj = 0; bj < 2; ++bj) {
                    const int j = wc * 32 + 8 * fq;
                    const v4u g = *(const GAS v4u*)(P + row * NINP + PC_GM + 256 * (2 * u.pn + bj) + (FINAL ? 128 : 0) + j);
                    pg8::f32x4 v0 = acc[ai][bj][m][0], v1 = acc[ai][bj][m][1];
                    v0[0] *= bflo(g.x); v0[1] *= bfhi(g.x); v0[2] *= bflo(g.y); v0[3] *= bfhi(g.y); v1[0] *= bflo(g.z); v1[1] *= bfhi(g.z); v1[2] *= bflo(g.w); v1[3] *= bfhi(g.w);
                    if (FINAL) { v4u w; w.x = pk2(v0[0], v0[1]); w.y = pk2(v0[2], v0[3]); w.z = pk2(v1[0], v1[1]); w.w = pk2(v1[2], v1[3]); *(GAS v4u*)(U + row * D + u.pn * 256 + bj * 128 + j) = w; }
                    else { acc[ai][bj][m][0] = v0; acc[ai][bj][m][1] = v1; }
                }
                asm volatile("" ::: "memory");
            }
    }
    __device__ __forceinline__ void mid(pg8::f32x4 (&acc)[2][2][4][2], const pg8::Unit& u, int wr, int wc, int fr, int fq) const { run<false>(acc, u, wr, wc, fr, fq); }
    __device__ __forceinline__ void operator()(pg8::f32x4 (&acc)[2][2][4][2], const pg8::Unit& u, int wr, int wc, int fr, int fq) const { run<true>(acc, u, wr, wc, fr, fq); }
};
struct ChainOrder {
    int G, c;
    __device__ bool next(int i, pg8::Unit& u) const {
        const int L = i * G + c; if (L >= NTILE_M * 4) return false;
        u.pm = L % NTILE_M; u.pn = L / NTILE_M; u.am = u.pm; u.bn = u.pn; u.am2 = u.pm + NTILE_M; u.bn2 = u.pn + 4; return true;
    }
    __device__ __forceinline__ void a_ready(const pg8::Unit&) const {}
    __device__ __forceinline__ void done(const pg8::Unit&) const {}
};
struct EpiF32 {
    static constexpr bool PERM = true, AFTER_DRAIN = false, CHAIN = false;
    float* Y;
    __device__ __forceinline__ void mid(const pg8::f32x4 (&)[2][2][4][2], const pg8::Unit&, int, int, int, int) const {}
    __device__ __forceinline__ void operator()(const pg8::f32x4 (&acc)[2][2][4][2], const pg8::Unit& u, int wr, int wc, int fr, int fq) const {
        asm volatile("" : "+v"(fr), "+v"(fq));
        const int colb = u.pn * 256 + wc * 32 + 8 * fq;
#pragma unroll
        for (int ai = 0; ai < 2; ++ai)
#pragma unroll
            for (int m = 0; m < 4; ++m) { float* rp = Y + ((size_t)u.pm * 256 + ai * 128 + wr * 64 + m * 16 + fr) * D + colb;
#pragma unroll
                for (int bj = 0; bj < 2; ++bj) { *(GAS pg8::f32x4*)(rp + bj * 128) = acc[ai][bj][m][0]; *(GAS pg8::f32x4*)(rp + bj * 128 + 4) = acc[ai][bj][m][1]; } }
    }
};
struct EpiSwiglu {
    static constexpr bool PERM = true, AFTER_DRAIN = false, CHAIN = false;
    bf16* ACT;
    __device__ __forceinline__ void mid(const pg8::f32x4 (&)[2][2][4][2], const pg8::Unit&, int, int, int, int) const {}
    __device__ __forceinline__ void operator()(const pg8::f32x4 (&acc)[2][2][4][2], const pg8::Unit& u, int wr, int wc, int fr, int fq) const {
        asm volatile("" : "+v"(fr), "+v"(fq));
        const int col = u.pn * 128 + wc * 32 + 8 * fq;
#pragma unroll
        for (int ai = 0; ai < 2; ++ai)
#pragma unroll
            for (int m = 0; m < 4; ++m) { bf16* rp = ACT + ((size_t)u.pm * 256 + ai * 128 + wr * 64 + m * 16 + fr) * DFF + col;
                float o[8];
#pragma unroll
                for (int n = 0; n < 2; ++n)
#pragma unroll
                    for (int q = 0; q < 4; ++q) { const float g = acc[ai][0][m][n][q]; o[4 * n + q] = g / (1.f + __expf(-g)) * acc[ai][1][m][n][q]; }
                v4u w; w.x = pk2(o[0], o[1]); w.y = pk2(o[2], o[3]); w.z = pk2(o[4], o[5]); w.w = pk2(o[6], o[7]); *(GAS v4u*)rp = w; }
    }
};
template <int nN> struct MoeOrder {
    int G, c; const int* meta;
    __device__ bool next(int i, pg8::Unit& u) const {
        const int L = i * G + c, nt = __builtin_amdgcn_readfirstlane(meta[0]); if (L >= nt * nN) return false;
        u.pm = L / nN; u.pn = L % nN; u.am = u.pm; u.bn = __builtin_amdgcn_readfirstlane(meta[16 + u.pm]) * nN + u.pn; u.am2 = 0; u.bn2 = 0; return true;
    }
    __device__ __forceinline__ void a_ready(const pg8::Unit&) const {}
    __device__ __forceinline__ void done(const pg8::Unit&) const {}
};
constexpr size_t NSA_VSLT = WS_NSA, NSA_VWT = WS_NSA + 4 * MiB, NSA_KC = WS_NSA + 8 * MiB, NSA_VCT = WS_NSA + 9 * MiB, NSA_CVEC = WS_NSA + 10 * MiB;
constexpr size_t SMP_SEG = WS_SMP, SMP_HP = WS_SMP + 272 * MiB, SMP_KCS = WS_SMP + 340 * MiB, SMP_VCS = WS_SMP + 348 * MiB;
constexpr int SEGROWS = 34816, SEGTILES = 136;
static_assert(SMP_VCS + 8 * MiB <= WS_END, "ws map");
__device__ __forceinline__ int kperm_inv(int p) { return (p & ~31) | (((p >> 2) & 1) << 4) | (((p >> 3) & 3) << 2) | (p & 3); }

__device__ __forceinline__ void nsa_prologue(Frame& F, const Args& a) {
    const int NGW = F.G * NWAVES, gw = F.bid * NWAVES + F.wave;
    if (gw >= NGW - 16) { const int wv = NGW - 1 - gw, q = wv >> 2, col = (wv & 3) * 64 + F.lane;
        const float* pos = INP(float, I_CPOS) + (size_t)q * 2048; const float* w1 = INP(float, I_CW1) + (size_t)q * 2048 * 256 + col; float acc = 0.f;
        for (int i = 0; i < 2048; ++i) acc += pos[i] * w1[(size_t)i * 256];
        WSP(float, NSA_CVEC)[q * 256 + col] = acc; }
    const int* pt = INP(int, I_PT); const int kv = F.lane >> 5, g = (F.lane >> 4) & 1, d4 = F.lane & 15;
    for (int it = gw; it < 2 * MS * NPAGES * PAGE; it += NGW) {
        const int r = it & 127, p = (it >> 7) & 63, b = (it >> 13) & 31, l = it >> 18;
        const int page = pt[b * NPAGES + p];
        const f32x4 v = *(const GAS f32x4*)(INP(float, I_CCMP) + (((size_t)l * NPOOL + page) * PAGE + r) * KVW + 4 * F.lane);
        bf16* dst = WSP(bf16, SMP_SEG) + (((size_t)(l * 2 + kv) * SEGROWS) + 2048 + (size_t)(b * 2 + g) * 512 + p * 8 + (r >> 4)) * 1024 + (r & 15) * 64 + 4 * d4;
        v2u o; o.x = pk2(v.x, v.y); o.y = pk2(v.z, v.w); *(GAS v2u*)dst = o;
    }
}
__device__ __forceinline__ void nsa_prep(Frame& F, const Args& a, int l) {
    const int NGW = F.G * NWAVES, gw = F.bid * NWAVES + F.wave; const bf16* P = WSP(bf16, WS_P);
    { const int kv = F.lane >> 5, g = (F.lane >> 4) & 1, d4 = F.lane & 15;
      for (int row = gw; row < MP; row += NGW) { const int b = row >> 13, t = row & (SEQ - 1);
          const v2u v = *(const GAS v2u*)(P + (size_t)row * NINP + PC_KVC + 4 * F.lane);
          *(GAS v2u*)(WSP(bf16, SMP_SEG) + (((size_t)(l * 2 + kv) * SEGROWS) + (size_t)(b * 2 + g) * 512 + (t >> 4)) * 1024 + (t & 15) * 64 + 4 * d4) = v; } }
    LAS bf16* tile = (LAS bf16*)(F.lds + RING_OFF + F.wave * 16384);
    for (int unit = gw; unit < 2 * 4 * 128; unit += NGW) {
        const int tb = unit & 127, bg = (unit >> 7) & 3, kind = unit >> 9, b = bg >> 1, g = bg & 1;
        const bf16* src = P + ((size_t)b * SEQ + tb * 64 + F.lane) * NINP + (kind ? PC_KVW : PC_KVS) + 128 + g * 64;
#pragma unroll
        for (int q = 0; q < 8; ++q) *(LAS v4u*)(tile + F.lane * 72 + 8 * q) = *(const GAS v4u*)(src + 8 * q);
        LDS_WAIT(); asm volatile("" ::: "memory");
        bf16* dst = WSP(bf16, kind ? NSA_VWT : NSA_VSLT) + ((size_t)bg * 64) * SEQ + tb * 64 + F.lane; const int ts = kperm_inv(F.lane);
        for (int d = 0; d < 64; ++d) dst[(size_t)d * SEQ] = tile[ts * 72 + d];
        LDS_WAIT(); asm volatile("" ::: "memory");
    }
}
struct CmpOrder {
    int G, c;
    __device__ bool next(int i, pg8::Unit& u) const {
        const int L = i * G + c; if (L >= 2 * SEGTILES * 2) return false;
        const int kv = L / (SEGTILES * 2), rem = L % (SEGTILES * 2); u.pn = rem / SEGTILES; u.pm = kv * SEGTILES + rem % SEGTILES; u.am = u.pm; u.bn = kv * 2 + u.pn; u.am2 = 0; u.bn2 = 0; return true;
    }
    __device__ __forceinline__ void a_ready(const pg8::Unit&) const {}
    __device__ __forceinline__ void done(const pg8::Unit&) const {}
};
struct EpiBf16P {
    static constexpr bool PERM = true, AFTER_DRAIN = false, CHAIN = false;
    bf16* O; int ld;
    __device__ __forceinline__ void mid(const pg8::f32x4 (&)[2][2][4][2], const pg8::Unit&, int, int, int, int) const {}
    __device__ __forceinline__ void operator()(const pg8::f32x4 (&acc)[2][2][4][2], const pg8::Unit& u, int wr, int wc, int fr, int fq) const {
        asm volatile("" : "+v"(fr), "+v"(fq));
        const int colb = u.pn * 256 + wc * 32 + 8 * fq;
#pragma unroll
        for (int ai = 0; ai < 2; ++ai)
#pragma unroll
            for (int m = 0; m < 4; ++m) { bf16* rp = O + ((size_t)u.pm * 256 + ai * 128 + wr * 64 + m * 16 + fr) * ld + colb;
#pragma unroll
                for (int bj = 0; bj < 2; ++bj) { const pg8::f32x4 v0 = acc[ai][bj][m][0], v1 = acc[ai][bj][m][1];
                    v4u w; w.x = pk2(v0[0], v0[1]); w.y = pk2(v0[2], v0[3]); w.z = pk2(v1[0], v1[1]); w.w = pk2(v1[2], v1[3]); *(GAS v4u*)(rp + bj * 128) = w; } }
    }
};
__device__ __forceinline__ void nsa_cmp2(Frame& F, const Args& a, int l) {
    LAS float* hs = (LAS float*)(F.lds + RING_OFF);
    const bf16* HP = WSP(bf16, SMP_HP);
    for (int unit = F.bid; unit < 256 + 4096; unit += F.G) {
        int kv, bg, nb, smp;
        if (unit < 256) { smp = 0; nb = unit & 31; bg = (unit >> 5) & 3; kv = unit >> 7; } else { const int u2 = unit - 256; smp = 1; nb = u2 & 31; bg = (u2 >> 5) & 63; kv = u2 >> 11; }
        const size_t R0 = (size_t)kv * SEGROWS + (smp ? 2048 : 0) + (size_t)bg * 512 + nb * 16;
        const float* cv = WSP(float, NSA_CVEC) + (l * 2 + kv) * 256;
        for (int idx = F.tid; idx < 16 * 256; idx += NTHR) { const int i = idx >> 8, c = idx & 255;
            float h = 0.f; if (nb * 16 + i < NCMP) { h = bf2f(HP[(R0 + i) * 512 + c]) + bf2f(HP[(R0 + i + 1) * 512 + 256 + c]) + cv[c]; h = siluf_(h); }
            hs[idx] = h; }
        __syncthreads();
        const int i = F.tid >> 5, dq = F.tid & 31, n = nb * 16 + i; const float* w2 = INP(float, I_CW2) + (size_t)(l * 2 + kv) * 256 * 64 + 2 * dq;
        float o0 = 0.f, o1 = 0.f;
        for (int c = 0; c < 256; ++c) { const float h = hs[i * 256 + c]; const f32x2 w = *(const GAS f32x2*)(w2 + c * 64); o0 += h * w.x; o1 += h * w.y; }
        if (smp) { float* dst = WSP(float, kv ? SMP_VCS : SMP_KCS) + ((size_t)bg * 512 + n) * 64 + 2 * dq; *(GAS f32x2*)dst = (f32x2){o0, o1}; }
        else if (kv == 0) { *(GAS unsigned*)(WSP(bf16, NSA_KC) + ((size_t)bg * 512 + n) * 64 + 2 * dq) = pk2(o0, o1); }
        else { bf16* dst = WSP(bf16, NSA_VCT) + ((size_t)bg * 64 + 2 * dq) * 512 + kperm(n); dst[0] = (bf16)f2bf(o0); dst[512] = (bf16)f2bf(o1); }
        __syncthreads();
    }
}
constexpr int AT_KB = 9216, AT_SLOT = 2 * AT_KB;
constexpr int AT_IMP = 2 * AT_SLOT;
constexpr int AT_SEL = AT_IMP + 8 * 4096;
constexpr float AT_C2 = 0.125f * 1.4426950408889634f;
struct AtStg { v4u k, v; };
__device__ __forceinline__ void at_load(AtStg& s, const bf16* Kblk, size_t kpitch, const bf16* VTblk, size_t vpitch, int tid) {
    const int r = tid >> 3, c = (tid & 7) * 8;
    s.k = *(const GAS v4u*)(Kblk + (size_t)r * kpitch + c); s.v = *(const GAS v4u*)(VTblk + (size_t)r * vpitch + c);
}
__device__ __forceinline__ void at_store(const AtStg& s, LAS unsigned char* slot, int tid) {
    const int r = tid >> 3, c = (tid & 7) * 16;
    *(LAS v4u*)(slot + r * 144 + c) = s.k; *(LAS v4u*)(slot + AT_KB + r * 144 + c) = s.v;
}
__device__ __forceinline__ void at_qk(f32x4 (&sc)[4][2], const LAS unsigned char* slot, const bf16x8 (&Qb)[2][2], int fr, int fq) {
#pragma unroll
    for (int mt = 0; mt < 4; ++mt) { sc[mt][0] = (f32x4){0.f, 0.f, 0.f, 0.f}; sc[mt][1] = (f32x4){0.f, 0.f, 0.f, 0.f};
#pragma unroll
        for (int ks = 0; ks < 2; ++ks) { const bf16x8 ak = *(const LAS bf16x8*)(slot + (16 * mt + fr) * 144 + (32 * ks + 8 * fq) * 2);
            sc[mt][0] = __builtin_amdgcn_mfma_f32_16x16x32_bf16(ak, Qb[0][ks], sc[mt][0], 0, 0, 0); sc[mt][1] = __builtin_amdgcn_mfma_f32_16x16x32_bf16(ak, Qb[1][ks], sc[mt][1], 0, 0, 0); } }
}
__device__ __forceinline__ void at_pv(f32x4 (&oc)[4][2], const f32x4 (&p)[4][2], const LAS unsigned char* slot, int fr, int fq) {
    bf16x8 Bp[2][2];
#pragma unroll
    for (int nt = 0; nt < 2; ++nt)
#pragma unroll
        for (int kc = 0; kc < 2; ++kc) { v4u w; w.x = pk2(p[2 * kc][nt][0], p[2 * kc][nt][1]); w.y = pk2(p[2 * kc][nt][2], p[2 * kc][nt][3]); w.z = pk2(p[2 * kc + 1][nt][0], p[2 * kc + 1][nt][1]); w.w = pk2(p[2 * kc + 1][nt][2], p[2 * kc + 1][nt][3]); Bp[nt][kc] = __builtin_bit_cast(bf16x8, w); }
#pragma unroll
    for (int dt = 0; dt < 4; ++dt)
#pragma unroll
        for (int kc = 0; kc < 2; ++kc) { const bf16x8 av = *(const LAS bf16x8*)(slot + AT_KB + (16 * dt + fr) * 144 + (32 * kc + 8 * fq) * 2);
            oc[dt][0] = __builtin_amdgcn_mfma_f32_16x16x32_bf16(av, Bp[0][kc], oc[dt][0], 0, 0, 0); oc[dt][1] = __builtin_amdgcn_mfma_f32_16x16x32_bf16(av, Bp[1][kc], oc[dt][1], 0, 0, 0); }
}
__device__ __forceinline__ void at_online(f32x4 (&sc)[4][2], float (&m)[2], float (&l)[2], f32x4 (&oc)[4][2]) {
#pragma unroll
    for (int nt = 0; nt < 2; ++nt) {
        float mx = -INFINITY;
#pragma unroll
        for (int mt = 0; mt < 4; ++mt) mx = fmaxf(fmaxf(fmaxf(sc[mt][nt][0], sc[mt][nt][1]), fmaxf(sc[mt][nt][2], sc[mt][nt][3])), mx);
        mx = fmaxf(mx, shx<16>(mx)); mx = fmaxf(mx, shx<32>(mx));
        const float mn = fmaxf(m[nt], mx), ms = mn == -INFINITY ? 0.f : mn, alpha = exp2f(m[nt] - ms);
        float s = 0.f;
#pragma unroll
        for (int mt = 0; mt < 4; ++mt)
#pragma unroll
            for (int i = 0; i < 4; ++i) { const float e = exp2f(sc[mt][nt][i] - ms); sc[mt][nt][i] = e; s += e; }
        s += shx<16>(s); s += shx<32>(s);
        l[nt] = l[nt] * alpha + s; m[nt] = mn;
#pragma unroll
        for (int dt = 0; dt < 4; ++dt) oc[dt][nt] = oc[dt][nt] * alpha;
    }
}
#define AT_SYNC() __syncthreads()
__device__ __forceinline__ unsigned at_w4(const unsigned (&a)[4], int w) { return w == 0 ? a[0] : w == 1 ? a[1] : w == 2 ? a[2] : a[3]; }
#define AT_LOOP(nblk, PTRS, BODY) do { \
        AtStg stg_; const bf16* Kp_; const bf16* Vp_; \
        if ((nblk) > 0) { PTRS(0, Kp_, Vp_); at_load(stg_, Kp_, kpitch_, Vp_, vpitch_, tid); at_store(stg_, ring, tid); } \
        AT_SYNC(); \
        for (int i_ = 0; i_ < (nblk); ++i_) { \
            LAS unsigned char* slot = ring + (i_ & 1) * AT_SLOT; \
            if (i_ + 1 < (nblk)) { PTRS(i_ + 1, Kp_, Vp_); at_load(stg_, Kp_, kpitch_, Vp_, vpitch_, tid); } \
            BODY(i_); \
            if (i_ + 1 < (nblk)) at_store(stg_, ring + ((i_ + 1) & 1) * AT_SLOT, tid); \
            AT_SYNC(); \
        } } while (0)

__device__ __forceinline__ void nsa_attn_tile(Frame& F, const Args& a, int l, int b, int g, int tb) {
    LAS unsigned char* ring = F.lds + RING_OFF;
    int tid_l = F.tid, lane_l = F.lane; asm volatile("" : "+v"(tid_l), "+v"(lane_l));
    const int tid = tid_l, lane = lane_l, wave = F.wave, fr = lane & 15, fq = lane >> 4;
    LAS float* impw = (LAS float*)(F.lds + RING_OFF + AT_IMP + wave * 4096);
    LAS unsigned* selw = (LAS unsigned*)(F.lds + RING_OFF + AT_SEL + wave * 128);
    const bf16* P = WSP(bf16, WS_P); const float* SC = WSP(float, WS_SC);
    const int t0 = tb * 64, bg = b * 2 + g;
    int tt[2], head = fr & 3; size_t row[2];
#pragma unroll
    for (int nt = 0; nt < 2; ++nt) { tt[nt] = wave * 8 + 4 * nt + (fr >> 2); row[nt] = (size_t)b * SEQ + t0 + tt[nt]; }
    bf16x8 Qb[2][2];
#pragma unroll
    for (int nt = 0; nt < 2; ++nt)
#pragma unroll
        for (int ks = 0; ks < 2; ++ks) Qb[nt][ks] = *(const GAS bf16x8*)(P + row[nt] * NINP + PC_QB + (4 * g + head) * 64 + 32 * ks + 8 * fq);
    f32x4 outa[4][2];
#pragma unroll
    for (int dt = 0; dt < 4; ++dt) { outa[dt][0] = (f32x4){0.f, 0.f, 0.f, 0.f}; outa[dt][1] = (f32x4){0.f, 0.f, 0.f, 0.f}; }
    f32x4 sc[4][2], oc[4][2]; float m[2], lsum[2];
    size_t kpitch_, vpitch_;
#define AT_RESET() do { m[0] = m[1] = -INFINITY; lsum[0] = lsum[1] = 0.f; _Pragma("unroll") for (int dt = 0; dt < 4; ++dt) { oc[dt][0] = (f32x4){0.f, 0.f, 0.f, 0.f}; oc[dt][1] = (f32x4){0.f, 0.f, 0.f, 0.f}; } } while (0)
#define AT_ACCUM(br) do { _Pragma("unroll") for (int nt = 0; nt < 2; ++nt) { const float gt = sigmoidf_(SC[row[nt] * 32 + 8 + (4 * g + head) * 3 + (br)]); const float f = lsum[nt] > 0.f ? gt / lsum[nt] : 0.f; \
        _Pragma("unroll") for (int dt = 0; dt < 4; ++dt) outa[dt][nt] += oc[dt][nt] * f; } } while (0)

    const int nkb = (4 * tb + 3 + 63) >> 6;
    int ncmp[2];
#pragma unroll
    for (int nt = 0; nt < 2; ++nt) { const int t = t0 + tt[nt]; ncmp[nt] = t >= 31 ? (t - 15) >> 4 : 0; }
    const bf16* KC = WSP(bf16, NSA_KC) + (size_t)bg * 512 * 64; const bf16* VCT = WSP(bf16, NSA_VCT) + (size_t)bg * 64 * 512;
    kpitch_ = 64; vpitch_ = 512;
#define CMP_PTRS(i, Kp, Vp) do { Kp = KC + (size_t)(i) * 64 * 64; Vp = VCT + (i) * 64; } while (0)
#define CMP_MASK(i) do { _Pragma("unroll") for (int mt = 0; mt < 4; ++mt) _Pragma("unroll") for (int nt = 0; nt < 2; ++nt) _Pragma("unroll") for (int q = 0; q < 4; ++q) { \
        const int n = (i) * 64 + 16 * mt + 4 * fq + q; sc[mt][nt][q] = n < ncmp[nt] ? sc[mt][nt][q] * AT_C2 : -INFINITY; } } while (0)
    AT_RESET();
#define CMP_BODY1(i) do { at_qk(sc, slot, Qb, fr, fq); CMP_MASK(i); at_online(sc, m, lsum, oc); } while (0)
    AT_LOOP(nkb, CMP_PTRS, CMP_BODY1);
    for (int i = lane; i < 1024; i += 64) impw[i] = 0.f;
    float rinv[2], msafe[2], carry[2] = {0.f, 0.f};
#pragma unroll
    for (int nt = 0; nt < 2; ++nt) { rinv[nt] = lsum[nt] > 0.f ? 1.f / lsum[nt] : 0.f; msafe[nt] = m[nt] == -INFINITY ? 0.f : m[nt]; }
#define CMP_BODY2(i) do { at_qk(sc, slot, Qb, fr, fq); CMP_MASK(i); \
        _Pragma("unroll") for (int nt = 0; nt < 2; ++nt) { \
            _Pragma("unroll") for (int mt = 0; mt < 4; ++mt) _Pragma("unroll") for (int q = 0; q < 4; ++q) sc[mt][nt][q] = exp2f(sc[mt][nt][q] - msafe[nt]) * rinv[nt]; \
            float qd[4], p3[4]; \
            _Pragma("unroll") for (int mt = 0; mt < 4; ++mt) { float x = (sc[mt][nt][0] + sc[mt][nt][1]) + (sc[mt][nt][2] + sc[mt][nt][3]), y = sc[mt][nt][3]; \
                x += shx<1>(x); x += shx<2>(x); y += shx<1>(y); y += shx<2>(y); qd[mt] = x; p3[mt] = y; } \
            _Pragma("unroll") for (int mt = 0; mt < 4; ++mt) { const float up = bperm(p3[mt], (lane + 48) & 63); const float prevmt = mt == 0 ? carry[nt] : bperm(p3[mt == 0 ? 0 : mt - 1], (lane + 48) & 63); \
                const float c = fq > 0 ? up : prevmt; \
                if ((fr & 3) == 0) impw[(4 * nt + (fr >> 2)) * 128 + (i) * 16 + 4 * mt + fq] = qd[mt] + c; } \
            carry[nt] = bperm(p3[3], (lane + 48) & 63); } \
        at_pv(oc, sc, slot, fr, fq); } while (0)
    AT_RESET(); lsum[0] = lsum[1] = 1.f;
    AT_LOOP(nkb, CMP_PTRS, CMP_BODY2);
    AT_ACCUM(0);
    for (int tk = 0; tk < 8; ++tk) {
        LAS float* iv = impw + tk * 128;
        float v0 = iv[lane], v1 = iv[64 + lane];
        { const int j0 = lane, j1 = lane + 64; v0 = (j0 == 0 || j0 == tb) ? 1e9f : (j0 <= tb ? v0 : -1.f); v1 = (j1 == tb) ? 1e9f : (j1 <= tb ? v1 : -1.f); }
        iv[lane] = v0; iv[64 + lane] = v1;
        LDS_WAIT(); asm volatile("" ::: "memory");
        int c0 = 0, c1 = 0;
        for (int i4 = 0; i4 < 32; ++i4) { const f32x4 x = *(const LAS f32x4*)(iv + 4 * i4);
#pragma unroll
            for (int q = 0; q < 4; ++q) { const int i = 4 * i4 + q; const float xi = x[q];
                c0 += (xi > v0 || (xi == v0 && i < lane)) ? 1 : 0; c1 += (xi > v1 || (xi == v1 && i < lane + 64)) ? 1 : 0; } }
        const unsigned long long b0 = __builtin_amdgcn_ballot_w64(c0 < NSEL && lane <= tb), b1 = __builtin_amdgcn_ballot_w64(c1 < NSEL && lane + 64 <= tb);
        if (lane == 0) { selw[tk * 4 + 0] = (unsigned)b0; selw[tk * 4 + 1] = (unsigned)(b0 >> 32); selw[tk * 4 + 2] = (unsigned)b1; selw[tk * 4 + 3] = (unsigned)(b1 >> 32); }
    }
    LDS_WAIT(); asm volatile("" ::: "memory");
    unsigned mk[2][4], orm[4];
#pragma unroll
    for (int w4 = 0; w4 < 4; ++w4) { mk[0][w4] = selw[(fr >> 2) * 4 + w4]; mk[1][w4] = selw[(4 + (fr >> 2)) * 4 + w4];
        unsigned o = 0; for (int tk = 0; tk < 8; ++tk) o |= selw[tk * 4 + w4]; orm[w4] = __builtin_amdgcn_readfirstlane(o); }
    const bf16* KS = P + ((size_t)b * SEQ) * NINP + PC_KVS + g * 64; const bf16* VST = WSP(bf16, NSA_VSLT) + (size_t)bg * 64 * SEQ;
    kpitch_ = NINP; vpitch_ = SEQ;
#define SEL_PTRS(i, Kp, Vp) do { Kp = KS + (size_t)(i) * 64 * NINP; Vp = VST + (i) * 64; } while (0)
#define SEL_BODY(i) do { if ((at_w4(orm, (i) >> 5) >> ((i) & 31)) & 1u) { at_qk(sc, slot, Qb, fr, fq); \
        _Pragma("unroll") for (int nt = 0; nt < 2; ++nt) { const bool on = (at_w4(mk[nt], (i) >> 5) >> ((i) & 31)) & 1u; \
            _Pragma("unroll") for (int mt = 0; mt < 4; ++mt) _Pragma("unroll") for (int q = 0; q < 4; ++q) { const int kk = 16 * mt + 4 * fq + q; \
                sc[mt][nt][q] = (on && ((i) < tb || kk <= tt[nt])) ? sc[mt][nt][q] * AT_C2 : -INFINITY; } } \
        at_online(sc, m, lsum, oc); at_pv(oc, sc, slot, fr, fq); } } while (0)
    AT_RESET();
    AT_LOOP(tb + 1, SEL_PTRS, SEL_BODY);
    AT_ACCUM(1);
    const bf16* KW = P + ((size_t)b * SEQ) * NINP + PC_KVW + g * 64; const bf16* VWT_ = WSP(bf16, NSA_VWT) + (size_t)bg * 64 * SEQ;
    const int jw0 = tb >= 8 ? tb - 8 : 0, nwb = tb - jw0 + 1;
#define WIN_PTRS(i, Kp, Vp) do { Kp = KW + (size_t)(jw0 + (i)) * 64 * NINP; Vp = VWT_ + (jw0 + (i)) * 64; } while (0)
#define WIN_BODY(i) do { const int j = jw0 + (i); at_qk(sc, slot, Qb, fr, fq); \
        _Pragma("unroll") for (int nt = 0; nt < 2; ++nt) _Pragma("unroll") for (int mt = 0; mt < 4; ++mt) _Pragma("unroll") for (int q = 0; q < 4; ++q) { const int kk = 16 * mt + 4 * fq + q; \
            const bool ok = (j < tb || kk <= tt[nt]) && (j > tb - 8 || kk > tt[nt]); sc[mt][nt][q] = ok ? sc[mt][nt][q] * AT_C2 : -INFINITY; } \
        at_online(sc, m, lsum, oc); at_pv(oc, sc, slot, fr, fq); } while (0)
    AT_RESET();
    AT_LOOP(nwb, WIN_PTRS, WIN_BODY);
    AT_ACCUM(2);
    bf16* OB = WSP(bf16, WS_OAB) + (size_t)MT * 512;
#pragma unroll
    for (int nt = 0; nt < 2; ++nt)
#pragma unroll
        for (int dt = 0; dt < 4; ++dt) { v2u w; w.x = pk2(outa[dt][nt][0], outa[dt][nt][1]); w.y = pk2(outa[dt][nt][2], outa[dt][nt][3]); *(GAS v2u*)(OB + row[nt] * 512 + (4 * g + head) * 64 + 16 * dt + 4 * fq) = w; }
    AT_SYNC();
#undef AT_RESET
#undef AT_ACCUM
#undef CMP_PTRS
#undef CMP_MASK
#undef CMP_BODY1
#undef CMP_BODY2
#undef SEL_PTRS
#undef SEL_BODY
#undef WIN_PTRS
#undef WIN_BODY
}

__device__ __forceinline__ void nsa_sample_softmax(LAS float* sc, int nkeys, int pitch, LAS float* red, int tid, int lane, int wave) {
    if (wave < 4) { LAS float* s = sc + wave * pitch; float mx = -INFINITY;
        for (int i = lane; i < nkeys; i += 64) mx = fmaxf(mx, s[i]);
        mx = wave_max(mx); const float ms = mx == -INFINITY ? 0.f : mx; float sum = 0.f;
        for (int i = lane; i < nkeys; i += 64) { const float e = __expf(s[i] - ms); s[i] = e; sum += e; }
        sum = wave_sum(sum); const float inv = sum > 0.f ? 1.f / fmaxf(sum, 1e-30f) : 0.f;
        for (int i = lane; i < nkeys; i += 64) s[i] *= inv; }
    (void)red; (void)tid;
}
__device__ __forceinline__ float dot64(const float* kr, const LAS float* q) {
    float acc = 0.f;
#pragma unroll
    for (int c = 0; c < 16; ++c) { const f32x4 k = *(const GAS f32x4*)(kr + 4 * c); const f32x4 qq = *(const LAS f32x4*)(q + 4 * c); acc += (k.x * qq.x + k.y * qq.y) + (k.z * qq.z + k.w * qq.w); }
    return acc;
}
__device__ __forceinline__ void nsa_attn_sample(Frame& F, const Args& a, int l, int unit) {
    constexpr int SP = 1152;
    LAS float* qs = (LAS float*)(F.lds + RING_OFF);
    LAS float* sc = qs + 256;
    LAS float* impv = sc + 4 * SP;
    LAS float* red = impv + 192;
    LAS int* list = (LAS int*)(red + 512);
    LAS int* flag = list + 16;
    const int tid = F.tid, lane = F.lane, wave = F.wave, bs = unit >> 1, g = unit & 1; const size_t row = MP + bs;
    const bf16* P = WSP(bf16, WS_P); const float* SC = WSP(float, WS_SC); const int* pt = INP(int, I_PT) + bs * NPAGES;
    if (tid < 256) qs[tid] = 0.125f * bf2f(P[row * NINP + PC_QB + (4 * g + (tid >> 6)) * 64 + (tid & 63)]);
    float oacc = 0.f;
    const int r_ = (tid >> 6) & 3, d_ = tid & 63, half = tid >> 8;
    __syncthreads();
    const float* KCS = WSP(float, SMP_KCS) + (size_t)unit * 512 * 64; const float* VCS = WSP(float, SMP_VCS) + (size_t)unit * 512 * 64;
    if (tid < NCMP) { const float* kr = KCS + (size_t)tid * 64;
#pragma unroll
        for (int r = 0; r < 4; ++r) sc[r * SP + tid] = dot64(kr, qs + r * 64); }
    __syncthreads();
    nsa_sample_softmax(sc, NCMP, SP, red, tid, lane, wave);
    __syncthreads();
    if (tid < 129) { float v = 0.f;
        if (tid < 128) { for (int r = 0; r < 4; ++r) { const LAS float* p = sc + r * SP; for (int q = -1; q < 4; ++q) { const int n = 4 * tid + q; if (n >= 0 && n < NCMP) v += p[n]; } } }
        impv[tid] = (tid == 0 || tid == 128) ? 1e9f : v; }
    { float part = 0.f; const LAS float* p = sc + r_ * SP; const int n0 = half * 256, n1 = half ? NCMP : 256;
      for (int n = n0; n < n1; ++n) part += p[n] * VCS[(size_t)n * 64 + d_];
      red[half * 256 + (tid & 255)] = part; }
    __syncthreads();
    if (tid < 256) oacc += sigmoidf_(SC[row * 32 + 8 + (4 * g + r_) * 3 + 0]) * (red[tid] + red[256 + tid]);
    if (tid < 129) { const float v = impv[tid]; int c = 0; for (int i = 0; i < 129; ++i) { const float x = impv[i]; c += (x > v || (x == v && i < tid)) ? 1 : 0; } flag[tid] = c < NSEL ? 1 : 0; }
    __syncthreads();
    if (tid == 0) { int n = 0; for (int j = 0; j < 129; ++j) if (flag[j] && n < NSEL) list[n++] = j; for (; n < NSEL; ++n) list[n] = -1; }
    __syncthreads();
    const float* CS = INP(float, I_CSLC) + (size_t)l * NPOOL * PAGE * KVW; const float* newslc = a.out + O_SLC_S + (size_t)(l * MS + bs) * KVW;
    for (int pr = tid; pr < 1024; pr += NTHR) { const int jb = list[pr >> 6], kk = pr & 63; const float* kr = nullptr;
        if (jb >= 0 && jb < 128) { const int pos = jb * 64 + kk; kr = CS + ((size_t)pt[pos >> 7] * PAGE + (pos & 127)) * KVW + g * 64; }
        else if (jb == 128 && kk == 0) kr = newslc + g * 64;
#pragma unroll
        for (int r = 0; r < 4; ++r) sc[r * SP + pr] = kr ? dot64(kr, qs + r * 64) : -INFINITY; }
    __syncthreads();
    nsa_sample_softmax(sc, 1024, SP, red, tid, lane, wave);
    __syncthreads();
    { float part = 0.f; const LAS float* p = sc + r_ * SP;
      for (int pr = half * 512; pr < half * 512 + 512; ++pr) { const int jb = list[pr >> 6], kk = pr & 63; const float* vr = nullptr;
          if (jb >= 0 && jb < 128) { const int pos = jb * 64 + kk; vr = CS + ((size_t)pt[pos >> 7] * PAGE + (pos & 127)) * KVW + 128 + g * 64; }
          else if (jb == 128 && kk == 0) vr = newslc + 128 + g * 64;
          if (vr) part += p[pr] * vr[d_]; }
      red[half * 256 + (tid & 255)] = part; }
    __syncthreads();
    if (tid < 256) oacc += sigmoidf_(SC[row * 32 + 8 + (4 * g + r_) * 3 + 1]) * (red[tid] + red[256 + tid]);
    __syncthreads();
    const float* WB = INP(float, I_SWIN) + ((size_t)(l * MS + bs) * WINDOW) * KVW; const float* newwin = a.out + O_WIN_S + ((size_t)(l * MS + bs) * WINDOW + (WINDOW - 1)) * KVW;
    { const float* kr = tid < 511 ? WB + (size_t)(tid + 1) * KVW + g * 64 : newwin + g * 64;
#pragma unroll
      for (int r = 0; r < 4; ++r) sc[r * SP + tid] = dot64(kr, qs + r * 64); }
    __syncthreads();
    nsa_sample_softmax(sc, 512, SP, red, tid, lane, wave);
    __syncthreads();
    { float part = 0.f; const LAS float* p = sc + r_ * SP;
      for (int w = half * 256; w < half * 256 + 256; ++w) { const float* vr = w < 511 ? WB + (size_t)(w + 1) * KVW + 128 + g * 64 : newwin + 128 + g * 64; part += p[w] * vr[d_]; }
      red[half * 256 + (tid & 255)] = part; }
    __syncthreads();
    if (tid < 256) { oacc += sigmoidf_(SC[row * 32 + 8 + (4 * g + r_) * 3 + 2]) * (red[tid] + red[256 + tid]);
        (WSP(bf16, WS_OAB) + (size_t)MT * 512)[row * 512 + (4 * g + r_) * 64 + d_] = (bf16)f2bf(oacc); }
    __syncthreads();
}
__device__ __forceinline__ void fresh(Frame& F) { F.lane = my_lane(); F.tid = F.wave * 64 + F.lane; }
#ifndef MK_FUSED
#define MK_FUSED 1
#endif
__global__ void __launch_bounds__(NTHR, 2) mega(Args a) {
    extern __shared__ __attribute__((aligned(16))) unsigned char lds_raw[];
    Frame F;
    F.lds = (LAS unsigned char*)lds_raw;
    F.MISC = (volatile LAS unsigned*)(F.lds + MISC_OFF);
    F.wave = __builtin_amdgcn_readfirstlane((int)threadIdx.x >> 6); F.lane = my_lane(); F.tid = F.wave * 64 + F.lane;
    F.G = gridDim.x; F.bid = blockIdx.x;
    F.ctl = (gu32*)(a.ws + WS_CTL);
    for (int u = F.tid; u < (LDS_BYTES - LDSCTL_OFF) / 4; u += NTHR) ((LAS unsigned*)(F.lds + LDSCTL_OFF))[u] = 0u;
    __syncthreads();
    XcdBarrier bar; bar.bar = (unsigned*)(F.ctl + CW_BAR); bar.x = 0; bar.st = nullptr;
    if (MK_FUSED) bar = xcd_barrier_post((unsigned*)(F.ctl + CW_BAR), F.MISC + 8);
    const int lo = a.ph_lo, hi = a.ph_hi;
#define IN(k) (fresh(F), lo <= (k) && (k) < hi)
#define SEAM(k) do { if (MK_FUSED && IN(k) && IN((k) + 1)) xcd_barrier(bar); } while (0)

    if (IN(PH_PRO)) { p0_prologue(F, a); }
    SEAM(PH_PRO);
#pragma unroll
    for (int l = 0; l < 2; ++l) {
        const int pb = 1 + l * NPL;
        if (IN(pb + LP_LNMOD)) { if (l == 0) p_lnmod0(F, a); }
        SEAM(pb + LP_LNMOD);
        if (IN(pb + LP_INPROJ)) {
            pg8::Gemm g{WSP(bf16, WS_XN), WSP(bf16, WS_WIN_T) + (size_t)l * NINP * D, MT, NINP, D}; pg8::StaticOrder S; S.init(MT, NINP, F.G, F.bid);
            EpiIn E{WSP(bf16, WS_P), WSP(float, WS_SC), a.out, l};
            pg8::gemm_phase<EpiIn, pg8::StaticOrder, true, true>(F.lds + RING_OFF, g, S, E, F.tid);
        }
        SEAM(pb + LP_INPROJ);
        if (IN(pb + LP_PREP)) { gdn_prep(F, a, l); nsa_prep(F, a, l); }
        SEAM(pb + LP_PREP);
        if (IN(pb + LP_CMP1)) {
            pg8::Gemm g{WSP(bf16, SMP_SEG) + (size_t)l * 2 * SEGROWS * 1024, WSP(bf16, WS_CW1_T) + (size_t)l * 1024 * 1024, 2 * SEGROWS, 512, 1024}; CmpOrder S{F.G, F.bid};
            EpiBf16P E{WSP(bf16, SMP_HP), 512};
            pg8::gemm_phase<EpiBf16P, CmpOrder, true, true>(F.lds + RING_OFF, g, S, E, F.tid);
        }
        SEAM(pb + LP_CMP1);
        if (IN(pb + LP_CMP2)) { nsa_cmp2(F, a, l); }
        SEAM(pb + LP_CMP2);
        if (IN(pb + LP_MIX)) {
            if (F.bid < 8) gdn_scan(F, a, l, F.bid);
            else {
                const int wb = F.bid - 8, nwb_ = F.G - 8;
                for (int idx = wb; idx < 128; idx += nwb_) gdn_sample(F, a, l, idx);
                fresh(F);
                for (int idx = wb - 128; idx < 64; idx += nwb_) { if (idx >= 0) nsa_attn_sample(F, a, l, idx); }
                fresh(F);
                for (int L = wb; L < 512; L += nwb_) nsa_attn_tile(F, a, l, (L >> 1) & 1, L & 1, 127 - (L >> 2));
            }
        }
        SEAM(pb + LP_MIX);
        if (IN(pb + LP_ONORM)) { gdn_onorm(F, a, l); }
        SEAM(pb + LP_ONORM);
        if (IN(pb + LP_UP)) {
            pg8::Gemm g{WSP(bf16, WS_OAB), WSP(bf16, WS_WUP_T) + (size_t)l * 2048 * 512, MT, 1024, 512}; ChainOrder S{F.G, F.bid};
            EpiUp E{WSP(bf16, WS_P), WSP(bf16, WS_U)};
            pg8::gemm_phase<EpiUp, ChainOrder, true, true>(F.lds + RING_OFF, g, S, E, F.tid);
        }
        SEAM(pb + LP_UP);
        if (IN(pb + LP_OUT)) {
            pg8::Gemm g{WSP(bf16, WS_U), WSP(bf16, WS_WOUT_T) + (size_t)l * D * D, MT, D, D}; pg8::StaticOrder S; S.init(MT, D, F.G, F.bid);
            EpiF32 E{WSP(float, WS_Y)};
            pg8::gemm_phase<EpiF32, pg8::StaticOrder, true, true>(F.lds + RING_OFF, g, S, E, F.tid);
        }
        SEAM(pb + LP_OUT);
        if (IN(pb + LP_LN1)) {
            if (l == 0) p_lnpass<1, false>(F, a, 0, 0, nullptr, WSP(float, WS_XA), WSP(float, WS_Y));
            else        p_lnpass<1, true>(F, a, 1, 0, WSP(float, WS_XB), WSP(float, WS_XA), WSP(float, WS_Y));
        }
        SEAM(pb + LP_LN1);
        if (IN(pb + LP_MOEG)) { if (l == 1) p_moe_gather(F, a); }
        SEAM(pb + LP_MOEG);
        if (IN(pb + LP_FFN1)) {
            EpiSwiglu E{WSP(bf16, WS_ACT)};
            if (l == 0) { pg8::Gemm g{WSP(bf16, WS_XN), WSP(bf16, WS_WGU_T), MT, 2 * DFF, D}; pg8::StaticOrder S; S.init(MT, 2 * DFF, F.G, F.bid);
                pg8::gemm_phase<EpiSwiglu, pg8::StaticOrder, true, true>(F.lds + RING_OFF, g, S, E, F.tid); }
            else { pg8::Gemm g{WSP(bf16, WS_APERM), WSP(bf16, WS_MGU_T), MT, 2 * DFF, D}; MoeOrder<22> S{F.G, F.bid, WSP(int, MOE_META)};
                pg8::gemm_phase<EpiSwiglu, MoeOrder<22>, true, true>(F.lds + RING_OFF, g, S, E, F.tid); }
        }
        SEAM(pb + LP_FFN1);
        if (IN(pb + LP_FFN2)) {
            EpiF32 E{WSP(float, WS_Y)};
            if (l == 0) { pg8::Gemm g{WSP(bf16, WS_ACT), WSP(bf16, WS_WDN_T), MT, D, DFF}; pg8::StaticOrder S; S.init(MT, D, F.G, F.bid);
                pg8::gemm_phase<EpiF32, pg8::StaticOrder, true, true>(F.lds + RING_OFF, g, S, E, F.tid); }
            else { pg8::Gemm g{WSP(bf16, WS_ACT), WSP(bf16, WS_MDN_T), MT, D, DFF}; MoeOrder<4> S{F.G, F.bid, WSP(int, MOE_META)};
                pg8::gemm_phase<EpiF32, MoeOrder<4>, true, true>(F.lds + RING_OFF, g, S, E, F.tid); }
        }
        SEAM(pb + LP_FFN2);
        if (IN(pb + LP_LN2)) {
            if (l == 0) p_lnpass<1, false>(F, a, 0, 1, WSP(float, WS_XA), WSP(float, WS_XB), WSP(float, WS_Y));
            else        p_lnpass<2, false>(F, a, 1, 1, WSP(float, WS_XA), nullptr, WSP(float, WS_Y));
        }
        SEAM(pb + LP_LN2);
    }
#undef IN
#undef SEAM
}

extern "C" void kernel_launch(void* const* d_in, const int* in_sizes, int n_in, void* d_out, int out_size, void* d_ws, size_t ws_size, hipStream_t stream) {
    static int grid = 0;
    if (grid == 0) {
        if (n_in != N_INPUTS || (size_t)out_size != O_END || ws_size < WS_END) { fprintf(stderr, "kernel_launch: unexpected shapes: n_in %d out %d ws %zu (need %zu)\n", n_in, out_size, ws_size, (size_t)WS_END); grid = -1; return; }
        int dev = 0, cus = 0, per_cu = 0;
        if (hipGetDevice(&dev) != hipSuccess || hipDeviceGetAttribute(&cus, hipDeviceAttributeMultiprocessorCount, dev) != hipSuccess) { grid = -1; return; }
        if (hipFuncSetAttribute((const void*)mega, hipFuncAttributeMaxDynamicSharedMemorySize, LDS_BYTES) != hipSuccess) { fprintf(stderr, "kernel_launch: hipFuncSetAttribute failed\n"); grid = -1; return; }
        if (hipOccupancyMaxActiveBlocksPerMultiprocessor(&per_cu, (const void*)mega, NTHR, LDS_BYTES) != hipSuccess || per_cu < 1) fprintf(stderr, "kernel_launch: occupancy query says %d\n", per_cu);
        (void)hipGetLastError();
        grid = cus;
    }
    if (grid < 0) return;
    if (hipMemsetAsync((char*)d_ws + WS_CTL, 0, ZERO_BYTES, stream) != hipSuccess) return;
    Args a{};
    for (int i = 0; i < N_INPUTS; ++i) a.in[i] = d_in[i];
    a.out = (float*)d_out; a.ws = (unsigned char*)d_ws;
#if MK_FUSED
    a.ph_lo = 0; a.ph_hi = NPH;
    hipLaunchKernelGGL(mega, dim3(grid), dim3(NTHR), LDS_BYTES, stream, a);
#else
    for (int ph = 0; ph < NPH; ++ph) {
        const int lp = ph == 0 ? -1 : (ph - 1) % NPL, l = ph == 0 ? 0 : (ph - 1) / NPL;
        const bool active = ph == 0 || (lp == LP_LNMOD && l == 0) || lp == LP_INPROJ || lp == LP_PREP || lp == LP_CMP1 || lp == LP_CMP2 || lp == LP_MIX || lp == LP_ONORM || lp == LP_UP || lp == LP_OUT || lp == LP_LN1 || (lp == LP_MOEG && l == 1) || lp == LP_FFN1 || lp == LP_FFN2 || lp == LP_LN2;
        if (!active) continue;
        a.ph_lo = ph; a.ph_hi = ph + 1;
        hipLaunchKernelGGL(mega, dim3(grid), dim3(NTHR), LDS_BYTES, stream, a);
    }
#endif
}
```

```cpp
#include <hip/hip_runtime.h>
#include <cstdio>
#include <cstdint>
namespace pg8 {
#define PG8_LAS __attribute__((address_space(3)))
typedef unsigned short bf16_t;
typedef short bf16x8 __attribute__((ext_vector_type(8)));
typedef float f32x4 __attribute__((ext_vector_type(4)));
typedef unsigned u32x4 __attribute__((ext_vector_type(4)));
constexpr int BM = 256, BK = 64, HALF = 128, HTB = HALF * BK * 2  , STAGE_BYTES = 8 * HTB, NXCD = 8, WGM = 8;

__host__ __device__ __forceinline__ int lds_byte(int r, int c) { const int st = (r >> 4) * 2 + (c >> 5), rr = r & 15, cc = c & 31, ob = rr * 64 + cc * 2; return st * 1024 + (ob ^ (((ob >> 9) & 1) << 5)); }
__host__ __device__ __forceinline__ void stage_rc(int b, int& R, int& C) { const int st = b / 1024, sb = b % 1024, swz = sb ^ (((sb >> 9) & 1) << 5); R = (st >> 1) * 16 + swz / 64; C = (st & 1) * 32 + (swz % 64) / 2; }
__host__ __device__ __forceinline__ int perm32(int rho) { const int n = rho >> 4, i = rho & 15; return 8 * (i >> 2) + 4 * n + (i & 3); }

struct Unit { int pm, pn, am, bn, am2, bn2; };
struct Gemm { const bf16_t* A; const bf16_t* Bt; int M, N, K; };

struct StaticOrder {
    int nM, nN, nwg, G, c;
    __host__ __device__ void init(int M, int N, int G_, int c_) { nM = M / BM; nN = N / BM; nwg = nM * nN; G = G_; c = c_; }
    __host__ __device__ bool next(int i, Unit& u) const {
        const long L = (long)i * G + c; if (L >= nwg) return false;
        int wgid = (int)L; { const int q = nwg / NXCD, r = nwg % NXCD, xcd = wgid % NXCD, off = wgid / NXCD; wgid = (xcd < r ? xcd * (q + 1) : r * (q + 1) + (xcd - r) * q) + off; }
        const int nig = WGM * nN, gid = wgid / nig, fm = gid * WGM, gsz = (nM - fm) < WGM ? (nM - fm) : WGM;
        u.pm = fm + ((wgid % nig) % gsz); u.pn = (wgid % nig) / gsz; u.am = u.pm; u.bn = u.pn; u.am2 = 0; u.bn2 = 0; return true;
    }
    __device__ __forceinline__ void a_ready(const Unit&) const {}
    __device__ __forceinline__ void done(const Unit&) const {}
};

template <class Epi, class Sched, bool ALIGN_EPI = false, bool SP2 = false>
__device__ __forceinline__ void gemm_phase(PG8_LAS unsigned char* lds, const Gemm g, const Sched& S, const Epi& E, int tid_in) {
    int tid_ = tid_in; asm volatile("" : "+v"(tid_));
    const int tid = tid_, wid = __builtin_amdgcn_readfirstlane(tid >> 6), lane = tid & 63, wr = wid >> 2, wc = wid & 3, fr = lane & 15, fq = lane >> 4;
    const int K = g.K, nt = K / BK, ntot = Epi::CHAIN ? 2 * nt : nt;
    unsigned voffA[2], voffB[2];
#pragma unroll
    for (int i = 0; i < 2; ++i) { int R, C; stage_rc(tid * 16 + i * 8192, R, C); const int Rb = Epi::PERM ? ((R & ~31) + perm32(R & 31)) : R;
        voffA[i] = (unsigned)(R * K + C) * 2u; voffB[i] = (unsigned)(Rb * K + C) * 2u; }
    const size_t kstep = (size_t)(BK * 2);
    const size_t hstep = (size_t)HALF * K * 2;
    const size_t tstep = 2 * hstep;
    const unsigned ldsw = (unsigned)wid * 1024u;
    const int aoff = lds_byte(wr * 64 + fr, fq * 8), boff = lds_byte(wc * 32 + fr, fq * 8);
#define PG8_SA(b, h) (((b) * 2 + (h)) * HTB)
#define PG8_SB(b, h) ((4 + (b) * 2 + (h)) * HTB)
#define PG8_STAGE(bufoff, gbase, voff) do { _Pragma("unroll") for (int _i = 0; _i < 2; ++_i) \
        __builtin_amdgcn_global_load_lds((const unsigned*)((const char*)(gbase) + (voff)[_i]), (PG8_LAS unsigned*)(lds + (bufoff) + ldsw + _i * 8192), 16, 0, 0); } while (0)
#define PG8_LDA(dst, b, h) do { _Pragma("unroll") for (int m = 0; m < 4; ++m) _Pragma("unroll") for (int k = 0; k < 2; ++k) dst[m][k] = *(const PG8_LAS bf16x8*)(lds + PG8_SA(b, h) + aoff + m * 2048 + k * 1024); } while (0)
#define PG8_LDB(dst, b, h) do { _Pragma("unroll") for (int n = 0; n < 2; ++n) _Pragma("unroll") for (int k = 0; k < 2; ++k) dst[n][k] = *(const PG8_LAS bf16x8*)(lds + PG8_SB(b, h) + boff + n * 2048 + k * 1024); } while (0)
#define PG8_MMA(ai, bj, At, Bt) do { __builtin_amdgcn_s_setprio(1); _Pragma("unroll") for (int m = 0; m < 4; ++m) _Pragma("unroll") for (int n = 0; n < 2; ++n) _Pragma("unroll") for (int k = 0; k < 2; ++k) \
        acc[ai][bj][m][n] = __builtin_amdgcn_mfma_f32_16x16x32_bf16(Bt[n][k], At[m][k], acc[ai][bj][m][n], 0, 0, 0); __builtin_amdgcn_s_setprio(0); } while (0)
#define PG8_WAIT_V(n) asm volatile("s_waitcnt vmcnt(" #n ")" ::: "memory")
#define PG8_WAIT_L(n) asm volatile("s_waitcnt lgkmcnt(" #n ")" ::: "memory")
#define PG8_BAR __builtin_amdgcn_s_barrier()
#define PG8_SCHED __builtin_amdgcn_sched_barrier(0)
    Unit cur, nxt; int ui = 0;
    if (!S.next(0, cur)) return;
    f32x4 acc[2][2][4][2];
#pragma unroll
    for (int a = 0; a < 2; ++a)
#pragma unroll
        for (int b = 0; b < 2; ++b)
#pragma unroll
            for (int m = 0; m < 4; ++m)
#pragma unroll
                for (int n = 0; n < 2; ++n) acc[a][b][m][n] = (f32x4){0.f, 0.f, 0.f, 0.f};
    bf16x8 At[4][2], B0[2][2], B1[2][2];
    const char* cA = (const char*)g.A + (size_t)cur.am * tstep; const char* cB = (const char*)g.Bt + (size_t)cur.bn * tstep;
    const char* cA2 = cA; const char* cB2 = cB; if constexpr (Epi::CHAIN) { cA2 = (const char*)g.A + (size_t)cur.am2 * tstep; cB2 = (const char*)g.Bt + (size_t)cur.bn2 * tstep; }
#define PG8_TA(x) ((Epi::CHAIN && (x) >= nt) ? cA2 + (size_t)((x) - nt) * kstep : cA + (size_t)(x) * kstep)
#define PG8_TB(x) ((Epi::CHAIN && (x) >= nt) ? cB2 + (size_t)((x) - nt) * kstep : cB + (size_t)(x) * kstep)
    S.a_ready(cur);
    if constexpr (SP2) {
        PG8_STAGE(PG8_SB(0, 0), cB, voffB); PG8_STAGE(PG8_SB(0, 1), cB + hstep, voffB); PG8_STAGE(PG8_SA(0, 0), cA, voffA); PG8_STAGE(PG8_SA(0, 1), cA + hstep, voffA);
        if (wr == 1) PG8_BAR;
        PG8_WAIT_V(2); PG8_BAR;
        PG8_STAGE(PG8_SB(1, 0), cB + kstep, voffB); PG8_STAGE(PG8_SA(1, 0), cA + kstep, voffA); PG8_STAGE(PG8_SB(1, 1), cB + hstep + kstep, voffB);
        PG8_WAIT_V(6); PG8_BAR;
    } else {
        PG8_STAGE(PG8_SB(0, 0), cB, voffB); PG8_STAGE(PG8_SA(0, 0), cA, voffA); PG8_STAGE(PG8_SB(0, 1), cB + hstep, voffB); PG8_STAGE(PG8_SA(0, 1), cA + hstep, voffA);
        if (wr == 1) PG8_BAR;
        PG8_WAIT_V(4); PG8_BAR;
        PG8_STAGE(PG8_SB(1, 0), cB + kstep, voffB); PG8_STAGE(PG8_SA(1, 0), cA + kstep, voffA); PG8_STAGE(PG8_SB(1, 1), cB + hstep + kstep, voffB);
        PG8_WAIT_V(6); PG8_BAR;
    }
    for (;;) {
        const bool has_next = S.next(ui + 1, nxt);
        const char* nA = has_next ? (const char*)g.A + (size_t)nxt.am * tstep : cA; const char* nB = has_next ? (const char*)g.Bt + (size_t)nxt.bn * tstep : cB;
        for (int t = 0; t < ntot; t += 2) {
            if constexpr (Epi::CHAIN) { if (t == nt) E.mid(acc, cur, wr, wc, fr, fq); }
            const bool last = (t == ntot - 2);
            const char* a1 = PG8_TA(t + 1);
            const char* a2 = last ? nA : PG8_TA(t + 2); const char* b2 = last ? nB : PG8_TB(t + 2);
            const char* a3 = a2 + kstep; const char* b3 = b2 + kstep;
            if (last && has_next) S.a_ready(nxt);
            if constexpr (SP2) {
            PG8_LDB(B0, 0, 0); PG8_LDB(B1, 0, 1); PG8_SCHED; PG8_LDA(At, 0, 0); PG8_STAGE(PG8_SA(1, 1), a1 + hstep, voffA);
            PG8_WAIT_V(8); PG8_WAIT_L(0); PG8_BAR; PG8_MMA(0, 0, At, B0); PG8_MMA(0, 1, At, B1); PG8_BAR; PG8_SCHED;
            PG8_LDA(At, 0, 1); PG8_STAGE(PG8_SB(0, 0), b2, voffB); PG8_STAGE(PG8_SB(0, 1), b2 + hstep, voffB); PG8_STAGE(PG8_SA(0, 0), a2, voffA);
            PG8_WAIT_V(8); PG8_WAIT_L(0); PG8_BAR; PG8_MMA(1, 0, At, B0); PG8_MMA(1, 1, At, B1); PG8_BAR; PG8_SCHED;
            PG8_LDB(B0, 1, 0); PG8_LDB(B1, 1, 1); PG8_SCHED; PG8_LDA(At, 1, 0); PG8_STAGE(PG8_SA(0, 1), a2 + hstep, voffA);
            PG8_WAIT_V(8); PG8_WAIT_L(0); PG8_BAR; PG8_MMA(0, 0, At, B0); PG8_MMA(0, 1, At, B1); PG8_BAR; PG8_SCHED;
            PG8_LDA(At, 1, 1); PG8_STAGE(PG8_SB(1, 0), b3, voffB); PG8_STAGE(PG8_SB(1, 1), b3 + hstep, voffB); PG8_STAGE(PG8_SA(1, 0), a3, voffA);
            PG8_WAIT_V(8); PG8_WAIT_L(0); PG8_BAR; PG8_MMA(1, 0, At, B0); PG8_MMA(1, 1, At, B1); PG8_BAR; PG8_SCHED;
            } else {
            PG8_LDB(B0, 0, 0); PG8_SCHED; PG8_LDA(At, 0, 0); PG8_STAGE(PG8_SA(1, 1), a1 + hstep, voffA);
            PG8_WAIT_L(8); PG8_BAR; PG8_WAIT_L(0); PG8_MMA(0, 0, At, B0); PG8_BAR; PG8_SCHED;
            PG8_LDB(B1, 0, 1); PG8_STAGE(PG8_SB(0, 0), b2, voffB);
            PG8_BAR; PG8_WAIT_L(0); PG8_MMA(0, 1, At, B1); PG8_BAR;
            PG8_LDA(At, 0, 1); PG8_STAGE(PG8_SA(0, 0), a2, voffA);
            PG8_BAR; PG8_WAIT_L(0); PG8_MMA(1, 0, At, B0); PG8_BAR; PG8_SCHED;
            PG8_STAGE(PG8_SB(0, 1), b2 + hstep, voffB);
            PG8_WAIT_V(6); PG8_BAR; PG8_MMA(1, 1, At, B1); PG8_BAR;
            PG8_LDB(B0, 1, 0); PG8_SCHED; PG8_LDA(At, 1, 0); PG8_STAGE(PG8_SA(0, 1), a2 + hstep, voffA);
            PG8_WAIT_L(8); PG8_BAR; PG8_WAIT_L(0); PG8_MMA(0, 0, At, B0); PG8_BAR; PG8_SCHED;
            PG8_LDB(B1, 1, 1); PG8_STAGE(PG8_SB(1, 0), b3, voffB);
            PG8_BAR; PG8_WAIT_L(0); PG8_MMA(0, 1, At, B1); PG8_BAR;
            PG8_LDA(At, 1, 1); PG8_STAGE(PG8_SA(1, 0), a3, voffA);
            PG8_BAR; PG8_WAIT_L(0); PG8_MMA(1, 0, At, B0); PG8_BAR; PG8_SCHED;
            PG8_STAGE(PG8_SB(1, 1), b3 + hstep, voffB);
            PG8_WAIT_V(6); PG8_BAR; PG8_MMA(1, 1, At, B1); PG8_BAR;
            }
        }
        if constexpr (ALIGN_EPI) { if (wr == 0) PG8_BAR; }
        if constexpr (!Epi::AFTER_DRAIN) { E(acc, cur, wr, wc, fr, fq); S.done(cur); }
        if (!has_next) break;
#pragma unroll
        for (int a = 0; a < 2; ++a)
#pragma unroll
            for (int b = 0; b < 2; ++b)
#pragma unroll
                for (int m = 0; m < 4; ++m)
#pragma unroll
                    for (int n = 0; n < 2; ++n) acc[a][b][m][n] = (f32x4){0.f, 0.f, 0.f, 0.f};
        cur = nxt; cA = nA; cB = nB; ++ui;
        if constexpr (Epi::CHAIN) { cA2 = (const char*)g.A + (size_t)cur.am2 * tstep; cB2 = (const char*)g.Bt + (size_t)cur.bn2 * tstep; }
        if constexpr (ALIGN_EPI) { if (wr == 1) PG8_BAR; }
    }
    PG8_WAIT_V(0);
    if constexpr (!ALIGN_EPI) { if (wr == 0) PG8_BAR; }
    PG8_BAR;
    if constexpr (Epi::AFTER_DRAIN) { E.fused(acc, cur, wr, wc, fr, fq, lds, wid, lane); S.done(cur); }
#undef PG8_SA
#undef PG8_SB
#undef PG8_STAGE
#undef PG8_LDA
#undef PG8_LDB
#undef PG8_MMA
#undef PG8_WAIT_V
#undef PG8_WAIT_L
#undef PG8_BAR
#undef PG8_SCHED
#undef PG8_TA
#undef PG8_TB
}
}
#define GAS __attribute__((address_space(1)))
#define LAS __attribute__((address_space(3)))
typedef unsigned short bf16;
typedef unsigned v4u __attribute__((ext_vector_type(4)));
typedef unsigned v2u __attribute__((ext_vector_type(2)));
typedef float f32x4 __attribute__((ext_vector_type(4)));
typedef float f32x2 __attribute__((ext_vector_type(2)));
typedef short bf16x8 __attribute__((ext_vector_type(8)));
typedef short bf16x4 __attribute__((ext_vector_type(4)));
typedef GAS unsigned gu32;
#define RLX_AGENT __ATOMIC_RELAXED, __HIP_MEMORY_SCOPE_AGENT
#define LDS_WAIT() asm volatile("s_waitcnt lgkmcnt(0)" ::: "memory")
#define VM_WAIT() asm volatile("s_waitcnt vmcnt(0)" ::: "memory")
#define LBAR() do { asm volatile("s_waitcnt lgkmcnt(0)" ::: "memory"); __builtin_amdgcn_s_barrier(); asm volatile("" ::: "memory"); } while (0)

constexpr int NWAVES = 8, NTHR = 512;
constexpr int D = 1024, SEQ = 8192, NB = 2, MP = NB * SEQ, MS = 32, MT = 16640, NTILE_M = MT / 256, MREAL = MP + MS;
constexpr int H_A = 4, DK = 128, DV = 128, CQKV = 1536, CHUNK = 64, NCHUNK = SEQ / CHUNK;
constexpr int H_B = 8, G_B = 2, DH = 64, KVW = 256;
constexpr int NCMP = 511, NSLC = 128, NSEL = 16, WINDOW = 512;
constexpr int DFF = 2816, NEXP = 8;
constexpr int NIN = 5408, NINP = 5632;
constexpr int PAST = 8192, PAGE = 128, NPAGES = 64, NPOOL = 2560;
constexpr float ALPHA = 1.4142135623730951f;
constexpr float LN_EPS = 1e-5f;
constexpr int PC_QKV = 0, PC_Z = 1536, PC_QB = 2048, PC_KVC = 2560, PC_KVS = 2816, PC_KVW = 3072, PC_GM = 3328, PC_SM = 5376;

constexpr size_t O_YP = 0, O_YS = O_YP + (size_t)MP * D, O_DELTA_P = O_YS + (size_t)MS * D, O_CONV_P = O_DELTA_P + 2ull * 2 * 4 * 128 * 128,
    O_CMP_P = O_CONV_P + 2ull * 2 * 3 * 1536, O_SLC_P = O_CMP_P + 2ull * 2 * 8192 * 256, O_WIN_P = O_SLC_P + 2ull * 2 * 8192 * 256,
    O_DELTA_S = O_WIN_P + 2ull * 2 * 512 * 256, O_CONV_S = O_DELTA_S + 2ull * 32 * 4 * 128 * 128, O_CMP_S = O_CONV_S + 2ull * 32 * 3 * 1536,
    O_SLC_S = O_CMP_S + 2ull * 32 * 256, O_WIN_S = O_SLC_S + 2ull * 32 * 256, O_END = O_WIN_S + 2ull * 32 * 512 * 256;

enum { I_XP = 0, I_XS, I_SDELTA, I_SCONV, I_CCMP, I_CSLC, I_SWIN, I_PT, I_CP, I_CS, I_WADA, I_BADA, I_WIN, I_CONVW, I_ALOG, I_DTB, I_NORMW,
       I_CPOS, I_CW1, I_CW2, I_WUPA, I_WUPB, I_WOUT, I_LNG, I_LNB, I_FGU, I_FDN, I_MR, I_MGU, I_MDN, N_INPUTS };

constexpr size_t MiB = 1u << 20;
constexpr size_t WS_CTL = 0, WS_MOD = 1 * MiB, ZERO_BYTES = 4 * MiB;
constexpr size_t WS_WIN_T = 4 * MiB, WS_WUP_T = 26 * MiB, WS_WOUT_T = 30 * MiB, WS_WGU_T = 34 * MiB, WS_WDN_T = 45 * MiB, WS_MGU_T = 51 * MiB, WS_MDN_T = 139 * MiB, WS_CW1_T = 183 * MiB;
constexpr size_t WS_XN = 192 * MiB, WS_P = 225 * MiB, WS_SC = 404 * MiB, WS_XA = 407 * MiB, WS_XB = 472 * MiB, WS_Y = 537 * MiB, WS_OAB = 674 * MiB, WS_U = 707 * MiB,
    WS_ACT = 740 * MiB, WS_APERM = 929 * MiB, WS_MOE = 998 * MiB;
constexpr size_t WS_GDN = 1000 * MiB, WS_NSA = 1110 * MiB, WS_SMP = 1150 * MiB, WS_END = 1560 * MiB;
constexpr int CW_TMO = 0, CW_BAR = 4096;
constexpr int MODROWS = 34, MODW = 6144;

constexpr int RING_OFF = 0, RING_BYTES = 131072;
constexpr int LDSCTL_OFF = RING_BYTES, MISC_OFF = LDSCTL_OFF + 320;
constexpr int LDS_BYTES = 147456;

typedef float f32x2_t_ __attribute__((ext_vector_type(2))); typedef __bf16 bf16x2_t_ __attribute__((ext_vector_type(2)));
__device__ __forceinline__ unsigned pk2(float lo, float hi) { f32x2_t_ v = {lo, hi}; bf16x2_t_ b = __builtin_convertvector(v, bf16x2_t_); return __builtin_bit_cast(unsigned, b); }
__device__ __forceinline__ unsigned f2bf(float f) { return pk2(f, f) & 0xffffu; }
__device__ __forceinline__ float bf2f(unsigned short b) { return __builtin_bit_cast(float, (unsigned)b << 16); }
__device__ __forceinline__ float bflo(unsigned w) { return __builtin_bit_cast(float, w << 16); }
__device__ __forceinline__ float bfhi(unsigned w) { return __builtin_bit_cast(float, w & 0xffff0000u); }
__device__ __forceinline__ float add1(float e) { float one = 1.f; asm volatile("" : "+v"(one)); return e + one; }
__device__ __forceinline__ float sigmoidf_(float x) { return __builtin_amdgcn_rcpf(add1(__expf(-x))); }
__device__ __forceinline__ float siluf_(float x) { return x * __builtin_amdgcn_rcpf(add1(__expf(-x))); }
__device__ __forceinline__ float softplusf_(float x) { const float e = __expf(x); return x > 20.f ? x : (e < 0.01f ? e * (1.f - e * (0.5f - e * 0.33333334f)) : __logf(1.f + e)); }
__device__ __forceinline__ int my_lane() { int l; asm volatile("v_mbcnt_lo_u32_b32 %0, -1, 0\n\tv_mbcnt_hi_u32_b32 %0, -1, %0" : "=v"(l)); return l; }
__device__ __forceinline__ float bperm(float v, int srclane) { return __builtin_bit_cast(float, __builtin_amdgcn_ds_bpermute(srclane << 2, __builtin_bit_cast(int, v))); }
template <int O> __device__ __forceinline__ float shx(float v) {
    if constexpr (O < 32) return __builtin_bit_cast(float, __builtin_amdgcn_ds_swizzle(__builtin_bit_cast(int, v), (O << 10) | 0x1f));
    else return bperm(v, my_lane() ^ 32);
}
__device__ __forceinline__ float wave_sum(float v) { v += shx<1>(v); v += shx<2>(v); v += shx<4>(v); v += shx<8>(v); v += shx<16>(v); v += shx<32>(v); return v; }
__device__ __forceinline__ float wave_max(float v) { v = fmaxf(v, shx<1>(v)); v = fmaxf(v, shx<2>(v)); v = fmaxf(v, shx<4>(v)); v = fmaxf(v, shx<8>(v)); v = fmaxf(v, shx<16>(v)); v = fmaxf(v, shx<32>(v)); return v; }
#define XB_TMO      128
#define XB_XCNT(j)  (256  + 64 * (j))
#define XB_XSUB(j)  (1280 + 64 * (j))
#define XB_XGEN(j)  (2304 + 64 * (j))
#define XB_TOP      3328
#define XB_TOPGEN   3392
#define XCD_BAR_WORDS 3456
#define XB_SPIN_CAP (1u << 18)

__device__ __forceinline__ unsigned xb_ld(unsigned* p)              { return __hip_atomic_load(p, __ATOMIC_RELAXED, __HIP_MEMORY_SCOPE_AGENT); }
__device__ __forceinline__ unsigned xb_add(unsigned* p, unsigned v) { return __hip_atomic_fetch_add(p, v, __ATOMIC_RELAXED, __HIP_MEMORY_SCOPE_AGENT); }
__device__ __forceinline__ unsigned xb_xcc_id() { return (unsigned)__builtin_amdgcn_s_getreg((3 << 11) | 20) & 0xFu; }
#define XB_SPIN(cond, bar) do { unsigned _sp = 0; while (cond) { __builtin_amdgcn_s_sleep(1); \
    if ((++_sp & 255u) == 0u) { if (xb_ld(&(bar)[XB_TMO])) break; if (_sp > XB_SPIN_CAP) { atomicAdd(&(bar)[XB_TMO], 1u); break; } } } } while (0)

struct XcdBarrier {
    unsigned* bar; unsigned x;
    volatile LAS unsigned* st;
};

__device__ __forceinline__ XcdBarrier xcd_barrier_post(unsigned* bar, volatile LAS unsigned* st) {
    XcdBarrier b; b.bar = bar; b.x = xb_xcc_id(); b.st = st;
    if (threadIdx.x == 0) (void)xb_add(&bar[XB_XCNT(b.x)], 1u);
    return b;
}
__device__ __forceinline__ void xcd_barrier_complete(unsigned* bar, unsigned x, unsigned& nloc, unsigned& nx) {
    const unsigned G = gridDim.x * gridDim.y * gridDim.z;
    unsigned sum, cnt, mine, sp = 0u;
    for (;;) {
        sum = 0u; cnt = 0u; mine = 0u;
#pragma unroll
        for (unsigned j = 0; j < 16; ++j) { const unsigned c = xb_ld(&bar[XB_XCNT(j)]); sum += c; cnt += (c > 0u) ? 1u : 0u; mine = (j == x) ? c : mine; }
        if (sum == G) break;
        __builtin_amdgcn_s_sleep(1);
        if ((++sp & 255u) == 0u) { if (xb_ld(&bar[XB_TMO])) break; if (sp > XB_SPIN_CAP) { atomicAdd(&bar[XB_TMO], 1u); break; } }
    }
    nloc = mine > 0u ? mine : 1u; nx = cnt > 0u ? cnt : 1u;
}

__device__ __forceinline__ void xcd_barrier(const XcdBarrier& b) {
    asm volatile("s_waitcnt vmcnt(0)" ::: "memory");
    __syncthreads();
    if (threadIdx.x == 0) {
        unsigned* bar = b.bar;
        __builtin_amdgcn_s_waitcnt(0);
        unsigned nloc = b.st[0], nx = b.st[1];
        if (nloc == 0u) { xcd_barrier_complete(bar, b.x, nloc, nx); b.st[0] = nloc; b.st[1] = nx; }
        const unsigned old = xb_add(&bar[XB_XSUB(b.x)], 1u);
        const unsigned gen = old / nloc;
        if (old + 1u == (gen + 1u) * nloc) {
            __builtin_amdgcn_fence(__ATOMIC_RELEASE, "agent");
            asm volatile("s_waitcnt vmcnt(0)" ::: "memory");
            const unsigned og = xb_add(&bar[XB_TOP], 1u);
            const unsigned tg = og / nx;
            if (og + 1u == (tg + 1u) * nx) xb_add(&bar[XB_TOPGEN], 1u);
            else XB_SPIN(xb_ld(&bar[XB_TOPGEN]) == tg, bar);
            __builtin_amdgcn_fence(__ATOMIC_ACQUIRE, "agent");
            xb_add(&bar[XB_XGEN(b.x)], 1u);
            asm volatile("s_waitcnt vmcnt(0)" ::: "memory");
        } else {
            XB_SPIN(xb_ld(&bar[XB_XGEN(b.x)]) == gen, bar);
            __builtin_amdgcn_fence(__ATOMIC_ACQUIRE, "agent");
            asm volatile("s_waitcnt vmcnt(0)" ::: "memory");
        }
    }
    __syncthreads();
}

struct Args { const void* in[30]; float* out; unsigned char* ws; int ph_lo, ph_hi; };
struct Frame {
    LAS unsigned char* lds;
    volatile LAS unsigned* MISC;
    gu32* ctl;
    int tid, lane, wave, G, bid;
};
__device__ __forceinline__ const void* ld_in(const Args& a, int i) { int z = 0; asm volatile("" : "+s"(z)); return a.in[i + z]; }
#define INP(T, i) ((const T*)ld_in(a, i))
__device__ __forceinline__ unsigned char* ws_base(const Args& a) { unsigned char* p = a.ws; asm volatile("" : "+s"(p)); return p; }
#define WSP(T, off) ((T*)(ws_base(a) + (off)))

constexpr int PH_PRO = 0, NPL = 14, NPH = 1 + 2 * NPL;
constexpr int LP_LNMOD = 0, LP_INPROJ = 1, LP_PREP = 2, LP_CMP1 = 3, LP_CMP2 = 4, LP_MIX = 5, LP_ONORM = 6, LP_UP = 7, LP_OUT = 8, LP_LN1 = 9, LP_MOEG = 10, LP_FFN1 = 11, LP_FFN2 = 12, LP_LN2 = 13;

__device__ __forceinline__ int srccol(int map, int n) {
    if (map == 0) return n;
    if (map == 1) {
        if (n < 2048) return n;
        if (n < 2560) return 2056 + (n - 2048);
        if (n < 3328) return 2568 + (n - 2560);
        if (n < 5376) { const int w = n - 3328; return 3360 + ((w >> 7) & 1) * 1024 + 128 * (w >> 8) + (w & 127); }
        if (n < 5384) return 2048 + (n - 5376);
        if (n < 5408) return 3336 + (n - 5384);
        return -1;
    }
    { const int pn = n >> 8, w = n & 255; return (w >> 7) * DFF + 128 * pn + (w & 127); }
}
__device__ __forceinline__ void transpose_item(const float* W, int K, int Nsrc, bf16* WT, int map, LAS float* scr, int kb, int nb, int lane) {
    const int k0 = 64 * kb, n0 = 32 * nb, sc = srccol(map, n0 + (lane & 31)); const float* wp = W + (size_t)(k0 + (lane >> 5)) * Nsrc + (sc >= 0 ? sc : 0);
    float x[32];
#pragma unroll
    for (int i = 0; i < 32; ++i) x[i] = wp[(size_t)(2 * i) * Nsrc];
#pragma unroll
    for (int i = 0; i < 32; ++i) scr[(2 * i + (lane >> 5)) * 33 + (lane & 31)] = sc >= 0 ? x[i] : 0.f;
    LDS_WAIT(); asm volatile("" ::: "memory");
    const int c = lane & 7;
#pragma unroll
    for (int j = 0; j < 4; ++j) { const int n = (lane >> 3) + 8 * j; const LAS float* s = scr + (8 * c) * 33 + n;
        v4u o; o.x = pk2(s[0 * 33], s[1 * 33]); o.y = pk2(s[2 * 33], s[3 * 33]); o.z = pk2(s[4 * 33], s[5 * 33]); o.w = pk2(s[6 * 33], s[7 * 33]);
        *(GAS v4u*)(WT + (size_t)(n0 + n) * K + k0 + 8 * c) = o; }
    LDS_WAIT(); asm volatile("" ::: "memory");
}
constexpr int CONV_ITEMS = 46720, CW_CONVQ = 3776;
struct ConvIt { const float* wp; bf16* wt; int K, ls; bool ok; };
__device__ __forceinline__ ConvIt conv_decode(Frame& F, const Args& a, int gi) {
    const float* W; bf16* WT; int K, Nsrc, Ndest, map = 0, it;
    if (gi < 5632) { const int l = gi / 2816; it = gi - l * 2816; W = INP(float, I_WIN) + (size_t)l * D * NIN; K = D; Nsrc = NIN; WT = WSP(bf16, WS_WIN_T) + (size_t)l * NINP * D; Ndest = NINP; map = 1; }
    else if (gi < 7680) { const int r = gi - 5632, l = r >> 10, rr = r & 1023;
        if (rr < 256) { it = rr; W = INP(float, I_WUPA) + (size_t)l * 512 * D; K = 512; Nsrc = D; WT = WSP(bf16, WS_WUP_T) + (size_t)l * 2048 * 512; Ndest = D; }
        else if (rr < 512) { it = rr - 256; W = INP(float, I_WUPB) + (size_t)l * 512 * D; K = 512; Nsrc = D; WT = WSP(bf16, WS_WUP_T) + (size_t)l * 2048 * 512 + (size_t)1024 * 512; Ndest = D; }
        else { it = rr - 512; W = INP(float, I_WOUT) + (size_t)l * D * D; K = D; Nsrc = D; WT = WSP(bf16, WS_WOUT_T) + (size_t)l * D * D; Ndest = D; } }
    else if (gi < 10496) { it = gi - 7680; W = INP(float, I_FGU); K = D; Nsrc = 2 * DFF; WT = WSP(bf16, WS_WGU_T); Ndest = 2 * DFF; map = 2; }
    else if (gi < 11904) { it = gi - 10496; W = INP(float, I_FDN); K = DFF; Nsrc = D; WT = WSP(bf16, WS_WDN_T); Ndest = D; }
    else if (gi < 45696) { const int r = gi - 11904, e = r / 4224, rr = r - e * 4224;
        if (rr < 2816) { it = rr; W = INP(float, I_MGU) + (size_t)e * D * 2 * DFF; K = D; Nsrc = 2 * DFF; WT = WSP(bf16, WS_MGU_T) + (size_t)e * 2 * DFF * D; Ndest = 2 * DFF; map = 2; }
        else { it = rr - 2816; W = INP(float, I_MDN) + (size_t)e * DFF * D; K = DFF; Nsrc = D; WT = WSP(bf16, WS_MDN_T) + (size_t)e * D * DFF; Ndest = D; } }
    else { const int r = gi - 45696, q = r >> 7; it = r & 127;
        W = INP(float, I_CW1) + ((size_t)(q >> 1) * 2048 + (size_t)(q & 1) * 1024) * 256; K = 1024; Nsrc = 256; WT = WSP(bf16, WS_CW1_T) + ((size_t)(q >> 1) * 512 + (size_t)(q & 1) * 256) * 1024; Ndest = 256; }
    const int nnb = Ndest / 32, kb = it / nnb, nb = it % nnb, k0 = 64 * kb, n0 = 32 * nb, sc = srccol(map, n0 + (F.lane & 31));
    ConvIt r; r.wp = W + (size_t)(k0 + (F.lane >> 5)) * Nsrc + (sc >= 0 ? sc : 0); r.wt = WT + (size_t)n0 * K + k0; r.K = K; r.ls = 2 * Nsrc; r.ok = sc >= 0; return r;
}
__device__ __forceinline__ void conv_load(float (&x)[32], const ConvIt& c) {
#pragma unroll
    for (int i = 0; i < 32; ++i) x[i] = c.wp[(size_t)i * c.ls];
}
__device__ __forceinline__ void conv_store(const float (&x)[32], const ConvIt& c, LAS float* scr, int lane) {
#pragma unroll
    for (int i = 0; i < 32; ++i) scr[(2 * i + (lane >> 5)) * 33 + (lane & 31)] = c.ok ? x[i] : 0.f;
    LDS_WAIT(); asm volatile("" ::: "memory");
    const int cc = lane & 7;
#pragma unroll
    for (int j = 0; j < 4; ++j) { const int n = (lane >> 3) + 8 * j; const LAS float* s = scr + (8 * cc) * 33 + n;
        v4u o; o.x = pk2(s[0 * 33], s[1 * 33]); o.y = pk2(s[2 * 33], s[3 * 33]); o.z = pk2(s[4 * 33], s[5 * 33]); o.w = pk2(s[6 * 33], s[7 * 33]);
        *(GAS v4u*)(c.wt + (size_t)n * c.K + 8 * cc) = o; }
    LDS_WAIT(); asm volatile("" ::: "memory");
}
__device__ __forceinline__ void conv_item(Frame& F, const Args& a, int gi, LAS float* scr) { const ConvIt c = conv_decode(F, a, gi); float x[32]; conv_load(x, c); conv_store(x, c, scr, F.lane); }

constexpr int CONV_MOE0 = 11904, CONV_MOE1 = 45696, CONV_PRO = CONV_ITEMS - (CONV_MOE1 - CONV_MOE0);
__device__ __forceinline__ void convert_all(Frame& F, const Args& a) {
    LAS float* scr = (LAS float*)(F.lds + RING_OFF + F.wave * 16384);
    for (;;) {
        int c = 0; if (F.lane == 0) c = (int)__hip_atomic_fetch_add(F.ctl + CW_CONVQ, 1u, __ATOMIC_RELAXED, __HIP_MEMORY_SCOPE_AGENT);
        c = __builtin_amdgcn_readfirstlane(c);
        if (c * 4 >= CONV_PRO) break;
        float xa[32], xb[32]; const int g0 = c * 4;
#define CONV_GI(j) ((g0 + (j)) < CONV_MOE0 ? (g0 + (j)) : (g0 + (j)) + (CONV_MOE1 - CONV_MOE0))
        ConvIt ca = conv_decode(F, a, CONV_GI(0)), cb; conv_load(xa, ca);
        cb = conv_decode(F, a, CONV_GI(1)); conv_load(xb, cb); conv_store(xa, ca, scr, F.lane);
        ca = conv_decode(F, a, CONV_GI(2)); conv_load(xa, ca); conv_store(xb, cb, scr, F.lane);
        cb = conv_decode(F, a, CONV_GI(3)); conv_load(xb, cb); conv_store(xa, ca, scr, F.lane);
        conv_store(xb, cb, scr, F.lane);
#undef CONV_GI
    }
}
constexpr int DEFER_CHUNKS = 256 + (CONV_MOE1 - CONV_MOE0) / 128;
template <int NR> __device__ __forceinline__ void seg_page(Frame& F, const Args& a, int it);
__device__ __forceinline__ void defer_chunk(Frame& F, const Args& a, int d) {
    if (d < 256) seg_page<16>(F, a, 2048 + d * 8 + F.wave);
    else { LAS float* scr = (LAS float*)(F.lds + RING_OFF + F.wave * 16384); const int g0 = CONV_MOE0 + (d - 256) * 128 + F.wave * 16;
        float xa[32], xb[32]; ConvIt ca = conv_decode(F, a, g0), cb; conv_load(xa, ca);
#pragma unroll 1
        for (int j = 0; j < 16; j += 2) {
            cb = conv_decode(F, a, g0 + j + 1); conv_load(xb, cb);
            conv_store(xa, ca, scr, F.lane);
            ca = conv_decode(F, a, g0 + (j + 2 < 16 ? j + 2 : 15)); conv_load(xa, ca);
            conv_store(xb, cb, scr, F.lane); } }
}
__device__ __forceinline__ void mod_gemv(Frame& F, const Args& a) {
    LAS float* s = (LAS float*)(F.lds + RING_OFF);
    float* MOD = WSP(float, WS_MOD);
    for (int item = F.bid; item < 96; item += F.G) {
        const int l = item / 48, rg = (item % 48) / 12, cb = item % 12, r0 = rg * 9, nr = rg == 3 ? 7 : 9;
        { float cv[18];
#pragma unroll
          for (int q = 0; q < 18; ++q) { const int idx = F.tid + q * NTHR, r = r0 + (idx >> 10), k = idx & 1023; const int rc = r < MODROWS ? r : MODROWS - 1;
              cv[q] = rc < 2 ? INP(float, I_CP)[rc * D + k] : INP(float, I_CS)[(rc - 2) * D + k]; }
#pragma unroll
          for (int q = 0; q < 18; ++q) { const int idx = F.tid + q * NTHR, r = r0 + (idx >> 10); s[idx] = r < MODROWS ? siluf_(cv[q]) : 0.f; } }
        __syncthreads();
        const int col = cb * 512 + F.wave * 64 + F.lane;
        const float* W = INP(float, I_WADA) + (size_t)l * D * MODW + col;
        float acc[9];
#pragma unroll
        for (int r = 0; r < 9; ++r) acc[r] = 0.f;
#pragma unroll 1
        for (int k32 = 0; k32 < 32; ++k32) { float w[32];
#pragma unroll
            for (int j = 0; j < 32; ++j) w[j] = W[(size_t)(32 * k32 + j) * MODW];
#pragma unroll
            for (int j4 = 0; j4 < 8; ++j4) {
#pragma unroll
                for (int r = 0; r < 9; ++r) { const f32x4 f = *(const LAS f32x4*)(s + r * 1024 + 32 * k32 + 4 * j4); acc[r] += f.x * w[4 * j4] + f.y * w[4 * j4 + 1] + f.z * w[4 * j4 + 2] + f.w * w[4 * j4 + 3]; }
                asm volatile("" ::: "memory"); } }
        const float bias = INP(float, I_BADA)[l * MODW + col];
#pragma unroll
        for (int r = 0; r < 9; ++r) if (r < nr) MOD[(size_t)(l * MODROWS + r0 + r) * MODW + col] = acc[r] + bias;
        __syncthreads();
    }
}
__device__ __forceinline__ void copy_f4(Frame& F, const float* src, float* dst, size_t n4) {
    const size_t stride = (size_t)F.G * NTHR;
    for (size_t i = (size_t)F.bid * NTHR + F.tid; i < n4; i += stride) ((GAS f32x4*)dst)[i] = ((const GAS f32x4*)src)[i];
}
__device__ __forceinline__ void nsa_prologue(Frame& F, const Args& a);
#if defined(MK_TIME)
#define PSTAMP(k) do { if (F.bid == 0 && F.tid == 0) { const unsigned long long t_ = __builtin_amdgcn_s_memrealtime(); F.ctl[3200 + 2 * (k)] = (unsigned)t_; F.ctl[3201 + 2 * (k)] = (unsigned)(t_ >> 32); } } while (0)
#else
#define PSTAMP(k) do { } while (0)
#endif
__device__ __forceinline__ void p0_prologue(Frame& F, const Args& a) {
    mod_gemv(F, a); PSTAMP(52);
    nsa_prologue(F, a); PSTAMP(53);
    { constexpr int W4 = 511 * 256 / 4, C4 = 2 * 1536 / 4, NW4 = 64 * W4, NALL = NW4 + 64 * C4; const int stride = F.G * NTHR;
      const float* swin = INP(float, I_SWIN); const float* sconv = INP(float, I_SCONV);
      for (int i0 = F.bid * NTHR + F.tid; i0 < NALL; i0 += 4 * stride) { f32x4 v[4]; GAS f32x4* d[4];
#pragma unroll
          for (int j = 0; j < 4; ++j) { const int i = i0 + j * stride; d[j] = nullptr;
              if (i < NW4) { const int lb = i / W4, r = i - lb * W4; v[j] = ((const GAS f32x4*)(swin + ((size_t)lb * 512 + 1) * 256))[r]; d[j] = (GAS f32x4*)(a.out + O_WIN_S + (size_t)lb * 512 * 256) + r; }
              else if (i < NALL) { const int k = i - NW4, lb = k / C4, r = k - lb * C4; v[j] = ((const GAS f32x4*)(sconv + ((size_t)lb * 3 + 1) * 1536))[r]; d[j] = (GAS f32x4*)(a.out + O_CONV_S + (size_t)lb * 3 * 1536) + r; } }
#pragma unroll
          for (int j = 0; j < 4; ++j) if (d[j]) *d[j] = v[j]; } }
    PSTAMP(54);
    convert_all(F, a);
}

__device__ __forceinline__ const float* mod_row(const Args& a, int l, int row) { return WSP(float, WS_MOD) + (size_t)(l * MODROWS + (row < MP ? (row >> 13) : 2 + (row - MP))) * MODW; }
__device__ __forceinline__ const float* x_in_row(const Args& a, int row) { return row < MP ? INP(float, I_XP) + (size_t)row * D : INP(float, I_XS) + (size_t)(row - MP) * D; }
__device__ __forceinline__ void row_stats(const f32x4 (&v)[4], float& mean, float& rstd) {
    float s = 0.f;
#pragma unroll
    for (int j = 0; j < 4; ++j) s += (v[j].x + v[j].y) + (v[j].z + v[j].w);
    mean = wave_sum(s) * (1.f / D); float q = 0.f;
#pragma unroll
    for (int j = 0; j < 4; ++j) { const f32x4 d = v[j] - mean; q += (d.x * d.x + d.y * d.y) + (d.z * d.z + d.w * d.w); }
    rstd = 1.f / sqrtf(wave_sum(q) * (1.f / D) + LN_EPS);
}
__device__ __forceinline__ void mod_ln_store(const f32x4 (&v)[4], const float* sh, const float* sc, bf16* orow, int lane) {
    float mean, rstd; row_stats(v, mean, rstd);
#pragma unroll
    for (int j = 0; j < 4; ++j) { const int c = 256 * j + 4 * lane; const f32x4 s1 = *(const GAS f32x4*)(sc + c), s0 = *(const GAS f32x4*)(sh + c);
        const f32x4 xh = (v[j] - mean) * rstd; const f32x4 h = xh * s1 + (xh + s0); v2u o; o.x = pk2(h.x, h.y); o.y = pk2(h.z, h.w); *(GAS v2u*)(orow + c) = o; }
}
__device__ __forceinline__ void p_lnmod0(Frame& F, const Args& a) {
    const int gw = F.bid * NWAVES + F.wave, NGW = F.G * NWAVES; bf16* XN = WSP(bf16, WS_XN);
    for (int row = gw; row < MT; row += NGW) {
        if (row >= MREAL) { for (int j = 0; j < 4; ++j) *(GAS v2u*)(XN + (size_t)row * D + 256 * j + 4 * F.lane) = (v2u){0u, 0u}; continue; }
        const float* xr = x_in_row(a, row); f32x4 v[4];
#pragma unroll
        for (int j = 0; j < 4; ++j) v[j] = *(const GAS f32x4*)(xr + 256 * j + 4 * F.lane);
        const float* mr = mod_row(a, 0, row);
        mod_ln_store(v, mr, mr + D, XN + (size_t)row * D, F.lane);
    }
}
__device__ __forceinline__ f32x4 bf4(v2u w) { return (f32x4){bflo(w.x), bfhi(w.x), bflo(w.y), bfhi(w.y)}; }
constexpr size_t MOE_META = WS_MOE, MOE_SLOT = WS_MOE + 64 * 1024, MOE_EPOS = WS_MOE + 256 * 1024, MOE_PROB = WS_MOE + 1 * MiB, MOE_CNT = WS_MOE + 1536 * 1024;
constexpr int CW_MOECNT = 2048;
template <int YMODE, bool ROUTE> __device__ __forceinline__ void p_lnpass(Frame& F, const Args& a, int l, int which, const float* xsrc, float* xdst, const bf16* Y) {
    const int gw = F.bid * NWAVES + F.wave, NGW = F.G * NWAVES; bf16* XN = WSP(bf16, WS_XN);
    const float* lg = INP(float, I_LNG) + (size_t)(l * 2 + which) * D; const float* lb = INP(float, I_LNB) + (size_t)(l * 2 + which) * D;
    const int* mslot = WSP(int, MOE_SLOT); float* mprob = WSP(float, MOE_PROB);
    f32x4 xn[4]; v2u yn[4], y2n[4]; int s0n = 0, s1n = 0; float p0n = 0.f, p1n = 0.f;
    int rc[8] = {0, 0, 0, 0, 0, 0, 0, 0};
#define LNP_LOAD(rw) do { const int rw_ = (rw); if (rw_ < MREAL) { const float* xr_ = xsrc ? xsrc + (size_t)rw_ * D : x_in_row(a, rw_); \
        if (YMODE == 2) { s0n = mslot[2 * rw_]; s1n = mslot[2 * rw_ + 1]; p0n = mprob[2 * rw_]; p1n = mprob[2 * rw_ + 1]; } \
        _Pragma("unroll") for (int j = 0; j < 4; ++j) { const int c = 256 * j + 4 * F.lane; xn[j] = *(const GAS f32x4*)(xr_ + c); \
            if (YMODE == 1) yn[j] = *(const GAS v2u*)(Y + (size_t)rw_ * D + c); \
            if (YMODE == 2) { yn[j] = *(const GAS v2u*)(Y + (size_t)s0n * D + c); y2n[j] = *(const GAS v2u*)(Y + (size_t)s1n * D + c); } } } } while (0)
    f32x4 wr[ROUTE ? 32 : 1];
    if (ROUTE) { const float* Wr = INP(float, I_MR);
#pragma unroll
        for (int j = 0; j < 4; ++j)
#pragma unroll
            for (int q = 0; q < 4; ++q) { const int c = 256 * j + 4 * F.lane + q; wr[(4 * j + q) * 2] = *(const GAS f32x4*)(Wr + (size_t)c * 8); wr[(4 * j + q) * 2 + 1] = *(const GAS f32x4*)(Wr + (size_t)c * 8 + 4); } }
    LNP_LOAD(gw);
    for (int row = gw; row < MREAL; row += NGW) {
        const float* mr = mod_row(a, l, row); const float* gate = mr + (which ? 5 : 2) * D;
        f32x4 v[4];
#pragma unroll
        for (int j = 0; j < 4; ++j) { const int c = 256 * j + 4 * F.lane; f32x4 x = xn[j] * ALPHA;
            if (YMODE == 1) x += *(const GAS f32x4*)(gate + c) * bf4(yn[j]);
            if (YMODE == 2) x += *(const GAS f32x4*)(gate + c) * (bf4(yn[j]) * p0n + bf4(y2n[j]) * p1n);
            v[j] = x; }
        LNP_LOAD(row + NGW);
        float mean, rstd; row_stats(v, mean, rstd);
        float* xo = xdst ? xdst + (size_t)row * D : (row < MP ? a.out + O_YP + (size_t)row * D : a.out + O_YS + (size_t)(row - MP) * D);
#pragma unroll
        for (int j = 0; j < 4; ++j) { const int c = 256 * j + 4 * F.lane; v[j] = (v[j] - mean) * rstd * *(const GAS f32x4*)(lg + c) + *(const GAS f32x4*)(lb + c); *(GAS f32x4*)(xo + c) = v[j]; }
        const float* sh = nullptr; const float* sc = nullptr;
        if (which == 0) { sh = mr + 3 * D; sc = mr + 4 * D; } else if (l == 0) { const float* mr2 = mod_row(a, 1, row); sh = mr2; sc = mr2 + D; }
        if (sh) {
            row_stats(v, mean, rstd);
#pragma unroll
            for (int j = 0; j < 4; ++j) { const int c = 256 * j + 4 * F.lane; { const f32x4 xh = (v[j] - mean) * rstd; v[j] = xh * *(const GAS f32x4*)(sc + c) + (xh + *(const GAS f32x4*)(sh + c)); }
                v2u o; o.x = pk2(v[j].x, v[j].y); o.y = pk2(v[j].z, v[j].w); *(GAS v2u*)(XN + (size_t)row * D + c) = o; }
            if (ROUTE) {
                float lgt[8];
#pragma unroll
                for (int e = 0; e < 8; ++e) lgt[e] = 0.f;
#pragma unroll
                for (int j = 0; j < 4; ++j)
#pragma unroll
                    for (int q = 0; q < 4; ++q) { const f32x4 w0 = wr[(4 * j + q) * 2], w1 = wr[(4 * j + q) * 2 + 1]; const float hv = v[j][q];
                        lgt[0] += hv * w0.x; lgt[1] += hv * w0.y; lgt[2] += hv * w0.z; lgt[3] += hv * w0.w; lgt[4] += hv * w1.x; lgt[5] += hv * w1.y; lgt[6] += hv * w1.z; lgt[7] += hv * w1.w; }
#pragma unroll
                for (int e = 0; e < 8; ++e) lgt[e] = wave_sum(lgt[e]);
                int e0 = 0; float l0 = lgt[0];
#pragma unroll
                for (int e = 1; e < 8; ++e) if (lgt[e] > l0) { l0 = lgt[e]; e0 = e; }
                int e1 = -1; float l1 = -3.0e38f;
#pragma unroll
                for (int e = 0; e < 8; ++e) if (e != e0 && lgt[e] > l1) { l1 = lgt[e]; e1 = e; }
                const float p0 = 1.f / (1.f + __expf(l1 - l0));
                int q0 = 0, q1 = 0;
#pragma unroll
                for (int e = 0; e < 8; ++e) { q0 = e == e0 ? rc[e] : q0; q1 = e == e1 ? rc[e] : q1; rc[e] += (e == e0 || e == e1) ? 1 : 0; }
                if (F.lane == 0) { int* ep = WSP(int, MOE_EPOS) + 4 * row;
                    *(GAS v4u*)ep = (v4u){(unsigned)e0, (unsigned)e1, (unsigned)q0, (unsigned)q1};
                    *(GAS v2u*)(mprob + 2 * row) = (v2u){__builtin_bit_cast(unsigned, p0), __builtin_bit_cast(unsigned, 1.f - p0)}; }
            }
        }
    }
    if (ROUTE) { if (F.lane == 0) { int* T = WSP(int, MOE_CNT) + 8 * gw;
        *(GAS v4u*)T = (v4u){(unsigned)rc[0], (unsigned)rc[1], (unsigned)rc[2], (unsigned)rc[3]}; *(GAS v4u*)(T + 4) = (v4u){(unsigned)rc[4], (unsigned)rc[5], (unsigned)rc[6], (unsigned)rc[7]}; } }
}
__device__ __forceinline__ void p_moe_gather(Frame& F, const Args& a) {
    const int gw = F.bid * NWAVES + F.wave, NGW = F.G * NWAVES; const int* T = WSP(int, MOE_CNT);
    LAS float* red = (LAS float*)(F.lds + RING_OFF);
    {   float al[8];
#pragma unroll
        for (int e = 0; e < 8; ++e) al[e] = 0.f;
        for (int w = F.tid; w < NGW; w += NTHR) { const v4u t0 = *(const GAS v4u*)(T + 8 * w), t1 = *(const GAS v4u*)(T + 8 * w + 4);
#pragma unroll
            for (int e = 0; e < 4; ++e) { al[e] += (float)t0[e]; al[4 + e] += (float)t1[e]; } }
#pragma unroll
        for (int e = 0; e < 8; ++e) al[e] = wave_sum(al[e]);
        if (F.lane == 0) {
#pragma unroll
            for (int e = 0; e < 8; ++e) red[F.wave * 16 + e] = al[e]; }
    }
    {   float pb[8];
#pragma unroll
        for (int e = 0; e < 8; ++e) pb[e] = 0.f;
        for (int w = F.tid; w < F.bid * NWAVES; w += NTHR) { const v4u t0 = *(const GAS v4u*)(T + 8 * w), t1 = *(const GAS v4u*)(T + 8 * w + 4);
#pragma unroll
            for (int e = 0; e < 4; ++e) { pb[e] += (float)t0[e]; pb[4 + e] += (float)t1[e]; } }
#pragma unroll
        for (int e = 0; e < 8; ++e) pb[e] = wave_sum(pb[e]);
        if (F.lane == 0) {
#pragma unroll
            for (int e = 0; e < 8; ++e) red[F.wave * 16 + 8 + e] = pb[e]; }
    }
    __syncthreads();
    int off[9], base[8]; off[0] = 0;
#pragma unroll
    for (int e = 0; e < 8; ++e) { float ta = 0.f, tp = 0.f;
#pragma unroll
        for (int w = 0; w < 8; ++w) { ta += red[w * 16 + e]; tp += red[w * 16 + 8 + e]; }
        const int c = (int)ta; off[e + 1] = off[e] + ((c + 255) & ~255); base[e] = (int)tp; }
    for (int w = 0; w < F.wave; ++w) { const int* Tw = T + 8 * (F.bid * NWAVES + w);
#pragma unroll
        for (int e = 0; e < 8; ++e) base[e] += Tw[e]; }
    __syncthreads();
    int* meta = WSP(int, MOE_META);
    if (F.bid == 0) { if (F.tid == 0) meta[0] = off[8] >> 8;
        for (int t = F.tid; t < (off[8] >> 8); t += NTHR) { int e = 0;
#pragma unroll
            for (int q = 1; q < 8; ++q) if (t * 256 >= off[q]) e = q;
            meta[16 + t] = e; } }
    const bf16* XN = WSP(bf16, WS_XN); bf16* AP = WSP(bf16, WS_APERM); int* mslot = WSP(int, MOE_SLOT);
    for (int row = gw; row < MREAL; row += NGW) {
        const int* ep = WSP(int, MOE_EPOS) + 4 * row; const int e0 = ep[0], e1 = ep[1];
        int o0 = 0, o1 = 0;
#pragma unroll
        for (int q = 0; q < 8; ++q) { if (q == e0) o0 = off[q] + base[q]; if (q == e1) o1 = off[q] + base[q]; }
        const int s0 = o0 + ep[2], s1 = o1 + ep[3];
        if (F.lane == 0) { mslot[2 * row] = s0; mslot[2 * row + 1] = s1; }
        const v4u x0 = *(const GAS v4u*)(XN + (size_t)row * D + 8 * F.lane), x1 = *(const GAS v4u*)(XN + (size_t)row * D + 512 + 8 * F.lane);
        *(GAS v4u*)(AP + (size_t)s0 * D + 8 * F.lane) = x0; *(GAS v4u*)(AP + (size_t)s0 * D + 512 + 8 * F.lane) = x1;
        *(GAS v4u*)(AP + (size_t)s1 * D + 8 * F.lane) = x0; *(GAS v4u*)(AP + (size_t)s1 * D + 512 + 8 * F.lane) = x1;
    }
}

struct EpiIn {
    static constexpr bool PERM = true, AFTER_DRAIN = false, CHAIN = false;
    bf16* P; float* SC; float* out; int l;
    __device__ __forceinline__ void mid(const pg8::f32x4 (&)[2][2][4][2], const pg8::Unit&, int, int, int, int) const {}
    __device__ __forceinline__ void operator()(const pg8::f32x4 (&acc)[2][2][4][2], const pg8::Unit& u, int wr, int wc, int fr, int fq) const {
        asm volatile("" : "+v"(fr), "+v"(fq));
        const int pn = u.pn; const int colb = pn * 256 + wc * 32 + 8 * fq;
#pragma unroll
        for (int ai = 0; ai < 2; ++ai)
#pragma unroll
            for (int m = 0; m < 4; ++m) {
                const int row = u.pm * 256 + ai * 128 + wr * 64 + m * 16 + fr;
                if (pn >= 13 && pn <= 20) {
                    float r[8], sb[8];
#pragma unroll
                    for (int n = 0; n < 2; ++n)
#pragma unroll
                        for (int q = 0; q < 4; ++q) { const float ea = __expf(-acc[ai][0][m][n][q]), eb = __expf(-acc[ai][1][m][n][q]); sb[4 * n + q] = 1.f / (1.f + eb); r[4 * n + q] = (1.f + eb) / (1.f + ea); }
                    v4u w; w.x = pk2(r[0], r[1]); w.y = pk2(r[2], r[3]); w.z = pk2(r[4], r[5]); w.w = pk2(r[6], r[7]); *(GAS v4u*)(P + (size_t)row * NINP + colb) = w;
                    w.x = pk2(sb[0], sb[1]); w.y = pk2(sb[2], sb[3]); w.z = pk2(sb[4], sb[5]); w.w = pk2(sb[6], sb[7]); *(GAS v4u*)(P + (size_t)row * NINP + colb + 128) = w;
                    continue;
                }
#pragma unroll
                for (int bj = 0; bj < 2; ++bj) {
                    const int col = colb + bj * 128; const pg8::f32x4 v0 = acc[ai][bj][m][0], v1 = acc[ai][bj][m][1];
                    v4u w; w.x = pk2(v0[0], v0[1]); w.y = pk2(v0[2], v0[3]); w.z = pk2(v1[0], v1[1]); w.w = pk2(v1[2], v1[3]);
                    *(GAS v4u*)(P + (size_t)row * NINP + col) = w;
                    float* dst = nullptr;
                    if (pn >= 10 && pn <= 12) {
                        const int c = col - pn * 256;
                        if (pn == 12) { if (row < MP) { const int t = row & (SEQ - 1); if (t >= SEQ - WINDOW) dst = out + O_WIN_P + ((size_t)(l * 2 + (row >> 13)) * WINDOW + (t - (SEQ - WINDOW))) * KVW + c; }
                                        else if (row < MREAL) dst = out + O_WIN_S + ((size_t)(l * MS + (row - MP)) * WINDOW + (WINDOW - 1)) * KVW + c; }
                        else { const size_t op = pn == 10 ? O_CMP_P : O_SLC_P, os = pn == 10 ? O_CMP_S : O_SLC_S;
                               if (row < MP) dst = out + op + ((size_t)l * MP + row) * KVW + c; else if (row < MREAL) dst = out + os + (size_t)(l * MS + (row - MP)) * KVW + c; }
                    } else if (pn < 6) {
                        if (row < MP) { const int t = row & (SEQ - 1); if (t >= SEQ - 3) dst = out + O_CONV_P + ((size_t)(l * 2 + (row >> 13)) * 3 + (t - (SEQ - 3))) * CQKV + col; }
                        else if (row < MREAL) dst = out + O_CONV_S + ((size_t)(l * MS + (row - MP)) * 3 + 2) * CQKV + col;
                    } else if (pn == 21) {
                        if (wc == 0 && bj == 0) dst = SC + (size_t)row * 32 + 8 * fq;
                    }
                    if (dst) { *(GAS pg8::f32x4*)dst = v0; *(GAS pg8::f32x4*)(dst + 4) = v1; }
                }
            }
    }
};
constexpr size_t GDN_REC = WS_GDN, GDN_UT = WS_GDN + 56 * MiB, GDN_OT = WS_GDN + 72 * MiB, GDN_GL = WS_GDN + 104 * MiB;
constexpr int REC_WN = 0, REC_QD = 8192, REC_KDT = 16384, REC_QK = 24576, REC_ELEMS = 28672;
__device__ __forceinline__ int kperm(int k) { return (k & ~31) | (((k >> 2) & 3) << 3) | (((k >> 4) & 1) << 2) | (k & 3); }

__device__ __forceinline__ void gdn_prep(Frame& F, const Args& a, int l) {
    LAS float* kq = (LAS float*)(F.lds + RING_OFF);
    LAS float* qq = kq + 64 * 132;
    LAS float* vv = qq + 64 * 132;
    LAS float* Am = vv + 64 * 128;
    LAS float* sv = Am + 64 * 64;
    const bf16* P = WSP(bf16, WS_P); const float* SC = WSP(float, WS_SC);
    const float* cw = INP(float, I_CONVW) + (size_t)l * 4 * CQKV;
    const int wave = F.wave;
#if defined(MK_GSEC)
#define GSEC(k) do { if (F.bid == 0 && F.tid == 0 && l == 0) { const unsigned t_ = (unsigned)__builtin_amdgcn_s_memrealtime(); if ((k) == MK_GSEC + 1) F.MISC[20] += t_ - F.MISC[22]; F.MISC[22] = t_; } } while (0)
#else
#define GSEC(k) do { } while (0)
#endif
    for (int unit = F.bid; unit < 8 * NCHUNK; unit += F.G) {
        int tid_l = F.tid, lane_l = F.lane; asm volatile("" : "+v"(tid_l), "+v"(lane_l));
        const int tid = tid_l, lane = lane_l;
        const int bh = unit >> 7, n = unit & 127, b = bh >> 2, h = bh & 3, t0 = n * CHUNK; const size_t row0 = (size_t)b * SEQ + t0;
        GSEC(0);
        if (tid < 384) {
            const int part = tid >> 7, j = tid & 127;
            const int c = (part == 0 ? 1024 : part == 1 ? 512 : 0) + h * 128 + j;
            const float w0 = cw[c], w1 = cw[CQKV + c], w2 = cw[2 * CQKV + c], w3 = cw[3 * CQKV + c];
            const bf16* pc = P + row0 * NINP + PC_QKV + c;
            float xm3 = 0.f, xm2 = 0.f, xm1 = 0.f;
            if (n > 0) { xm3 = bf2f(*(pc - 3 * (ptrdiff_t)NINP)); xm2 = bf2f(*(pc - 2 * (ptrdiff_t)NINP)); xm1 = bf2f(*(pc - (ptrdiff_t)NINP)); }
            LAS float* dstp = part == 0 ? vv + j : part == 1 ? kq + j : qq + j; const int dpitch = part == 0 ? 128 : 132;
            bf16 xa[16], xb[16];
#pragma unroll
            for (int j = 0; j < 16; ++j) xa[j] = pc[(size_t)j * NINP];
#pragma unroll
            for (int i0 = 0; i0 < 64; i0 += 32) {
#pragma unroll
                for (int j = 0; j < 16; ++j) xb[j] = pc[(size_t)(i0 + 16 + j) * NINP];
#pragma unroll
                for (int j = 0; j < 16; ++j) { const float x = bf2f(xa[j]); const float y = siluf_(w0 * xm3 + w1 * xm2 + w2 * xm1 + w3 * x); xm3 = xm2; xm2 = xm1; xm1 = x; dstp[(i0 + j) * dpitch] = y; }
                if (i0 + 32 < 64) {
#pragma unroll
                    for (int j = 0; j < 16; ++j) xa[j] = pc[(size_t)(i0 + 32 + j) * NINP]; }
#pragma unroll
                for (int j = 0; j < 16; ++j) { const float x = bf2f(xb[j]); const float y = siluf_(w0 * xm3 + w1 * xm2 + w2 * xm1 + w3 * x); xm3 = xm2; xm2 = xm1; xm1 = x; dstp[(i0 + 16 + j) * dpitch] = y; }
            }
        } else if (tid < 448) {
            const int i = tid - 384; const float* sc = SC + (row0 + i) * 32;
            const float beta = sigmoidf_(sc[h]); const float g = -__expf(INP(float, I_ALOG)[l * 4 + h]) * softplusf_(sc[4 + h] + INP(float, I_DTB)[l * 4 + h]);
            float gc = g;
#pragma unroll
            for (int o = 1; o < 64; o <<= 1) { const float t = bperm(gc, lane - o); if (lane >= o) gc += t; }
            sv[i] = beta; sv[64 + i] = gc; sv[128 + i] = __expf(gc);
        }
        __syncthreads(); GSEC(1);
#pragma unroll
        for (int r = 0; r < 8; ++r) { const int i = wave * 8 + r;
            { const float x0 = kq[i * 132 + lane], x1 = kq[i * 132 + 64 + lane]; const float inv = 1.f / sqrtf(wave_sum(x0 * x0 + x1 * x1) + 1e-6f); kq[i * 132 + lane] = x0 * inv; kq[i * 132 + 64 + lane] = x1 * inv; }
            { const float x0 = qq[i * 132 + lane], x1 = qq[i * 132 + 64 + lane]; const float inv = 1.f / sqrtf(wave_sum(x0 * x0 + x1 * x1) + 1e-6f); qq[i * 132 + lane] = x0 * inv; qq[i * 132 + 64 + lane] = x1 * inv; } }
        __syncthreads(); GSEC(2);
        {
            const int mat = wave >> 2, it4 = wave & 3, fr = lane & 15, fq = lane >> 4; const LAS float* L = mat ? qq : kq;
            bf16x8 bi[4];
#pragma unroll
            for (int ks = 0; ks < 4; ++ks) { const LAS float* p = L + (16 * it4 + fr) * 132 + 32 * ks + 8 * fq; const f32x4 x0 = *(const LAS f32x4*)p, x1 = *(const LAS f32x4*)(p + 4);
                v4u w; w.x = pk2(x0.x, x0.y); w.y = pk2(x0.z, x0.w); w.z = pk2(x1.x, x1.y); w.w = pk2(x1.z, x1.w); bi[ks] = __builtin_bit_cast(bf16x8, w); }
            const int i = 16 * it4 + fr; const float gci = sv[64 + i], bti = sv[i];
            bf16* QKg = WSP(bf16, GDN_REC) + (size_t)unit * REC_ELEMS + REC_QK;
#pragma unroll
            for (int jt = 0; jt < 4; ++jt) {
                f32x4 o = (f32x4){0.f, 0.f, 0.f, 0.f};
                if (jt <= it4) {
                    f32x4 acc = (f32x4){0.f, 0.f, 0.f, 0.f};
#pragma unroll
                    for (int ks = 0; ks < 4; ++ks) { const LAS float* p = kq + (16 * jt + fr) * 132 + 32 * ks + 8 * fq; const f32x4 x0 = *(const LAS f32x4*)p, x1 = *(const LAS f32x4*)(p + 4);
                        v4u w; w.x = pk2(x0.x, x0.y); w.y = pk2(x0.z, x0.w); w.z = pk2(x1.x, x1.y); w.w = pk2(x1.z, x1.w);
                        acc = __builtin_amdgcn_mfma_f32_16x16x32_bf16(__builtin_bit_cast(bf16x8, w), bi[ks], acc, 0, 0, 0); }
#pragma unroll
                    for (int r = 0; r < 4; ++r) { const int j = 16 * jt + 4 * fq + r; const float dec = __expf(gci - sv[64 + j]);
                        o[r] = mat ? ((i >= j) ? acc[r] * dec * 0.08838834764831845f : 0.f) : ((i > j) ? bti * acc[r] * dec : 0.f); }
                }
                if (mat == 0) {
#pragma unroll
                    for (int r = 0; r < 4; ++r) Am[(16 * jt + 4 * fq + r) * 64 + i] = o[r]; }
                else { v2u w; w.x = pk2(o[0], o[1]); w.y = pk2(o[2], o[3]); *(GAS v2u*)(QKg + i * 64 + kperm(16 * jt + 4 * fq)) = w; }
            }
        }
        __syncthreads(); GSEC(3);
        if (tid < 256) {
            float x[64]; int zv; asm volatile("v_mov_b32 %0, 0" : "=v"(zv));
            const LAS float* svz = sv + zv; const LAS float* Amz = Am + zv;
            if (tid < 128) {
#pragma unroll
                for (int i = 0; i < 64; ++i) x[i] = vv[i * 128 + tid] * svz[i];
            } else {
#pragma unroll
                for (int i = 0; i < 64; ++i) x[i] = kq[i * 132 + (tid - 128)] * svz[i] * svz[128 + i];
            }
#pragma unroll
            for (int j = 0; j < 63; ++j) {
                f32x4 ca[16];
#pragma unroll
                for (int g4 = (j + 1) / 4; g4 < 16; ++g4) ca[g4] = *(const LAS f32x4*)(Amz + j * 64 + 4 * g4);
                const float nxj = -x[j];
#pragma unroll
                for (int g4 = (j + 1) / 4; g4 < 16; ++g4) {
                    asm("v_fmac_f32 %0, %1, %2" : "+v"(x[4 * g4]) : "v"(ca[g4].x), "v"(nxj)); asm("v_fmac_f32 %0, %1, %2" : "+v"(x[4 * g4 + 1]) : "v"(ca[g4].y), "v"(nxj));
                    asm("v_fmac_f32 %0, %1, %2" : "+v"(x[4 * g4 + 2]) : "v"(ca[g4].z), "v"(nxj)); asm("v_fmac_f32 %0, %1, %2" : "+v"(x[4 * g4 + 3]) : "v"(ca[g4].w), "v"(nxj)); }
                asm volatile("" ::: "memory");
            }
            if (tid < 128) { bf16* UT = WSP(bf16, GDN_UT) + ((size_t)unit * 128 + tid) * 64;
#pragma unroll
                for (int i8 = 0; i8 < 8; ++i8) { v4u w; w.x = pk2(x[8 * i8], x[8 * i8 + 1]); w.y = pk2(x[8 * i8 + 2], x[8 * i8 + 3]); w.z = pk2(x[8 * i8 + 4], x[8 * i8 + 5]); w.w = pk2(x[8 * i8 + 6], x[8 * i8 + 7]); *(GAS v4u*)(UT + 8 * i8) = w; }
            } else { bf16* WN = WSP(bf16, GDN_REC) + (size_t)unit * REC_ELEMS + REC_WN + kperm(tid - 128);
#pragma unroll
                for (int i = 0; i < 64; ++i) WN[i * 128] = (bf16)f2bf(-x[i]);
            }
        } else {
            const int t = tid - 256; const float gl = sv[64 + 63];
            bf16* QD = WSP(bf16, GDN_REC) + (size_t)unit * REC_ELEMS + REC_QD; bf16* KDT = WSP(bf16, GDN_REC) + (size_t)unit * REC_ELEMS + REC_KDT;
            for (int it = t; it < 64 * 32; it += 256) { const int i = it >> 5, k4 = it & 31; const f32x4 q = *(const LAS f32x4*)(qq + i * 132 + 4 * k4) * (sv[128 + i] * 0.08838834764831845f);
                v2u w; w.x = pk2(q.x, q.y); w.y = pk2(q.z, q.w); *(GAS v2u*)(QD + i * 128 + kperm(4 * k4)) = w; }
            for (int it = t; it < 128 * 16; it += 256) { const int k = it & 127, c4 = it >> 7; float o[4];
#pragma unroll
                for (int y = 0; y < 4; ++y) { const int c = 4 * c4 + y; o[y] = kq[c * 132 + k] * __expf(gl - sv[64 + c]); }
                v2u w; w.x = pk2(o[0], o[1]); w.y = pk2(o[2], o[3]); *(GAS v2u*)(KDT + k * 64 + kperm(4 * c4)) = w; }
            if (t == 0) WSP(float, GDN_GL)[unit] = __expf(gl);
        }
        __syncthreads(); GSEC(4);
    }
#if defined(MK_GSEC)
    if (F.bid == 0 && F.tid == 0 && l == 0) { F.ctl[3200 + 2 * 50] = 0; F.ctl[3201 + 2 * 50] = 0; F.ctl[3200 + 2 * 51] = F.MISC[20]; F.ctl[3201 + 2 * 51] = 0; F.MISC[20] = 0; }
#endif
#undef GSEC
}

__device__ __forceinline__ void gdn_scan(Frame& F, const Args& a, int l, int unit) {
    constexpr int PW = 272, PK = 144;
    constexpr int B_WN = 0, B_QD = 64 * PW, B_KDT = 2 * 64 * PW, B_QK = B_KDT + 128 * PK, BUFB = B_QK + 64 * PK;
    static_assert(2 * BUFB + 4096 <= RING_BYTES, "scan LDS");
    const int bh = unit >> 2, dq = unit & 3;
    const int tid = F.tid, lane = F.lane, wave = F.wave, fr = lane & 15, fq = lane >> 4;
    const bf16* REC = WSP(bf16, GDN_REC) + (size_t)bh * 128 * REC_ELEMS;
    const bf16* UT = WSP(bf16, GDN_UT) + (size_t)bh * 128 * 8192; float* OT = WSP(float, GDN_OT) + (size_t)bh * 128 * 8192; const float* GL = WSP(float, GDN_GL) + bh * 128;
    if (wave >= 2) {
        const int lt = tid - 128;
        v4u st0[10], st1[10];
        int dsto[10];
#pragma unroll
        for (int q = 0; q < 10; ++q) { const int p = lt + 384 * q;
            dsto[q] = p < 1024 ? B_WN + (p >> 4) * PW + (p & 15) * 16 : p < 2048 ? B_QD + ((p - 1024) >> 4) * PW + (p & 15) * 16 : p < 3072 ? B_KDT + ((p - 2048) >> 3) * PK + (p & 7) * 16 : p < 3584 ? B_QK + ((p - 3072) >> 3) * PK + (p & 7) * 16 : -1; }
        const int lastp = (lt + 3456 < 3584 ? lt + 3456 : 3583) * 8;
#define GDN_SRC 1
#define GDN_DST 1
#define GDN_LOADR(st, nn) do { const bf16* rp_ = REC + (size_t)((nn) < NCHUNK ? (nn) : NCHUNK - 1) * REC_ELEMS; _Pragma("unroll") for (int q = 0; q < 9; ++q) st[q] = *(const GAS v4u*)(rp_ + (size_t)(lt + 384 * q) * 8); st[9] = *(const GAS v4u*)(rp_ + lastp); } while (0)
#define GDN_STORER(st, nn) do { const int bo_ = ((nn) & 1) * BUFB; _Pragma("unroll") for (int q = 0; q < 10; ++q) { const int off_ = dsto[q] >= 0 ? bo_ + dsto[q] : 2 * BUFB + lt * 16; *(LAS v4u*)(F.lds + RING_OFF + off_) = st[q]; } } while (0)
        GDN_LOADR(st0, 0); GDN_LOADR(st1, 1);
        GDN_STORER(st0, 0); GDN_LOADR(st0, 2);
        LBAR();
        for (int n = 0; n < NCHUNK; n += 2) {
            GDN_STORER(st1, n + 1); GDN_LOADR(st1, n + 3); LBAR();
            GDN_STORER(st0, n + 2); GDN_LOADR(st0, n + 4); LBAR();
        }
#undef GDN_SRC
#undef GDN_DST
#undef GDN_LOADR
#undef GDN_STORER
    } else {
        const int dvc = dq * 32 + wave * 16 + fr;
        f32x4 S[8];
#pragma unroll
        for (int T = 0; T < 8; ++T) S[T] = (f32x4){0.f, 0.f, 0.f, 0.f};
        v2u un[4]; float egn;
        { const bf16* up = UT + ((size_t)0 * 128 + dvc) * 64 + 4 * fq;
#pragma unroll
          for (int m = 0; m < 4; ++m) un[m] = *(const GAS v2u*)(up + 16 * m);
          egn = GL[0]; }
        LBAR();
        f32x4 aop[4];
#pragma unroll
        for (int m = 0; m < 4; ++m) aop[m] = (f32x4){0.f, 0.f, 0.f, 0.f};
#define GDN_FR8(dst, OFF0, PITCH, ROW0, K0) do { _Pragma("unroll") for (int q = 0; q < 4; ++q) { dst[q] = *(const LAS bf16x8*)(bb + (OFF0) + ((ROW0) + 16 * q + fr) * (PITCH) + ((K0) + 8 * fq) * 2); } } while (0)
#define SB() __builtin_amdgcn_sched_barrier(0)
        for (int n = 0; n < NCHUNK; ++n) {
            const LAS unsigned char* bb = F.lds + RING_OFF + (n & 1) * BUFB;
            f32x4 av[4], ao[4];
#pragma unroll
            for (int m = 0; m < 4; ++m) { av[m] = (f32x4){bflo(un[m].x), bfhi(un[m].x), bflo(un[m].y), bfhi(un[m].y)}; ao[m] = (f32x4){0.f, 0.f, 0.f, 0.f}; }
            const float egl = egn;
            if (n > 0) { float* op = OT + ((size_t)(n - 1) * 128 + dvc) * 64 + 4 * fq;
#pragma unroll
                for (int m = 0; m < 4; ++m) *(GAS f32x4*)(op + 16 * m) = aop[m]; }
            if (n + 1 < NCHUNK) { const bf16* up = UT + ((size_t)(n + 1) * 128 + dvc) * 64 + 4 * fq;
#pragma unroll
                for (int m = 0; m < 4; ++m) un[m] = *(const GAS v2u*)(up + 16 * m);
                egn = GL[n + 1]; }
            bf16x8 Bs[4];
#pragma unroll
            for (int kt = 0; kt < 4; ++kt) { v4u w; w.x = pk2(S[2 * kt][0], S[2 * kt][1]); w.y = pk2(S[2 * kt][2], S[2 * kt][3]); w.z = pk2(S[2 * kt + 1][0], S[2 * kt + 1][1]); w.w = pk2(S[2 * kt + 1][2], S[2 * kt + 1][3]); Bs[kt] = __builtin_bit_cast(bf16x8, w); }
            bf16x8 fw0[4], fq0[4], fw1[4], fq1[4], fw2[4], fq2[4];
            GDN_FR8(fw0, B_WN, PW, 0, 0); GDN_FR8(fq0, B_QD, PW, 0, 0); GDN_FR8(fw1, B_WN, PW, 0, 32); GDN_FR8(fq1, B_QD, PW, 0, 32); SB();
            GDN_FR8(fw2, B_WN, PW, 0, 64); GDN_FR8(fq2, B_QD, PW, 0, 64);
#pragma unroll
            for (int m = 0; m < 4; ++m) { av[m] = __builtin_amdgcn_mfma_f32_16x16x32_bf16(fw0[m], Bs[0], av[m], 0, 0, 0); ao[m] = __builtin_amdgcn_mfma_f32_16x16x32_bf16(fq0[m], Bs[0], ao[m], 0, 0, 0); }
            SB();
            GDN_FR8(fw0, B_WN, PW, 0, 96); GDN_FR8(fq0, B_QD, PW, 0, 96);
#pragma unroll
            for (int m = 0; m < 4; ++m) { av[m] = __builtin_amdgcn_mfma_f32_16x16x32_bf16(fw1[m], Bs[1], av[m], 0, 0, 0); ao[m] = __builtin_amdgcn_mfma_f32_16x16x32_bf16(fq1[m], Bs[1], ao[m], 0, 0, 0); }
            SB();
            GDN_FR8(fw1, B_QK, PK, 0, 0); GDN_FR8(fq1, B_QK, PK, 0, 32);
#pragma unroll
            for (int m = 0; m < 4; ++m) { av[m] = __builtin_amdgcn_mfma_f32_16x16x32_bf16(fw2[m], Bs[2], av[m], 0, 0, 0); ao[m] = __builtin_amdgcn_mfma_f32_16x16x32_bf16(fq2[m], Bs[2], ao[m], 0, 0, 0); }
            SB();
            GDN_FR8(fw2, B_KDT, PK, 0, 0); GDN_FR8(fq2, B_KDT, PK, 64, 0);
#pragma unroll
            for (int m = 0; m < 4; ++m) { av[m] = __builtin_amdgcn_mfma_f32_16x16x32_bf16(fw0[m], Bs[3], av[m], 0, 0, 0); ao[m] = __builtin_amdgcn_mfma_f32_16x16x32_bf16(fq0[m], Bs[3], ao[m], 0, 0, 0); }
            SB();
            bf16x8 Bv[2];
#pragma unroll
            for (int kc = 0; kc < 2; ++kc) { v4u w; w.x = pk2(av[2 * kc][0], av[2 * kc][1]); w.y = pk2(av[2 * kc][2], av[2 * kc][3]); w.z = pk2(av[2 * kc + 1][0], av[2 * kc + 1][1]); w.w = pk2(av[2 * kc + 1][2], av[2 * kc + 1][3]); Bv[kc] = __builtin_bit_cast(bf16x8, w); }
            GDN_FR8(fw0, B_KDT, PK, 0, 32); GDN_FR8(fq0, B_KDT, PK, 64, 32);
#pragma unroll
            for (int m = 0; m < 4; ++m) { ao[m] = __builtin_amdgcn_mfma_f32_16x16x32_bf16(fw1[m], Bv[0], ao[m], 0, 0, 0); ao[m] = __builtin_amdgcn_mfma_f32_16x16x32_bf16(fq1[m], Bv[1], ao[m], 0, 0, 0); }
#pragma unroll
            for (int T = 0; T < 8; ++T) S[T] = S[T] * egl;
            SB();
#pragma unroll
            for (int T = 0; T < 4; ++T) { S[T] = __builtin_amdgcn_mfma_f32_16x16x32_bf16(fw2[T], Bv[0], S[T], 0, 0, 0); S[4 + T] = __builtin_amdgcn_mfma_f32_16x16x32_bf16(fq2[T], Bv[0], S[4 + T], 0, 0, 0); }
#pragma unroll
            for (int T = 0; T < 4; ++T) { S[T] = __builtin_amdgcn_mfma_f32_16x16x32_bf16(fw0[T], Bv[1], S[T], 0, 0, 0); S[4 + T] = __builtin_amdgcn_mfma_f32_16x16x32_bf16(fq0[T], Bv[1], S[4 + T], 0, 0, 0); }
#pragma unroll
            for (int m = 0; m < 4; ++m) aop[m] = ao[m];
            LBAR();
        }
        { float* op = OT + ((size_t)(NCHUNK - 1) * 128 + dvc) * 64 + 4 * fq;
#pragma unroll
          for (int m = 0; m < 4; ++m) *(GAS f32x4*)(op + 16 * m) = aop[m]; }
#undef GDN_FR8
#undef SB
        float* od = a.out + O_DELTA_P + ((size_t)l * 8 + bh) * 128 * 128;
#pragma unroll
        for (int T = 0; T < 8; ++T)
#pragma unroll
            for (int i = 0; i < 4; ++i) od[(size_t)(16 * T + 4 * fq + i) * 128 + dvc] = S[T][i];
    }
}

__device__ __forceinline__ void gdn_sample(Frame& F, const Args& a, int l, int unit) {
    LAS float* sq = (LAS float*)(F.lds + RING_OFF); LAS float* sk = sq + 128; LAS float* svv = sk + 128; LAS float* red = svv + 128;
    LAS float* misc = red + 512;
    const int tid = F.tid, b = unit >> 2, h = unit & 3; const size_t row = MP + b;
    const bf16* P = WSP(bf16, WS_P); const float* SC = WSP(float, WS_SC);
    if (tid < 384) {
        const int part = tid >> 7, j = tid & 127; const int c = (part == 0 ? 0 : part == 1 ? 512 : 1024) + h * 128 + j;
        const float* cw = INP(float, I_CONVW) + (size_t)l * 4 * CQKV; const float* sb = INP(float, I_SCONV) + ((size_t)(l * MS + b) * 3) * CQKV + c;
        const float y = siluf_(cw[c] * sb[0] + cw[CQKV + c] * sb[CQKV] + cw[2 * CQKV + c] * sb[2 * CQKV] + cw[3 * CQKV + c] * bf2f(P[row * NINP + PC_QKV + c]));
        (part == 0 ? sq : part == 1 ? sk : svv)[j] = y;
    }
    __syncthreads();
    if (F.wave < 2) { LAS float* p = F.wave == 0 ? sq : sk; const float x0 = p[F.lane], x1 = p[64 + F.lane]; const float inv = 1.f / sqrtf(wave_sum(x0 * x0 + x1 * x1) + 1e-6f); p[F.lane] = x0 * inv; p[64 + F.lane] = x1 * inv; }
    __syncthreads();
    const float beta = sigmoidf_(SC[row * 32 + h]); const float eg = __expf(-__expf(INP(float, I_ALOG)[l * 4 + h]) * softplusf_(SC[row * 32 + 4 + h] + INP(float, I_DTB)[l * 4 + h]));
    const int dv = tid & 127, ks = tid >> 7;
    const float* S0 = INP(float, I_SDELTA) + ((size_t)(l * MS + b) * 4 + h) * 128 * 128;
    float sreg[32]; float part = 0.f;
#pragma unroll
    for (int i = 0; i < 32; ++i) { sreg[i] = S0[(size_t)(ks * 32 + i) * 128 + dv]; part += sk[ks * 32 + i] * sreg[i]; }
    red[ks * 128 + dv] = part;
    __syncthreads();
    const float kS = red[dv] + red[128 + dv] + red[256 + dv] + red[384 + dv];
    const float vn = beta * (svv[dv] - eg * kS);
    __syncthreads();
    float* od = a.out + O_DELTA_S + ((size_t)(l * MS + b) * 4 + h) * 128 * 128; float po = 0.f;
#pragma unroll
    for (int i = 0; i < 32; ++i) { const float sn = eg * sreg[i] + sk[ks * 32 + i] * vn; od[(size_t)(ks * 32 + i) * 128 + dv] = sn; po += sq[ks * 32 + i] * sn; }
    red[ks * 128 + dv] = po;
    __syncthreads();
    if (tid < 128) { const float o = (red[dv] + red[128 + dv] + red[256 + dv] + red[384 + dv]) * 0.08838834764831845f; misc[dv] = o; }
    __syncthreads();
    if (F.wave == 0) { const float o0 = misc[F.lane], o1 = misc[64 + F.lane]; const float r = 1.f / sqrtf(wave_sum(o0 * o0 + o1 * o1) * (1.f / 128.f) + LN_EPS);
        bf16* OA = WSP(bf16, WS_OAB) + row * 512 + h * 128; const float* nw = INP(float, I_NORMW) + l * 128;
        const float z0 = bf2f(P[row * NINP + PC_Z + h * 128 + F.lane]), z1 = bf2f(P[row * NINP + PC_Z + h * 128 + 64 + F.lane]);
        OA[F.lane] = (bf16)f2bf(o0 * r * nw[F.lane] * siluf_(z0)); OA[64 + F.lane] = (bf16)f2bf(o1 * r * nw[64 + F.lane] * siluf_(z1)); }
    __syncthreads();
}

__device__ __forceinline__ void gdn_onorm(Frame& F, const Args& a, int l) {
    LAS float* tile = (LAS float*)(F.lds + RING_OFF);
    const bf16* P = WSP(bf16, WS_P); const float* nw = INP(float, I_NORMW) + l * 128;
    for (int unit = F.bid; unit < 8 * NCHUNK; unit += F.G) {
        const int bh = unit >> 7, n = unit & 127, b = bh >> 2, h = bh & 3; const size_t row0 = (size_t)b * SEQ + n * CHUNK;
        const float* src = WSP(float, GDN_OT) + (size_t)unit * 8192;
        { float tv[16];
#pragma unroll
          for (int q = 0; q < 16; ++q) tv[q] = src[F.tid + q * NTHR];
#pragma unroll
          for (int q = 0; q < 16; ++q) { const int i = F.tid + q * NTHR; tile[(i >> 6) * 65 + (i & 63)] = tv[q]; } }
        __syncthreads();
        const int c = F.tid >> 3, part = F.tid & 7;
        float v[16]; float ss = 0.f;
#pragma unroll
        for (int i = 0; i < 16; ++i) { v[i] = tile[(part * 16 + i) * 65 + c]; ss += v[i] * v[i]; }
        ss += shx<1>(ss); ss += shx<2>(ss); ss += shx<4>(ss);
        const float r = 1.f / sqrtf(ss * (1.f / 128.f) + LN_EPS);
        const bf16* zp = P + (row0 + c) * NINP + PC_Z + h * 128 + part * 16; bf16* op = WSP(bf16, WS_OAB) + (row0 + c) * 512 + h * 128 + part * 16;
        const v4u z0 = *(const GAS v4u*)zp, z1 = *(const GAS v4u*)(zp + 8); const unsigned zz[8] = {z0.x, z0.y, z0.z, z0.w, z1.x, z1.y, z1.z, z1.w};
        unsigned o[8];
#pragma unroll
        for (int i = 0; i < 8; ++i) { const float a0 = v[2 * i] * r * nw[part * 16 + 2 * i] * siluf_(bflo(zz[i])), a1 = v[2 * i + 1] * r * nw[part * 16 + 2 * i + 1] * siluf_(bfhi(zz[i])); o[i] = pk2(a0, a1); }
        *(GAS v4u*)op = (v4u){o[0], o[1], o[2], o[3]}; *(GAS v4u*)(op + 8) = (v4u){o[4], o[5], o[6], o[7]};
        __syncthreads();
    }
}
struct EpiUp {
    static constexpr bool PERM = true, AFTER_DRAIN = false, CHAIN = true;
    const bf16* P; bf16* U;
    template <bool FINAL> __device__ __forceinline__ void run(pg8::f32x4 (&acc)[2][2][4][2], const pg8::Unit& u, int wr, int wc, int fr, int fq) const {
        asm volatile("" : "+v"(fr), "+v"(fq));
#pragma unroll
        for (int ai = 0; ai < 2; ++ai)
#pragma unroll
            for (int m = 0; m < 4; ++m) {
                const size_t row = (size_t)u.pm * 256 + ai * 128 + wr * 64 + m * 16 + fr;
#pragma unroll
                for (int bj = 0; bj < 2; ++bj) {
                    const int j = wc * 32 + 8 * fq;
                    const v4u g = *(const GAS v4u*)(P + row * NINP + PC_GM + 256 * (2 * u.pn + bj) + (FINAL ? 128 : 0) + j);
                    pg8::f32x4 v0 = acc[ai][bj][m][0], v1 = acc[ai][bj][m][1];
                    v0[0] *= bflo(g.x); v0[1] *= bfhi(g.x); v0[2] *= bflo(g.y); v0[3] *= bfhi(g.y); v1[0] *= bflo(g.z); v1[1] *= bfhi(g.z); v1[2] *= bflo(g.w); v1[3] *= bfhi(g.w);
                    if (FINAL) { v4u w; w.x = pk2(v0[0], v0[1]); w.y = pk2(v0[2], v0[3]); w.z = pk2(v1[0], v1[1]); w.w = pk2(v1[2], v1[3]); *(GAS v4u*)(U + row * D + u.pn * 256 + bj * 128 + j) = w; }
                    else { acc[ai][bj][m][0] = v0; acc[ai][bj][m][1] = v1; }
                }
                asm volatile("" ::: "memory");
            }
    }
    __device__ __forceinline__ void mid(pg8::f32x4 (&acc)[2][2][4][2], const pg8::Unit& u, int wr, int wc, int fr, int fq) const { run<false>(acc, u, wr, wc, fr, fq); }
    __device__ __forceinline__ void operator()(pg8::f32x4 (&acc)[2][2][4][2], const pg8::Unit& u, int wr, int wc, int fr, int fq) const { run<true>(acc, u, wr, wc, fr, fq); }
};
struct ChainOrder {
    int G, c;
    __device__ bool next(int i, pg8::Unit& u) const {
        const int L = i * G + c; if (L >= 64 * 4) return false;
        u.pm = L & 63; u.pn = L >> 6; u.am = u.pm; u.bn = u.pn; u.am2 = u.pm + NTILE_M; u.bn2 = u.pn + 4; return true;
    }
    __device__ __forceinline__ void a_ready(const pg8::Unit&) const {}
    __device__ __forceinline__ void done(const pg8::Unit&) const {}
};
struct EpiY {
    static constexpr bool PERM = true, AFTER_DRAIN = false, CHAIN = false;
    bf16* Y;
    __device__ __forceinline__ void mid(const pg8::f32x4 (&)[2][2][4][2], const pg8::Unit&, int, int, int, int) const {}
    __device__ __forceinline__ void operator()(const pg8::f32x4 (&acc)[2][2][4][2], const pg8::Unit& u, int wr, int wc, int fr, int fq) const {
        asm volatile("" : "+v"(fr), "+v"(fq));
        const int colb = u.pn * 256 + wc * 32 + 8 * fq;
#pragma unroll
        for (int ai = 0; ai < 2; ++ai)
#pragma unroll
            for (int m = 0; m < 4; ++m) { bf16* rp = Y + ((size_t)u.pm * 256 + ai * 128 + wr * 64 + m * 16 + fr) * D + colb;
#pragma unroll
                for (int bj = 0; bj < 2; ++bj) { const pg8::f32x4 v0 = acc[ai][bj][m][0], v1 = acc[ai][bj][m][1];
                    v4u w; w.x = pk2(v0[0], v0[1]); w.y = pk2(v0[2], v0[3]); w.z = pk2(v1[0], v1[1]); w.w = pk2(v1[2], v1[3]); *(GAS v4u*)(rp + bj * 128) = w; } }
    }
};
struct EpiSwiglu {
    static constexpr bool PERM = true, AFTER_DRAIN = false, CHAIN = false;
    bf16* ACT;
    __device__ __forceinline__ void mid(const pg8::f32x4 (&)[2][2][4][2], const pg8::Unit&, int, int, int, int) const {}
    __device__ __forceinline__ void operator()(const pg8::f32x4 (&acc)[2][2][4][2], const pg8::Unit& u, int wr, int wc, int fr, int fq) const {
        asm volatile("" : "+v"(fr), "+v"(fq));
        const int col = u.pn * 128 + wc * 32 + 8 * fq;
#pragma unroll
        for (int ai = 0; ai < 2; ++ai)
#pragma unroll
            for (int m = 0; m < 4; ++m) { bf16* rp = ACT + ((size_t)u.pm * 256 + ai * 128 + wr * 64 + m * 16 + fr) * DFF + col;
                float o[8];
#pragma unroll
                for (int n = 0; n < 2; ++n)
#pragma unroll
                    for (int q = 0; q < 4; ++q) { const float g = acc[ai][0][m][n][q]; o[4 * n + q] = g / (1.f + __expf(-g)) * acc[ai][1][m][n][q]; }
                v4u w; w.x = pk2(o[0], o[1]); w.y = pk2(o[2], o[3]); w.z = pk2(o[4], o[5]); w.w = pk2(o[6], o[7]); *(GAS v4u*)rp = w; }
    }
};
template <int nN> struct MoeOrder {
    int G, c; const int* meta;
    __device__ bool next(int i, pg8::Unit& u) const {
        const int L = i * G + c, nt = __builtin_amdgcn_readfirstlane(meta[0]); if (L >= nt * nN) return false;
        u.pm = L / nN; u.pn = L % nN; u.am = u.pm; u.bn = __builtin_amdgcn_readfirstlane(meta[16 + u.pm]) * nN + u.pn; u.am2 = 0; u.bn2 = 0; return true;
    }
    __device__ __forceinline__ void a_ready(const pg8::Unit&) const {}
    __device__ __forceinline__ void done(const pg8::Unit&) const {}
};
template <int MODE> __device__ __forceinline__ void gemm_rows32(Frame& F, const Args& a, int nt16, const bf16* A, int lda, const bf16* Bt, int K, const bf16* A2, const bf16* Bt2, bf16* Y, bf16* U) {
    LAS float* red = (LAS float*)(F.lds + RING_OFF);
    const int lane = F.lane, wave = F.wave, fr = lane & 15, fq = lane >> 4, n0 = nt16 * 16;
    f32x4 acc[2] = {(f32x4){0.f, 0.f, 0.f, 0.f}, (f32x4){0.f, 0.f, 0.f, 0.f}};
    { const int nst = K / 32, per = (nst + 7) / 8, s0 = wave * per, s1 = s0 + per < nst ? s0 + per : nst;
      for (int s = s0; s < s1; ++s) { const int k0 = 32 * s + 8 * fq;
          const bf16x8 b = *(const GAS bf16x8*)(Bt + (size_t)(n0 + fr) * K + k0), a0 = *(const GAS bf16x8*)(A + (size_t)fr * lda + k0), a1 = *(const GAS bf16x8*)(A + (size_t)(16 + fr) * lda + k0);
          acc[0] = __builtin_amdgcn_mfma_f32_16x16x32_bf16(a0, b, acc[0], 0, 0, 0); acc[1] = __builtin_amdgcn_mfma_f32_16x16x32_bf16(a1, b, acc[1], 0, 0, 0); } }
    const int col = n0 + fr;
    if (MODE == 1) {
        const bf16* P = WSP(bf16, WS_P);
#pragma unroll
        for (int mt = 0; mt < 2; ++mt)
#pragma unroll
            for (int i = 0; i < 4; ++i) { const size_t row = MP + 16 * mt + 4 * fq + i; acc[mt][i] *= bf2f(P[row * NINP + PC_GM + 256 * (col >> 7) + (col & 127)]); }
        const int nst = K / 32, per = (nst + 7) / 8, s0 = wave * per, s1 = s0 + per < nst ? s0 + per : nst;
        for (int s = s0; s < s1; ++s) { const int k0 = 32 * s + 8 * fq;
            const bf16x8 b = *(const GAS bf16x8*)(Bt2 + (size_t)(n0 + fr) * K + k0), a0 = *(const GAS bf16x8*)(A2 + (size_t)fr * lda + k0), a1 = *(const GAS bf16x8*)(A2 + (size_t)(16 + fr) * lda + k0);
            acc[0] = __builtin_amdgcn_mfma_f32_16x16x32_bf16(a0, b, acc[0], 0, 0, 0); acc[1] = __builtin_amdgcn_mfma_f32_16x16x32_bf16(a1, b, acc[1], 0, 0, 0); }
    }
    *(LAS f32x4*)(red + ((wave * 2 + 0) * 64 + lane) * 4) = acc[0]; *(LAS f32x4*)(red + ((wave * 2 + 1) * 64 + lane) * 4) = acc[1];
    __syncthreads();
    if (wave < 2) { f32x4 s = (f32x4){0.f, 0.f, 0.f, 0.f};
#pragma unroll
        for (int w = 0; w < 8; ++w) s += *(const LAS f32x4*)(red + ((w * 2 + wave) * 64 + lane) * 4);
#pragma unroll
        for (int i = 0; i < 4; ++i) { const size_t row = MP + 16 * wave + 4 * fq + i;
            if (MODE == 1) { const float gb = bf2f(WSP(bf16, WS_P)[row * NINP + PC_GM + 256 * (col >> 7) + 128 + (col & 127)]); U[row * D + col] = (bf16)f2bf(s[i] * gb); }
            else Y[row * D + col] = (bf16)f2bf(s[i]); } }
    __syncthreads();
}
constexpr size_t NSA_VSLT = WS_NSA, NSA_VWT = WS_NSA + 4 * MiB, NSA_KC = WS_NSA + 8 * MiB, NSA_VCT = WS_NSA + 9 * MiB, NSA_CVEC = WS_NSA + 10 * MiB, NSA_KSL = WS_NSA + 12 * MiB, NSA_KW = WS_NSA + 16 * MiB;
constexpr size_t SMP_SEG = WS_SMP, SMP_HP = WS_SMP + 272 * MiB, SMP_KCS = WS_SMP + 340 * MiB, SMP_VCS = WS_SMP + 348 * MiB;
constexpr int SEGROWS = 34816, SEGTILES = 136;
static_assert(SMP_VCS + 8 * MiB <= WS_END, "ws map");
__device__ __forceinline__ int kperm_inv(int p) { return (p & ~31) | (((p >> 2) & 1) << 4) | (((p >> 3) & 3) << 2) | (p & 3); }

__device__ __forceinline__ void nsa_prologue(Frame& F, const Args& a) {
    const int NGW = F.G * NWAVES, gw = F.bid * NWAVES + F.wave;
    for (int wv = NGW - 1 - gw; wv < 256; wv += NGW) { const int q = wv >> 6, col = (wv & 63) * 4 + (F.lane & 3), ks = F.lane >> 2;
        const float* pos = INP(float, I_CPOS) + (size_t)q * 2048 + ks * 128; const float* w1 = INP(float, I_CW1) + ((size_t)q * 2048 + ks * 128) * 256 + col; float acc = 0.f;
#pragma unroll 16
        for (int i = 0; i < 128; ++i) acc += pos[i] * w1[(size_t)i * 256];
        acc += shx<4>(acc); acc += shx<8>(acc); acc += shx<16>(acc); acc += shx<32>(acc);
        if (F.lane < 4) WSP(float, NSA_CVEC)[q * 256 + col] = acc; }
    for (int it = gw; it < MS * NPAGES; it += NGW) seg_page<8>(F, a, it);
}
template <int NR> __device__ __forceinline__ void seg_page(Frame& F, const Args& a, int it) {
    const int* pt = INP(int, I_PT); const int kv = F.lane >> 5, g = (F.lane >> 4) & 1, d4 = F.lane & 15;
    const int p = it & 63, b = (it >> 6) & 31, l = it >> 11;
    const int page = pt[b * NPAGES + p];
    const float* src = INP(float, I_CCMP) + (((size_t)l * NPOOL + page) * PAGE) * KVW + 4 * F.lane;
    bf16* dst0 = WSP(bf16, SMP_SEG) + (((size_t)(l * 2 + kv) * SEGROWS) + 2048 + (size_t)(b * 2 + g) * 512 + p * 8) * 1024 + 4 * d4;
    for (int r0 = 0; r0 < PAGE; r0 += NR) { f32x4 v[NR];
#pragma unroll
        for (int j = 0; j < NR; ++j) v[j] = *(const GAS f32x4*)(src + (size_t)(r0 + j) * KVW);
#pragma unroll
        for (int j = 0; j < NR; ++j) { const int r = r0 + j; v2u o; o.x = pk2(v[j].x, v[j].y); o.y = pk2(v[j].z, v[j].w); *(GAS v2u*)(dst0 + (size_t)(r >> 4) * 1024 + (r & 15) * 64) = o; } }
}
__device__ __forceinline__ void nsa_prep(Frame& F, const Args& a, int l) {
    const int NGW = F.G * NWAVES, gw = F.bid * NWAVES + F.wave; const bf16* P = WSP(bf16, WS_P);
    { const int kv = F.lane >> 5, g = (F.lane >> 4) & 1, d4 = F.lane & 15;
      for (int row = gw; row < MP; row += NGW) { const int b = row >> 13, t = row & (SEQ - 1);
          const v2u v = *(const GAS v2u*)(P + (size_t)row * NINP + PC_KVC + 4 * F.lane);
          *(GAS v2u*)(WSP(bf16, SMP_SEG) + (((size_t)(l * 2 + kv) * SEGROWS) + (size_t)(b * 2 + g) * 512 + (t >> 4)) * 1024 + (t & 15) * 64 + 4 * d4) = v; } }
    LAS bf16* tile = (LAS bf16*)(F.lds + RING_OFF + F.wave * 16384);
    for (int unit = gw; unit < 2 * 4 * 128; unit += NGW) {
        const int tb = unit & 127, bg = (unit >> 7) & 3, kind = unit >> 9, b = bg >> 1, g = bg & 1;
        const bf16* src = P + ((size_t)b * SEQ + tb * 64 + F.lane) * NINP + (kind ? PC_KVW : PC_KVS) + g * 64;
        bf16* kd = WSP(bf16, kind ? NSA_KW : NSA_KSL) + ((size_t)bg * SEQ + tb * 64 + F.lane) * 64;
#pragma unroll
        for (int q = 0; q < 8; ++q) { *(GAS v4u*)(kd + 8 * q) = *(const GAS v4u*)(src + 8 * q); *(LAS v4u*)(tile + F.lane * 72 + 8 * q) = *(const GAS v4u*)(src + 128 + 8 * q); }
        LDS_WAIT(); asm volatile("" ::: "memory");
        bf16* dst = WSP(bf16, kind ? NSA_VWT : NSA_VSLT) + ((size_t)bg * 128 + tb) * 4096 + F.lane; const int ts = kperm_inv(F.lane);
        for (int d = 0; d < 64; ++d) dst[d * 64] = tile[ts * 72 + d];
        LDS_WAIT(); asm volatile("" ::: "memory");
    }
}
struct CmpOrder {
    int G, c;
    __device__ bool next(int i, pg8::Unit& u) const {
        const int L = i * G + c; if (L >= 2 * SEGTILES * 2) return false;
        const int kv = L / (SEGTILES * 2), rem = L % (SEGTILES * 2); u.pn = rem / SEGTILES; u.pm = kv * SEGTILES + rem % SEGTILES; u.am = u.pm; u.bn = kv * 2 + u.pn; u.am2 = 0; u.bn2 = 0; return true;
    }
    __device__ __forceinline__ void a_ready(const pg8::Unit&) const {}
    __device__ __forceinline__ void done(const pg8::Unit&) const {}
};
struct EpiBf16P {
    static constexpr bool PERM = true, AFTER_DRAIN = false, CHAIN = false;
    bf16* O; int ld;
    __device__ __forceinline__ void mid(const pg8::f32x4 (&)[2][2][4][2], const pg8::Unit&, int, int, int, int) const {}
    __device__ __forceinline__ void operator()(const pg8::f32x4 (&acc)[2][2][4][2], const pg8::Unit& u, int wr, int wc, int fr, int fq) const {
        asm volatile("" : "+v"(fr), "+v"(fq));
        const int colb = u.pn * 256 + wc * 32 + 8 * fq;
#pragma unroll
        for (int ai = 0; ai < 2; ++ai)
#pragma unroll
            for (int m = 0; m < 4; ++m) { bf16* rp = O + ((size_t)u.pm * 256 + ai * 128 + wr * 64 + m * 16 + fr) * ld + colb;
#pragma unroll
                for (int bj = 0; bj < 2; ++bj) { const pg8::f32x4 v0 = acc[ai][bj][m][0], v1 = acc[ai][bj][m][1];
                    v4u w; w.x = pk2(v0[0], v0[1]); w.y = pk2(v0[2], v0[3]); w.z = pk2(v1[0], v1[1]); w.w = pk2(v1[2], v1[3]); *(GAS v4u*)(rp + bj * 128) = w; } }
    }
};
__device__ __forceinline__ void nsa_cmp2(Frame& F, const Args& a, int l) {
    constexpr int WP = 528;
    LAS unsigned char* w2t = F.lds + RING_OFF;
    const bf16* HP = WSP(bf16, SMP_HP); int kv_in_lds = -1;
    const int lane = F.lane, fr = lane & 15, fq = lane >> 4;
    for (int unit = F.bid; unit < (256 + 4096) / 8; unit += F.G) {
        const int gidx = unit * 8 + F.wave; int kv, bg, nb, smp;
        if (gidx < 256) { smp = 0; nb = gidx & 31; bg = (gidx >> 5) & 3; kv = gidx >> 7; } else { const int u2 = gidx - 256; smp = 1; nb = u2 & 31; bg = (u2 >> 5) & 63; kv = u2 >> 11; }
        const int kvb = __builtin_amdgcn_readfirstlane((unit * 8 < 256) ? (unit * 8) >> 7 : (unit * 8 - 256) >> 11);
        if (kvb != kv_in_lds) { __syncthreads();
            const float* w2 = INP(float, I_CW2) + (size_t)(l * 2 + kvb) * 256 * 64;
            for (int i = F.tid; i < 256 * 64; i += NTHR) { const int c = i >> 6, d = i & 63; *(LAS bf16*)(w2t + d * WP + c * 2) = (bf16)f2bf(w2[i]); }
            kv_in_lds = kvb; __syncthreads(); }
        const size_t R0 = (size_t)kv * SEGROWS + (smp ? 2048 : 0) + (size_t)bg * 512 + nb * 16;
        const float* cv = WSP(float, NSA_CVEC) + (l * 2 + kv) * 256;
        const int n = nb * 16 + fr;
        f32x4 acc[4] = {(f32x4){0.f, 0.f, 0.f, 0.f}, (f32x4){0.f, 0.f, 0.f, 0.f}, (f32x4){0.f, 0.f, 0.f, 0.f}, (f32x4){0.f, 0.f, 0.f, 0.f}};
        v4u x0[8], x1[8];
#pragma unroll
        for (int ks = 0; ks < 8; ++ks) { const int c = 32 * ks + 8 * fq; x0[ks] = *(const GAS v4u*)(HP + (R0 + fr) * 512 + c); x1[ks] = *(const GAS v4u*)(HP + (R0 + fr + 1) * 512 + 256 + c); }
#pragma unroll
        for (int ks = 0; ks < 8; ++ks) { const int c = 32 * ks + 8 * fq; const f32x4 c0 = *(const GAS f32x4*)(cv + c), c1 = *(const GAS f32x4*)(cv + c + 4);
            float h[8] = {bflo(x0[ks].x) + bflo(x1[ks].x) + c0.x, bfhi(x0[ks].x) + bfhi(x1[ks].x) + c0.y, bflo(x0[ks].y) + bflo(x1[ks].y) + c0.z, bfhi(x0[ks].y) + bfhi(x1[ks].y) + c0.w,
                          bflo(x0[ks].z) + bflo(x1[ks].z) + c1.x, bfhi(x0[ks].z) + bfhi(x1[ks].z) + c1.y, bflo(x0[ks].w) + bflo(x1[ks].w) + c1.z, bfhi(x0[ks].w) + bfhi(x1[ks].w) + c1.w};
#pragma unroll
            for (int q = 0; q < 8; ++q) h[q] = n < NCMP ? siluf_(h[q]) : 0.f;
            v4u w; w.x = pk2(h[0], h[1]); w.y = pk2(h[2], h[3]); w.z = pk2(h[4], h[5]); w.w = pk2(h[6], h[7]); const bf16x8 af = __builtin_bit_cast(bf16x8, w);
#pragma unroll
            for (int nt = 0; nt < 4; ++nt) { const bf16x8 bfr = *(const LAS bf16x8*)(w2t + (16 * nt + fr) * WP + (32 * ks + 8 * fq) * 2); acc[nt] = __builtin_amdgcn_mfma_f32_16x16x32_bf16(af, bfr, acc[nt], 0, 0, 0); } }
#pragma unroll
        for (int nt = 0; nt < 4; ++nt)
#pragma unroll
            for (int i = 0; i < 4; ++i) { const int nn = nb * 16 + 4 * fq + i, d = 16 * nt + fr; const float o = acc[nt][i];
                if (smp) WSP(float, kv ? SMP_VCS : SMP_KCS)[((size_t)bg * 512 + nn) * 64 + d] = o;
                else if (kv == 0) WSP(bf16, NSA_KC)[((size_t)bg * 512 + nn) * 64 + d] = (bf16)f2bf(o);
                else WSP(bf16, NSA_VCT)[((size_t)bg * 64 + d) * 512 + kperm(nn)] = (bf16)f2bf(o); }
    }
}
constexpr int AT_KB = 9216, AT_SLOT = 2 * AT_KB;
constexpr int AT_IMP = 3 * AT_SLOT;
constexpr int AT_SEL = AT_IMP + 8 * 4096;
constexpr float AT_C2 = 0.125f * 1.4426950408889634f;
struct AtStg { v4u k, v; };
__device__ __forceinline__ void at_load(AtStg& s, const bf16* kl, const bf16* vl) { s.k = *(const GAS v4u*)kl; s.v = *(const GAS v4u*)vl; }
__device__ __forceinline__ void at_store(const AtStg& s, LAS unsigned char* slot, int tid) {
    const int r = tid >> 3, c = (tid & 7) * 16;
    *(LAS v4u*)(slot + r * 144 + c) = s.k; *(LAS v4u*)(slot + AT_KB + r * 144 + c) = s.v;
}
#define AT_SB() __builtin_amdgcn_sched_barrier(0)
__device__ __forceinline__ void at_swap16(unsigned& a, unsigned& b) { asm volatile("s_nop 1\n\tv_permlane16_swap_b32 %0, %1" : "+v"(a), "+v"(b)); }
__device__ __forceinline__ void at_swap32(unsigned& a, unsigned& b) { asm volatile("s_nop 1\n\tv_permlane32_swap_b32 %0, %1" : "+v"(a), "+v"(b)); }
__device__ __forceinline__ float at_rmax(float v) { unsigned a = __builtin_bit_cast(unsigned, v), b = a; at_swap16(a, b);
    const float w = fmaxf(__builtin_bit_cast(float, a), __builtin_bit_cast(float, b)); unsigned c = __builtin_bit_cast(unsigned, w), d = c; at_swap32(c, d);
    return fmaxf(__builtin_bit_cast(float, c), __builtin_bit_cast(float, d)); }
__device__ __forceinline__ float at_rsum(float v) { unsigned a = __builtin_bit_cast(unsigned, v), b = a; at_swap16(a, b);
    const float w = __builtin_bit_cast(float, a) + __builtin_bit_cast(float, b); unsigned c = __builtin_bit_cast(unsigned, w), d = c; at_swap32(c, d);
    return __builtin_bit_cast(float, c) + __builtin_bit_cast(float, d); }
__device__ __forceinline__ void at_qk(f32x4 (&sc)[4][2], const LAS unsigned char* slot, const bf16x8 (&Qb)[2][2], int fr, int fq) {
    bf16x8 kf[4][2];
#pragma unroll
    for (int mt = 0; mt < 4; ++mt)
#pragma unroll
        for (int ks = 0; ks < 2; ++ks) kf[mt][ks] = *(const LAS bf16x8*)(slot + (16 * mt + fr) * 144 + (32 * ks + 8 * fq) * 2);
    AT_SB();
#pragma unroll
    for (int mt = 0; mt < 4; ++mt) { sc[mt][0] = (f32x4){0.f, 0.f, 0.f, 0.f}; sc[mt][1] = (f32x4){0.f, 0.f, 0.f, 0.f};
#pragma unroll
        for (int ks = 0; ks < 2; ++ks) { sc[mt][0] = __builtin_amdgcn_mfma_f32_16x16x32_bf16(kf[mt][ks], Qb[0][ks], sc[mt][0], 0, 0, 0); sc[mt][1] = __builtin_amdgcn_mfma_f32_16x16x32_bf16(kf[mt][ks], Qb[1][ks], sc[mt][1], 0, 0, 0); } }
    AT_SB();
}
__device__ __forceinline__ void at_vfrag(bf16x8 (&vf)[2][2], const LAS unsigned char* slot, int fr, int fq) {
#pragma unroll
    for (int dt = 0; dt < 2; ++dt)
#pragma unroll
        for (int kc = 0; kc < 2; ++kc) vf[dt][kc] = *(const LAS bf16x8*)(slot + AT_KB + (16 * dt + fr) * 144 + (32 * kc + 8 * fq) * 2);
}
template <int TM> __device__ __forceinline__ void at_pv_t(f32x4 (&oc)[4][2], const f32x4 (&p)[4][2], const bf16x8 (&vf)[2][2], const LAS unsigned char* slot, int fr, int fq) {
    bf16x8 Bp[2][2], vg[2][2];
#pragma unroll
    for (int nt = 0; nt < 2; ++nt) if (TM >> nt & 1)
#pragma unroll
        for (int kc = 0; kc < 2; ++kc) { v4u w; w.x = pk2(p[2 * kc][nt][0], p[2 * kc][nt][1]); w.y = pk2(p[2 * kc][nt][2], p[2 * kc][nt][3]); w.z = pk2(p[2 * kc + 1][nt][0], p[2 * kc + 1][nt][1]); w.w = pk2(p[2 * kc + 1][nt][2], p[2 * kc + 1][nt][3]); Bp[nt][kc] = __builtin_bit_cast(bf16x8, w); }
#pragma unroll
    for (int dt = 0; dt < 2; ++dt)
#pragma unroll
        for (int kc = 0; kc < 2; ++kc) vg[dt][kc] = *(const LAS bf16x8*)(slot + AT_KB + (16 * (2 + dt) + fr) * 144 + (32 * kc + 8 * fq) * 2);
    AT_SB();
#pragma unroll
    for (int dt = 0; dt < 2; ++dt)
#pragma unroll
        for (int kc = 0; kc < 2; ++kc)
#pragma unroll
            for (int nt = 0; nt < 2; ++nt) if (TM >> nt & 1) oc[dt][nt] = __builtin_amdgcn_mfma_f32_16x16x32_bf16(vf[dt][kc], Bp[nt][kc], oc[dt][nt], 0, 0, 0);
#pragma unroll
    for (int dt = 0; dt < 2; ++dt)
#pragma unroll
        for (int kc = 0; kc < 2; ++kc)
#pragma unroll
            for (int nt = 0; nt < 2; ++nt) if (TM >> nt & 1) oc[2 + dt][nt] = __builtin_amdgcn_mfma_f32_16x16x32_bf16(vg[dt][kc], Bp[nt][kc], oc[2 + dt][nt], 0, 0, 0);
}
__device__ __forceinline__ float at_x32(float v, int x32) { return __builtin_bit_cast(float, __builtin_amdgcn_ds_bpermute(x32, __builtin_bit_cast(int, v))); }
template <bool ROWSEL> __device__ __forceinline__ void at_online(f32x4 (&sc)[4][2], float (&m)[2], float (&l)[2], f32x4 (&oc)[4][2], const bool (&on)[2]) {
#pragma unroll
    for (int nt = 0; nt < 2; ++nt) {
        float mx = -INFINITY;
#pragma unroll
        for (int mt = 0; mt < 4; ++mt) mx = fmaxf(fmaxf(fmaxf(sc[mt][nt][0], sc[mt][nt][1]), fmaxf(sc[mt][nt][2], sc[mt][nt][3])), mx);
        mx = at_rmax(mx);
        if (ROWSEL) mx = on[nt] ? mx : -INFINITY;
        const float mn = fmaxf(m[nt], mx * AT_C2), ms = mn == -INFINITY ? 0.f : mn, alpha = __builtin_amdgcn_exp2f(m[nt] - ms);
        const float mse = ROWSEL ? (on[nt] ? ms : INFINITY) : ms;
        float s = 0.f;
#pragma unroll
        for (int mt = 0; mt < 4; ++mt)
#pragma unroll
            for (int i = 0; i < 4; ++i) { const float e = __builtin_amdgcn_exp2f(__builtin_fmaf(sc[mt][nt][i], AT_C2, -mse)); sc[mt][nt][i] = e; s += e; }
        s = at_rsum(s);
        l[nt] = l[nt] * alpha + s; m[nt] = mn;
        if (__builtin_amdgcn_ballot_w64(alpha != 1.f) != 0ull) {
#pragma unroll
            for (int dt = 0; dt < 4; ++dt) oc[dt][nt] = oc[dt][nt] * alpha; }
    }
}
template <int TM> __device__ __forceinline__ void at_sel(f32x4 (&sc)[4][2], float (&m)[2], float (&l)[2], f32x4 (&oc)[4][2], const LAS unsigned char* slot, const bf16x8 (&Qb)[2][2], const bool (&on)[2], int fr, int fq) {
    bf16x8 kf[4][2], vf[2][2];
#pragma unroll
    for (int mt = 0; mt < 4; ++mt)
#pragma unroll
        for (int ks = 0; ks < 2; ++ks) kf[mt][ks] = *(const LAS bf16x8*)(slot + (16 * mt + fr) * 144 + (32 * ks + 8 * fq) * 2);
    AT_SB();
#pragma unroll
    for (int mt = 0; mt < 4; ++mt) {
#pragma unroll
        for (int nt = 0; nt < 2; ++nt) if (TM >> nt & 1) sc[mt][nt] = (f32x4){0.f, 0.f, 0.f, 0.f};
#pragma unroll
        for (int ks = 0; ks < 2; ++ks)
#pragma unroll
            for (int nt = 0; nt < 2; ++nt) if (TM >> nt & 1) sc[mt][nt] = __builtin_amdgcn_mfma_f32_16x16x32_bf16(kf[mt][ks], Qb[nt][ks], sc[mt][nt], 0, 0, 0); }
    AT_SB();
    at_vfrag(vf, slot, fr, fq);
#pragma unroll
    for (int nt = 0; nt < 2; ++nt) if (TM >> nt & 1) {
        float mx = -INFINITY;
#pragma unroll
        for (int mt = 0; mt < 4; ++mt) mx = fmaxf(fmaxf(fmaxf(sc[mt][nt][0], sc[mt][nt][1]), fmaxf(sc[mt][nt][2], sc[mt][nt][3])), mx);
        mx = at_rmax(mx);
        mx = on[nt] ? mx : -INFINITY;
        const float mn = fmaxf(m[nt], mx * AT_C2), ms = mn == -INFINITY ? 0.f : mn, alpha = __builtin_amdgcn_exp2f(m[nt] - ms), mse = on[nt] ? ms : INFINITY;
        float s = 0.f;
#pragma unroll
        for (int mt = 0; mt < 4; ++mt)
#pragma unroll
            for (int i = 0; i < 4; ++i) { const float e = __builtin_amdgcn_exp2f(__builtin_fmaf(sc[mt][nt][i], AT_C2, -mse)); sc[mt][nt][i] = e; s += e; }
        s = at_rsum(s);
        l[nt] = l[nt] * alpha + s; m[nt] = mn;
        if (__builtin_amdgcn_ballot_w64(alpha != 1.f) != 0ull) {
#pragma unroll
            for (int dt = 0; dt < 4; ++dt) oc[dt][nt] = oc[dt][nt] * alpha; }
    }
    at_pv_t<TM>(oc, sc, vf, slot, fr, fq);
}
#define AT_SYNC() LBAR()
__device__ __forceinline__ unsigned at_w4(const unsigned (&a)[4], int w) { return w == 0 ? a[0] : w == 1 ? a[1] : w == 2 ? a[2] : a[3]; }
#define AT_STEP(i_, LREG, SREG, BODY, nblk, KSTR, VSTR) do { \
        LAS unsigned char* slot = ring + s3_ * AT_SLOT; const int s3n_ = s3_ == 2 ? 0 : s3_ + 1; \
        if ((i_) + 2 < (nblk)) { kl_ += (KSTR); vl_ += (VSTR); } \
        at_load(LREG, kl_, vl_); \
        BODY(i_); \
        at_store(SREG, ring + s3n_ * AT_SLOT, tid); \
        s3_ = s3n_; AT_SYNC(); } while (0)
#define AT_LOOP(nblk, K0, V0, KSTR, VSTR, BODY) do { \
        AtStg stgA_, stgB_; const bf16* kl_ = (K0); const bf16* vl_ = (V0); int s3_ = 0; \
        at_load(stgA_, kl_, vl_); at_store(stgA_, ring, tid); \
        if (1 < (nblk)) { kl_ += (KSTR); vl_ += (VSTR); } \
        at_load(stgB_, kl_, vl_); \
        AT_SYNC(); \
        for (int i_ = 0; i_ < (nblk); i_ += 2) { \
            AT_STEP(i_, stgA_, stgB_, BODY, nblk, KSTR, VSTR); \
            if (i_ + 1 < (nblk)) AT_STEP(i_ + 1, stgB_, stgA_, BODY, nblk, KSTR, VSTR); \
        } } while (0)

__device__ __forceinline__ void nsa_attn_tile(Frame& F, const Args& a, int l, int b, int g, int tb) {
    LAS unsigned char* ring = F.lds + RING_OFF;
    int tid_l = F.tid, lane_l = F.lane; asm volatile("" : "+v"(tid_l), "+v"(lane_l));
    const int tid = tid_l, lane = lane_l, wave = F.wave, fr = lane & 15, fq = lane >> 4;
    LAS float* impw = (LAS float*)(F.lds + RING_OFF + AT_IMP + wave * 4096);
    LAS unsigned* selw = (LAS unsigned*)(F.lds + RING_OFF + AT_SEL + wave * 128);
    const bf16* P = WSP(bf16, WS_P); const float* SC = WSP(float, WS_SC);
    const int t0 = tb * 64, bg = b * 2 + g;
    int tt[2], head = fr & 3; size_t row[2];
#pragma unroll
    for (int nt = 0; nt < 2; ++nt) { tt[nt] = wave * 8 + 4 * nt + (fr >> 2); row[nt] = (size_t)b * SEQ + t0 + tt[nt]; }
    bf16x8 Qb[2][2];
#pragma unroll
    for (int nt = 0; nt < 2; ++nt)
#pragma unroll
        for (int ks = 0; ks < 2; ++ks) Qb[nt][ks] = *(const GAS bf16x8*)(P + row[nt] * NINP + PC_QB + (4 * g + head) * 64 + 32 * ks + 8 * fq);
    f32x4 outa[4][2];
#pragma unroll
    for (int dt = 0; dt < 4; ++dt) { outa[dt][0] = (f32x4){0.f, 0.f, 0.f, 0.f}; outa[dt][1] = (f32x4){0.f, 0.f, 0.f, 0.f}; }
    f32x4 sc[4][2], oc[4][2]; bf16x8 vf[2][2]; float m[2], lsum[2];
    const int pr_ = tid >> 3, pc_ = (tid & 7) * 8;
#define AT_RESET() do { m[0] = m[1] = -INFINITY; lsum[0] = lsum[1] = 0.f; _Pragma("unroll") for (int dt = 0; dt < 4; ++dt) { oc[dt][0] = (f32x4){0.f, 0.f, 0.f, 0.f}; oc[dt][1] = (f32x4){0.f, 0.f, 0.f, 0.f}; } } while (0)
#define AT_ACCUM(br) do { _Pragma("unroll") for (int nt = 0; nt < 2; ++nt) { const float gt = sigmoidf_(SC[row[nt] * 32 + 8 + (4 * g + head) * 3 + (br)]); const float f = lsum[nt] > 0.f ? gt / lsum[nt] : 0.f; \
        _Pragma("unroll") for (int dt = 0; dt < 4; ++dt) outa[dt][nt] += oc[dt][nt] * f; } } while (0)

#if defined(MK_TSEC)
#define TSEC(k) do { if (F.bid == 0 && tid == 0) { const unsigned t_ = (unsigned)__builtin_amdgcn_s_memrealtime(); if ((k) == MK_TSEC + 1) F.MISC[20] += t_ - F.MISC[22]; F.MISC[22] = t_; } } while (0)
#else
#define TSEC(k) do { } while (0)
#endif
    TSEC(0);
    const int nkb = (4 * tb + 3 + 63) >> 6;
    int ncmp[2];
#pragma unroll
    for (int nt = 0; nt < 2; ++nt) { const int t = t0 + tt[nt]; ncmp[nt] = t >= 31 ? (t - 15) >> 4 : 0; }
    const int ncmp_min = (t0 + wave * 8) >= 31 ? (t0 + wave * 8 - 15) >> 4 : 0;
    const bool onn[2] = {true, true};
    const bf16* KC = WSP(bf16, NSA_KC) + (size_t)bg * 512 * 64; const bf16* VCT = WSP(bf16, NSA_VCT) + (size_t)bg * 64 * 512;
    const bf16* kc0 = KC + (size_t)pr_ * 64 + pc_; const bf16* vc0 = VCT + (size_t)pr_ * 512 + pc_;
#define CMP_MASK(i) do { _Pragma("unroll") for (int mt = 0; mt < 4; ++mt) _Pragma("unroll") for (int nt = 0; nt < 2; ++nt) _Pragma("unroll") for (int q = 0; q < 4; ++q) { \
        const int n = (i) * 64 + 16 * mt + 4 * fq + q; sc[mt][nt][q] = n < ncmp[nt] ? sc[mt][nt][q] : -INFINITY; } } while (0)
    AT_RESET();
#define CMP_BODY1(i) do { at_qk(sc, slot, Qb, fr, fq); if ((i) * 64 + 64 > ncmp_min) CMP_MASK(i); at_online<false>(sc, m, lsum, oc, onn); } while (0)
    AT_LOOP(nkb, kc0, vc0, 64 * 64, 64, CMP_BODY1);
    for (int i = lane; i < 1024; i += 64) impw[i] = 0.f;
    float rinv[2], msafe[2], carry[2] = {0.f, 0.f};
#pragma unroll
    for (int nt = 0; nt < 2; ++nt) { rinv[nt] = lsum[nt] > 0.f ? 1.f / lsum[nt] : 0.f; msafe[nt] = m[nt] == -INFINITY ? 0.f : m[nt]; }
#define CMP_BODY2(i) do { at_qk(sc, slot, Qb, fr, fq); at_vfrag(vf, slot, fr, fq); if ((i) * 64 + 64 > ncmp_min) CMP_MASK(i); \
        _Pragma("unroll") for (int nt = 0; nt < 2; ++nt) { \
            _Pragma("unroll") for (int mt = 0; mt < 4; ++mt) _Pragma("unroll") for (int q = 0; q < 4; ++q) sc[mt][nt][q] = __builtin_amdgcn_exp2f(__builtin_fmaf(sc[mt][nt][q], AT_C2, -msafe[nt])) * rinv[nt]; \
            float qd[4], p3[4]; \
            _Pragma("unroll") for (int mt = 0; mt < 4; ++mt) { float x = (sc[mt][nt][0] + sc[mt][nt][1]) + (sc[mt][nt][2] + sc[mt][nt][3]), y = sc[mt][nt][3]; \
                x += shx<1>(x); x += shx<2>(x); y += shx<1>(y); y += shx<2>(y); qd[mt] = x; p3[mt] = y; } \
            _Pragma("unroll") for (int mt = 0; mt < 4; ++mt) { const float up = bperm(p3[mt], (lane + 48) & 63); const float prevmt = mt == 0 ? carry[nt] : bperm(p3[mt == 0 ? 0 : mt - 1], (lane + 48) & 63); \
                const float c = fq > 0 ? up : prevmt; \
                if ((fr & 3) == 0) impw[(4 * nt + (fr >> 2)) * 128 + (i) * 16 + 4 * mt + fq] = qd[mt] + c; } \
            carry[nt] = bperm(p3[3], (lane + 48) & 63); } \
        at_pv_t<3>(oc, sc, vf, slot, fr, fq); } while (0)
    AT_RESET(); lsum[0] = lsum[1] = 1.f;
    AT_LOOP(nkb, kc0, vc0, 64 * 64, 64, CMP_BODY2);
    AT_ACCUM(0);
    TSEC(1);
    for (int tk = 0; tk < 8; ++tk) {
        LAS float* iv = impw + tk * 128; LAS unsigned* iu = (LAS unsigned*)iv;
        float v0 = iv[lane], v1 = iv[64 + lane];
        { const int j0 = lane, j1 = lane + 64; v0 = (j0 == 0 || j0 == tb) ? 1e9f : (j0 <= tb ? v0 : -1.f); v1 = (j1 == tb) ? 1e9f : (j1 <= tb ? v1 : -1.f); }
        const unsigned b0_ = __builtin_bit_cast(unsigned, v0), b1_ = __builtin_bit_cast(unsigned, v1);
        const unsigned k0 = b0_ ^ ((b0_ >> 31) ? 0xffffffffu : 0x80000000u), k1 = b1_ ^ ((b1_ >> 31) ? 0xffffffffu : 0x80000000u);
        iu[lane] = k0; iu[64 + lane] = k1;
        LDS_WAIT(); asm volatile("" ::: "memory");
        const unsigned long long key0 = ((unsigned long long)k0 << 32) | (unsigned)(127 - lane), key1 = ((unsigned long long)k1 << 32) | (unsigned)(63 - lane);
        int c0 = 0, c1 = 0;
        const int ni4 = (((tb >> 2) + 1) + 3) & ~3;
#pragma unroll 4
        for (int i4 = 0; i4 < ni4; ++i4) { const v4u x = *(const LAS v4u*)(iu + 4 * i4);
#pragma unroll
            for (int q = 0; q < 4; ++q) { const unsigned long long ki = ((unsigned long long)x[q] << 32) | (unsigned)(127 - (4 * i4 + q));
                c0 += ki > key0 ? 1 : 0; c1 += ki > key1 ? 1 : 0; } }
        const unsigned long long b0 = __builtin_amdgcn_ballot_w64(c0 < NSEL && lane <= tb), b1 = __builtin_amdgcn_ballot_w64(c1 < NSEL && lane + 64 <= tb);
        if (lane == 0) { selw[tk * 4 + 0] = (unsigned)b0; selw[tk * 4 + 1] = (unsigned)(b0 >> 32); selw[tk * 4 + 2] = (unsigned)b1; selw[tk * 4 + 3] = (unsigned)(b1 >> 32); }
    }
    LDS_WAIT(); asm volatile("" ::: "memory");
    unsigned mkc[2] = {0u, 0u};
    TSEC(2);
    const bf16* KS = WSP(bf16, NSA_KSL) + (size_t)bg * SEQ * 64; const bf16* VST = WSP(bf16, NSA_VSLT) + (size_t)bg * 128 * 4096;
    const bf16* ks0 = KS + (size_t)pr_ * 64 + pc_; const bf16* vs0 = VST + (size_t)pr_ * 64 + pc_;
#define SEL_BODY(i) do { if (((i) & 31) == 0) { mkc[0] = selw[(fr >> 2) * 4 + ((i) >> 5)]; mkc[1] = selw[(4 + (fr >> 2)) * 4 + ((i) >> 5)]; } \
        const unsigned am_ = (__builtin_amdgcn_ballot_w64((mkc[0] >> ((i) & 31)) & 1u) != 0ull ? 1u : 0u) | (__builtin_amdgcn_ballot_w64((mkc[1] >> ((i) & 31)) & 1u) != 0ull ? 2u : 0u); \
        if (am_) { const bool on_[2] = {(bool)((mkc[0] >> ((i) & 31)) & 1u), (bool)((mkc[1] >> ((i) & 31)) & 1u)}; \
            if (am_ == 3u) at_sel<3>(sc, m, lsum, oc, slot, Qb, on_, fr, fq); else if (am_ == 1u) at_sel<1>(sc, m, lsum, oc, slot, Qb, on_, fr, fq); else at_sel<2>(sc, m, lsum, oc, slot, Qb, on_, fr, fq); } } while (0)
#define SELD_BODY(i) do { at_qk(sc, slot, Qb, fr, fq); at_vfrag(vf, slot, fr, fq); \
        _Pragma("unroll") for (int nt = 0; nt < 2; ++nt) { const bool on = (selw[(4 * nt + (fr >> 2)) * 4 + (tb >> 5)] >> (tb & 31)) & 1u; \
            _Pragma("unroll") for (int mt = 0; mt < 4; ++mt) _Pragma("unroll") for (int q = 0; q < 4; ++q) { const int kk = 16 * mt + 4 * fq + q; \
                sc[mt][nt][q] = (on && kk <= tt[nt]) ? sc[mt][nt][q] : -INFINITY; } } \
        at_online<false>(sc, m, lsum, oc, onn); at_pv_t<3>(oc, sc, vf, slot, fr, fq); } while (0)
    AT_RESET();
    if (tb > 0) AT_LOOP(tb, ks0, vs0, 4096, 4096, SEL_BODY);
    AT_LOOP(1, ks0 + (size_t)tb * 4096, vs0 + (size_t)tb * 4096, 0, 0, SELD_BODY);
    AT_ACCUM(1);
    TSEC(3);
    const bf16* KW = WSP(bf16, NSA_KW) + (size_t)bg * SEQ * 64; const bf16* VWT_ = WSP(bf16, NSA_VWT) + (size_t)bg * 128 * 4096;
    const int jw0 = tb >= 8 ? tb - 8 : 0, nwb = tb - jw0 + 1;
    const bf16* kw0 = KW + ((size_t)jw0 * 64 + pr_) * 64 + pc_; const bf16* vw0 = VWT_ + (size_t)jw0 * 4096 + (size_t)pr_ * 64 + pc_;
#define WIN_BODY(i) do { const int j = jw0 + (i); at_qk(sc, slot, Qb, fr, fq); at_vfrag(vf, slot, fr, fq); \
        if (j == tb || j == tb - 8) { \
        _Pragma("unroll") for (int nt = 0; nt < 2; ++nt) _Pragma("unroll") for (int mt = 0; mt < 4; ++mt) _Pragma("unroll") for (int q = 0; q < 4; ++q) { const int kk = 16 * mt + 4 * fq + q; \
            const bool ok = (j < tb || kk <= tt[nt]) && (j > tb - 8 || kk > tt[nt]); sc[mt][nt][q] = ok ? sc[mt][nt][q] : -INFINITY; } } \
        at_online<false>(sc, m, lsum, oc, onn); at_pv_t<3>(oc, sc, vf, slot, fr, fq); } while (0)
    AT_RESET();
    AT_LOOP(nwb, kw0, vw0, 4096, 4096, WIN_BODY);
    AT_ACCUM(2);
    bf16* OB = WSP(bf16, WS_OAB) + (size_t)MT * 512;
#pragma unroll
    for (int nt = 0; nt < 2; ++nt)
#pragma unroll
        for (int dt = 0; dt < 4; ++dt) { v2u w; w.x = pk2(outa[dt][nt][0], outa[dt][nt][1]); w.y = pk2(outa[dt][nt][2], outa[dt][nt][3]); *(GAS v2u*)(OB + row[nt] * 512 + (4 * g + head) * 64 + 16 * dt + 4 * fq) = w; }
    AT_SYNC();
    TSEC(4);
#undef TSEC
#undef AT_RESET
#undef AT_ACCUM
#undef CMP_MASK
#undef CMP_BODY1
#undef CMP_BODY2
#undef SEL_BODY
#undef SELD_BODY
#undef WIN_BODY
}

__device__ __forceinline__ void nsa_sample_softmax(LAS float* sc, int nkeys, int pitch, LAS float* red, int tid, int lane, int wave) {
    if (wave < 4) { LAS float* s = sc + wave * pitch; float mx = -INFINITY;
        for (int i = lane; i < nkeys; i += 64) mx = fmaxf(mx, s[i]);
        mx = wave_max(mx); const float ms = mx == -INFINITY ? 0.f : mx; float sum = 0.f;
        for (int i = lane; i < nkeys; i += 64) { const float e = __expf(s[i] - ms); s[i] = e; sum += e; }
        sum = wave_sum(sum); const float inv = sum > 0.f ? 1.f / fmaxf(sum, 1e-30f) : 0.f;
        for (int i = lane; i < nkeys; i += 64) s[i] *= inv; }
    (void)red; (void)tid;
}
__device__ __forceinline__ float dot64(const float* kr, const LAS float* q) {
    float acc = 0.f;
#pragma unroll
    for (int c = 0; c < 16; ++c) { const f32x4 k = *(const GAS f32x4*)(kr + 4 * c); const f32x4 qq = *(const LAS f32x4*)(q + 4 * c); acc += (k.x * qq.x + k.y * qq.y) + (k.z * qq.z + k.w * qq.w); }
    return acc;
}
#define SMP_PV(nkeys, VROW, gate_idx) do { \
        const int ks_ = tid >> 6, per_ = ((nkeys) + 7) >> 3, k0_ = ks_ * per_, k1_ = (k0_ + per_) < (nkeys) ? (k0_ + per_) : (nkeys); \
        float a0_ = 0.f, a1_ = 0.f, a2_ = 0.f, a3_ = 0.f; \
        _Pragma("unroll 8") for (int k = k0_; k < k1_; ++k) { const float v_ = (VROW(k))[d_]; a0_ += sc[k] * v_; a1_ += sc[SP + k] * v_; a2_ += sc[2 * SP + k] * v_; a3_ += sc[3 * SP + k] * v_; } \
        red[(ks_ * 4 + 0) * 64 + d_] = a0_; red[(ks_ * 4 + 1) * 64 + d_] = a1_; red[(ks_ * 4 + 2) * 64 + d_] = a2_; red[(ks_ * 4 + 3) * 64 + d_] = a3_; \
        __syncthreads(); \
        if (tid < 256) { float s_ = 0.f; _Pragma("unroll") for (int q = 0; q < 8; ++q) s_ += red[(q * 4 + r_) * 64 + d_]; oacc += sigmoidf_(SC[row * 32 + 8 + (4 * g + r_) * 3 + (gate_idx)]) * s_; } \
        __syncthreads(); } while (0)
__device__ __forceinline__ void nsa_attn_sample(Frame& F, const Args& a, int l, int unit) {
    constexpr int SP = 1152;
    LAS float* qs = (LAS float*)(F.lds + RING_OFF);
    LAS float* sc = qs + 256;
    LAS float* impv = sc + 4 * SP;
    LAS float* red = impv + 192;
    LAS int* list = (LAS int*)(red + 2048);
    LAS int* flag = list + 16;
    LAS int* rbase = flag + 192;
    const int tid = F.tid, lane = F.lane, wave = F.wave, bs = unit >> 1, g = unit & 1; const size_t row = MP + bs;
    const bf16* P = WSP(bf16, WS_P); const float* SC = WSP(float, WS_SC); const int* pt = INP(int, I_PT) + bs * NPAGES;
    if (tid < 256) qs[tid] = 0.125f * bf2f(P[row * NINP + PC_QB + (4 * g + (tid >> 6)) * 64 + (tid & 63)]);
    float oacc = 0.f;
    const int r_ = (tid >> 6) & 3, d_ = tid & 63;
    __syncthreads();
    const float* KCS = WSP(float, SMP_KCS) + (size_t)unit * 512 * 64; const float* VCS = WSP(float, SMP_VCS) + (size_t)unit * 512 * 64;
    if (tid < NCMP) { const float* kr = KCS + (size_t)tid * 64;
#pragma unroll
        for (int r = 0; r < 4; ++r) sc[r * SP + tid] = dot64(kr, qs + r * 64); }
    __syncthreads();
    nsa_sample_softmax(sc, NCMP, SP, red, tid, lane, wave);
    __syncthreads();
    if (tid < 129) { float v = 0.f;
        if (tid < 128) { for (int r = 0; r < 4; ++r) { const LAS float* p = sc + r * SP; for (int q = -1; q < 4; ++q) { const int n = 4 * tid + q; if (n >= 0 && n < NCMP) v += p[n]; } } }
        impv[tid] = (tid == 0 || tid == 128) ? 1e9f : v; }
#define VROW_CMP(k) (VCS + (size_t)(k) * 64)
    SMP_PV(NCMP, VROW_CMP, 0);
    if (tid < 129) { const float v = impv[tid]; int c = 0; for (int i = 0; i < 129; ++i) { const float x = impv[i]; c += (x > v || (x == v && i < tid)) ? 1 : 0; } flag[tid] = c < NSEL ? 1 : 0; }
    __syncthreads();
    if (tid == 0) { int n = 0; for (int j = 0; j < 129; ++j) if (flag[j] && n < NSEL) list[n++] = j; for (; n < NSEL; ++n) list[n] = -1; }
    __syncthreads();
    if (tid < 16) { const int jb = list[tid]; rbase[tid] = (jb >= 0 && jb < 128) ? pt[jb >> 1] * PAGE + (jb & 1) * 64 : -1; }
    __syncthreads();
    const float* CS = INP(float, I_CSLC) + (size_t)l * NPOOL * PAGE * KVW; const float* newslc = a.out + O_SLC_S + (size_t)(l * MS + bs) * KVW;
    for (int pr = tid; pr < 1024; pr += NTHR) { const int jb = list[pr >> 6], kk = pr & 63, rb = rbase[pr >> 6]; const float* kr = nullptr;
        if (rb >= 0) kr = CS + (size_t)(rb + kk) * KVW + g * 64; else if (jb == 128 && kk == 0) kr = newslc + g * 64;
#pragma unroll
        for (int r = 0; r < 4; ++r) sc[r * SP + pr] = kr ? dot64(kr, qs + r * 64) : -INFINITY; }
    __syncthreads();
    nsa_sample_softmax(sc, 1024, SP, red, tid, lane, wave);
    __syncthreads();
#define VROW_SEL(k) (rbase[(k) >> 6] >= 0 ? CS + (size_t)(rbase[(k) >> 6] + ((k) & 63)) * KVW + 128 + g * 64 : newslc + 128 + g * 64)
    SMP_PV(1024, VROW_SEL, 1);
    const float* WB = INP(float, I_SWIN) + ((size_t)(l * MS + bs) * WINDOW) * KVW; const float* newwin = a.out + O_WIN_S + ((size_t)(l * MS + bs) * WINDOW + (WINDOW - 1)) * KVW;
    { const float* kr = tid < 511 ? WB + (size_t)(tid + 1) * KVW + g * 64 : newwin + g * 64;
#pragma unroll
      for (int r = 0; r < 4; ++r) sc[r * SP + tid] = dot64(kr, qs + r * 64); }
    __syncthreads();
    nsa_sample_softmax(sc, 512, SP, red, tid, lane, wave);
    __syncthreads();
#define VROW_WIN(k) ((k) < 511 ? WB + (size_t)((k) + 1) * KVW + 128 + g * 64 : newwin + 128 + g * 64)
    SMP_PV(512, VROW_WIN, 2);
    if (tid < 256) (WSP(bf16, WS_OAB) + (size_t)MT * 512)[row * 512 + (4 * g + r_) * 64 + d_] = (bf16)f2bf(oacc);
    __syncthreads();
#undef VROW_CMP
#undef VROW_SEL
#undef VROW_WIN
}
#if defined(MK_CHECK) && MK_CHECK
constexpr int CW_CHK = 3072;
__device__ __forceinline__ void chk_report(Frame& F, float e) { if (e == e) atomicMax((unsigned*)(F.ctl + CW_CHK), __builtin_bit_cast(unsigned, e)); else atomicMax((unsigned*)(F.ctl + CW_CHK), 0x7f000000u); }
__device__ __forceinline__ void chk_cmp(Frame& F, const Args& a, int l, int smp, int bg, int kv, int n) {
    LAS float* hid = (LAS float*)(F.lds + RING_OFF); LAS float* red = hid + 256;
    const int tid = F.tid; const float* w1 = INP(float, I_CW1) + (size_t)(l * 2 + kv) * 2048 * 256; const float* pe = INP(float, I_CPOS) + (size_t)(l * 2 + kv) * 2048;
    const int g = bg & 1, bb = bg >> 1;
    if (tid < 256) { float acc = 0.f;
        for (int i = 0; i < 2048; ++i) { const int rr = 16 * n + (i >> 6), d = i & 63; float x;
            if (smp) { const int page = INP(int, I_PT)[bb * NPAGES + (rr >> 7)]; x = INP(float, I_CCMP)[(((size_t)l * NPOOL + page) * PAGE + (rr & 127)) * KVW + kv * 128 + g * 64 + d]; }
            else x = bf2f(WSP(bf16, WS_P)[((size_t)bb * SEQ + rr) * NINP + PC_KVC + kv * 128 + g * 64 + d]);
            acc += (x + pe[i]) * w1[(size_t)i * 256 + tid]; }
        hid[tid] = siluf_(acc); }
    __syncthreads();
    if (tid < 64) { float o = 0.f; const float* w2 = INP(float, I_CW2) + (size_t)(l * 2 + kv) * 256 * 64;
        for (int c = 0; c < 256; ++c) o += hid[c] * w2[c * 64 + tid];
        float f;
        if (smp) f = WSP(float, kv ? SMP_VCS : SMP_KCS)[((size_t)bg * 512 + n) * 64 + tid];
        else if (kv == 0) f = bf2f(WSP(bf16, NSA_KC)[((size_t)bg * 512 + n) * 64 + tid]);
        else f = bf2f(WSP(bf16, NSA_VCT)[((size_t)bg * 64 + tid) * 512 + kperm(n)]);
        red[tid] = fabsf(f - o); red[64 + tid] = fabsf(o); }
    __syncthreads();
    if (tid == 0) { float e = 0.f, m = 0.f; for (int i = 0; i < 64; ++i) { e = fmaxf(e, red[i]); m = fmaxf(m, red[64 + i]); } chk_report(F, e / (m + 1e-20f)); }
    __syncthreads();
}
__device__ __forceinline__ void chk_attn(Frame& F, const Args& a, int b, int t, int g) {
    LAS float* qs = (LAS float*)(F.lds + RING_OFF);
    LAS float* sc = qs + 256;
    LAS float* imp = sc + 4096;
    LAS float* ob = imp + 128;
    LAS int* sel = (LAS int*)(ob + 768);
    LAS float* red = (LAS float*)(sel + 16);
    const int tid = F.tid, bg = b * 2 + g; const size_t row = (size_t)b * SEQ + t;
    const bf16* P = WSP(bf16, WS_P); const float* SC = WSP(float, WS_SC);
    if (tid < 256) qs[tid] = 0.125f * bf2f(P[row * NINP + PC_QB + (4 * g + (tid >> 6)) * 64 + (tid & 63)]);
    __syncthreads();
    const int r_ = (tid >> 6) & 3, d_ = tid & 63;
    int ncmp = 0; for (int n = 0; n < NCMP; ++n) if (n * 16 + 31 <= t) ncmp = n + 1;
    for (int idx = tid; idx < 4 * 512; idx += NTHR) { const int r = idx >> 9, n = idx & 511; float s = -INFINITY;
        if (n < ncmp) { s = 0.f; for (int d = 0; d < 64; ++d) s += qs[r * 64 + d] * bf2f(WSP(bf16, NSA_KC)[((size_t)bg * 512 + n) * 64 + d]); }
        sc[r * 1024 + n] = s; }
    __syncthreads();
    if (tid < 4) { LAS float* s = sc + tid * 1024; float mx = -INFINITY; for (int n = 0; n < ncmp; ++n) mx = fmaxf(mx, s[n]); float sum = 0.f;
        for (int n = 0; n < 512; ++n) { const float e = n < ncmp ? __expf(s[n] - mx) : 0.f; s[n] = e; sum += e; } const float inv = 1.f / fmaxf(sum, 1e-30f); for (int n = 0; n < 512; ++n) s[n] *= inv; }
    __syncthreads();
    if (tid < 128) { float v = 0.f; const int sj = tid * 64;
        for (int n = 0; n < NCMP; ++n) { const int ci = n * 16; if (ci < sj + 64 && ci + 32 > sj) v += sc[n] + sc[1024 + n] + sc[2048 + n] + sc[3072 + n]; }
        const bool forced = (tid == t / 64) || (tid == 0), valid = tid * 64 <= t; imp[tid] = forced ? 1e9f : (valid ? v : -1.f); }
    if (tid < 256) { float o = 0.f; for (int n = 0; n < ncmp; ++n) o += sc[r_ * 1024 + n] * bf2f(WSP(bf16, NSA_VCT)[((size_t)bg * 64 + d_) * 512 + kperm(n)]); ob[tid] = o; }
    __syncthreads();
    if (tid == 0) { for (int k = 0; k < 16; ++k) { int best = -1; float bv = -3e38f; for (int j = 0; j < 128; ++j) { bool used = false; for (int q = 0; q < k; ++q) used |= (sel[q] == j); if (!used && imp[j] > bv) { bv = imp[j]; best = j; } } sel[k] = best; } }
    __syncthreads();
    for (int idx = tid; idx < 4 * 1024; idx += NTHR) { const int r = idx >> 10, pr = idx & 1023, kpos = sel[pr >> 6] * 64 + (pr & 63); float s = -INFINITY;
        if (kpos <= t) { s = 0.f; for (int d = 0; d < 64; ++d) s += qs[r * 64 + d] * bf2f(P[((size_t)b * SEQ + kpos) * NINP + PC_KVS + g * 64 + d]); }
        sc[r * 1024 + pr] = s; }
    __syncthreads();
    if (tid < 4) { LAS float* s = sc + tid * 1024; float mx = -INFINITY; for (int n = 0; n < 1024; ++n) mx = fmaxf(mx, s[n]); float sum = 0.f;
        for (int n = 0; n < 1024; ++n) { const float e = s[n] == -INFINITY ? 0.f : __expf(s[n] - mx); s[n] = e; sum += e; } const float inv = 1.f / fmaxf(sum, 1e-30f); for (int n = 0; n < 1024; ++n) s[n] *= inv; }
    __syncthreads();
    if (tid < 256) { float o = 0.f; for (int pr = 0; pr < 1024; ++pr) { const int kpos = sel[pr >> 6] * 64 + (pr & 63); if (kpos <= t) o += sc[r_ * 1024 + pr] * bf2f(P[((size_t)b * SEQ + kpos) * NINP + PC_KVS + 128 + g * 64 + d_]); } ob[256 + tid] = o; }
    __syncthreads();
    for (int idx = tid; idx < 4 * 512; idx += NTHR) { const int r = idx >> 9, w = idx & 511, kpos = t - 511 + w; float s = -INFINITY;
        if (kpos >= 0) { s = 0.f; for (int d = 0; d < 64; ++d) s += qs[r * 64 + d] * bf2f(P[((size_t)b * SEQ + kpos) * NINP + PC_KVW + g * 64 + d]); }
        sc[r * 1024 + w] = s; }
    __syncthreads();
    if (tid < 4) { LAS float* s = sc + tid * 1024; float mx = -INFINITY; for (int n = 0; n < 512; ++n) mx = fmaxf(mx, s[n]); float sum = 0.f;
        for (int n = 0; n < 512; ++n) { const float e = s[n] == -INFINITY ? 0.f : __expf(s[n] - mx); s[n] = e; sum += e; } const float inv = 1.f / fmaxf(sum, 1e-30f); for (int n = 0; n < 512; ++n) s[n] *= inv; }
    __syncthreads();
    if (tid < 256) { float o = 0.f; for (int w = 0; w < 512; ++w) { const int kpos = t - 511 + w; if (kpos >= 0) o += sc[r_ * 1024 + w] * bf2f(P[((size_t)b * SEQ + kpos) * NINP + PC_KVW + 128 + g * 64 + d_]); } ob[512 + tid] = o; }
    __syncthreads();
    if (tid < 256) { const float* gp = SC + row * 32 + 8 + (4 * g + r_) * 3; const float ref = sigmoidf_(gp[0]) * ob[tid] + sigmoidf_(gp[1]) * ob[256 + tid] + sigmoidf_(gp[2]) * ob[512 + tid];
        const float fast = bf2f((WSP(bf16, WS_OAB) + (size_t)MT * 512)[row * 512 + (4 * g + r_) * 64 + d_]); red[tid] = fabsf(fast - ref); red[256 + tid] = fabsf(ref); }
    __syncthreads();
    if (tid == 0) { float e = 0.f, m = 0.f; for (int i = 0; i < 256; ++i) { e = fmaxf(e, red[i]); m = fmaxf(m, red[256 + i]); } chk_report(F, e / (m + 1e-20f)); }
    __syncthreads();
}
__device__ __forceinline__ void chk_gdn(Frame& F, const Args& a, int b, int h, int T) {
    LAS float* S = (LAS float*)(F.lds + RING_OFF);
    LAS float* qkv = S + 16384;
    LAS float* kS = qkv + 384;
    LAS float* sc2 = kS + 128;
    LAS float* red = sc2 + 4;
    const int tid = F.tid; const bf16* P = WSP(bf16, WS_P); const float* SC = WSP(float, WS_SC);
    const float* cw = INP(float, I_CONVW) + (size_t)1 * 4 * 1536;
    for (int i = tid; i < 16384; i += NTHR) S[i] = 0.f;
    __syncthreads();
    for (int t = 0; t <= T; ++t) {
        const size_t row = (size_t)b * SEQ + t;
        if (tid < 384) { const int c = (tid >> 7) * 512 + h * 128 + (tid & 127); float y = 0.f;
            for (int j = 0; j < 4; ++j) { const int tt = t + j - 3; if (tt >= 0) y += cw[j * 1536 + c] * bf2f(P[((size_t)b * SEQ + tt) * NINP + PC_QKV + c]); }
            qkv[tid] = siluf_(y); }
        __syncthreads();
        if (tid < 2) { float ss = 0.f; for (int i = 0; i < 128; ++i) ss += qkv[tid * 128 + i] * qkv[tid * 128 + i]; sc2[tid] = 1.f / sqrtf(ss + 1e-6f); }
        if (tid == 2) { sc2[2] = sigmoidf_(SC[row * 32 + h]); const float g = -__expf(INP(float, I_ALOG)[4 + h]) * softplusf_(SC[row * 32 + 4 + h] + INP(float, I_DTB)[4 + h]); sc2[3] = __expf(g); }
        __syncthreads();
        if (tid < 128) { const float rk = sc2[1]; float s = 0.f; for (int k = 0; k < 128; ++k) s += qkv[128 + k] * rk * S[k * 128 + tid]; kS[tid] = s; }
        __syncthreads();
        { const float rk = sc2[1], beta = sc2[2], eg = sc2[3];
          for (int i = tid; i < 16384; i += NTHR) { const int k = i >> 7, v = i & 127; const float kk = qkv[128 + k] * rk; S[i] = eg * (S[i] - beta * kk * kS[v]) + beta * kk * qkv[256 + v]; } }
        __syncthreads();
    }
    if (tid < 128) { const float rq = sc2[0] * 0.08838834764831845f; float o = 0.f; for (int k = 0; k < 128; ++k) o += qkv[k] * rq * S[k * 128 + tid]; kS[tid] = o; }
    __syncthreads();
    if (tid == 0) { float ss = 0.f; for (int i = 0; i < 128; ++i) ss += kS[i] * kS[i]; sc2[0] = 1.f / sqrtf(ss * (1.f / 128.f) + LN_EPS); }
    __syncthreads();
    if (tid < 128) { const size_t row = (size_t)b * SEQ + T; const float ref = kS[tid] * sc2[0] * INP(float, I_NORMW)[128 + tid] * siluf_(bf2f(P[row * NINP + PC_Z + h * 128 + tid]));
        const float fast = bf2f(WSP(bf16, WS_OAB)[row * 512 + h * 128 + tid]); red[tid] = fabsf(fast - ref); red[128 + tid] = fabsf(ref); }
    __syncthreads();
    if (tid == 0) { float e = 0.f, m = 0.f; for (int i = 0; i < 128; ++i) { e = fmaxf(e, red[i]); m = fmaxf(m, red[128 + i]); } chk_report(F, e / (m + 1e-20f)); }
    __syncthreads();
}
__device__ __forceinline__ void chk_moe(Frame& F, const Args& a, int row) {
    LAS float* hh = (LAS float*)(F.lds + RING_OFF);
    LAS float* act = hh + 1024;
    LAS float* ref = act + 2816;
    LAS float* red = ref + 1024;
    const int tid = F.tid; const bf16* XN = WSP(bf16, WS_XN); const int* ep = WSP(int, MOE_EPOS) + 4 * row; const float* mprob = WSP(float, MOE_PROB); const int* mslot = WSP(int, MOE_SLOT);
    for (int i = tid; i < 1024; i += NTHR) { hh[i] = bf2f(XN[(size_t)row * D + i]); ref[i] = 0.f; }
    __syncthreads();
    for (int s = 0; s < 2; ++s) { const int e = ep[s]; const float p = mprob[2 * row + s];
        const float* wgu = INP(float, I_MGU) + (size_t)e * D * 2 * DFF; const float* wdn = INP(float, I_MDN) + (size_t)e * DFF * D;
        for (int f = tid; f < DFF; f += NTHR) { float g = 0.f, u = 0.f; for (int k = 0; k < D; ++k) { g += hh[k] * wgu[(size_t)k * 2 * DFF + f]; u += hh[k] * wgu[(size_t)k * 2 * DFF + DFF + f]; } act[f] = bf2f((unsigned short)f2bf(siluf_(g) * u)); }
        __syncthreads();
        for (int c = tid; c < D; c += NTHR) { float o = 0.f; for (int f = 0; f < DFF; ++f) o += act[f] * wdn[(size_t)f * D + c]; ref[c] += p * o; }
        __syncthreads(); }
    const bf16* Y = WSP(bf16, WS_Y); const int s0 = mslot[2 * row], s1 = mslot[2 * row + 1]; const float p0 = mprob[2 * row], p1 = mprob[2 * row + 1];
    for (int c = tid; c < D; c += NTHR) { const float fast = p0 * bf2f(Y[(size_t)s0 * D + c]) + p1 * bf2f(Y[(size_t)s1 * D + c]); red[c] = fabsf(fast - ref[c]); }
    __syncthreads();
    if (tid == 0) { float e = 0.f, m = 0.f; for (int i = 0; i < D; ++i) { e = fmaxf(e, red[i]); m = fmaxf(m, fabsf(ref[i])); } chk_report(F, e / (m + 1e-20f)); }
    __syncthreads();
}
__device__ __forceinline__ void chk_phase(Frame& F, const Args& a) {
#if MK_CHECK == 3
    { const int rows[16] = {0, 1, 777, 4095, 4096, 8191, 8192, 9000, 12345, 16000, 16383, MP, MP + 1, MP + 7, MP + 30, MP + 31}; if (F.bid < 16) chk_moe(F, a, rows[F.bid]); return; }
#endif
#if MK_CHECK == 2
    { const int Ts[4] = {5, 70, 200, 333}; if (F.bid < 32) chk_gdn(F, a, F.bid & 1, (F.bid >> 1) & 3, F.bid < 8 ? Ts[0] : F.bid < 16 ? Ts[1] : F.bid < 24 ? Ts[2] : Ts[3]); return; }
#endif
    const int ts[8] = {5, 40, 100, 777, 3000, 5001, 8000, 8191};
    if (F.bid < 32) { const int k = F.bid; chk_attn(F, a, (k >> 1) & 1, k < 4 ? ts[0] : k < 8 ? ts[1] : k < 12 ? ts[2] : k < 16 ? ts[3] : k < 20 ? ts[4] : k < 24 ? ts[5] : k < 28 ? ts[6] : ts[7], k & 1); }
    else if (F.bid < 48) { const int k = F.bid - 32; chk_cmp(F, a, 1, 0, k & 3, (k >> 2) & 1, k < 8 ? 0 : 509 + (k & 1)); }
    else if (F.bid < 64) { const int k = F.bid - 48; chk_cmp(F, a, 1, 1, (k & 3) * 17 + 3, (k >> 2) & 1, k < 8 ? 7 : 510); }
}
__device__ __forceinline__ void chk_apply(Frame& F, const Args& a) {
    const float E = __builtin_bit_cast(float, __hip_atomic_load(F.ctl + CW_CHK, RLX_AGENT));
    for (int i = F.bid * NTHR + F.tid; i < 2 * 32 * 256; i += F.G * NTHR) a.out[O_CMP_S + i] *= (1.f + E);
}
#endif
constexpr int DEFER_WGS = 64;
constexpr int CW_Q = 3328;
__device__ __forceinline__ int q_pull(Frame& F, gu32* ctr) {
    if (F.tid == 0) F.MISC[16] = __hip_atomic_fetch_add(ctr, 1u, __ATOMIC_RELAXED, __HIP_MEMORY_SCOPE_AGENT);
    __syncthreads(); const int v = (int)F.MISC[16]; __syncthreads(); return v;
}
__device__ __forceinline__ void fresh(Frame& F) { F.lane = my_lane(); F.tid = F.wave * 64 + F.lane; }
#ifndef MK_FUSED
#define MK_FUSED 1
#endif
__global__ void __launch_bounds__(NTHR, 2) mega(Args a) {
    extern __shared__ __attribute__((aligned(16))) unsigned char lds_raw[];
    Frame F;
    F.lds = (LAS unsigned char*)lds_raw;
    F.MISC = (volatile LAS unsigned*)(F.lds + MISC_OFF);
    F.wave = __builtin_amdgcn_readfirstlane((int)threadIdx.x >> 6); F.lane = my_lane(); F.tid = F.wave * 64 + F.lane;
    F.G = gridDim.x; F.bid = blockIdx.x;
    F.ctl = (gu32*)(a.ws + WS_CTL);
    for (int u = F.tid; u < (LDS_BYTES - LDSCTL_OFF) / 4; u += NTHR) ((LAS unsigned*)(F.lds + LDSCTL_OFF))[u] = 0u;
    __syncthreads();
    XcdBarrier bar; bar.bar = (unsigned*)(F.ctl + CW_BAR); bar.x = 0; bar.st = nullptr;
    if (MK_FUSED) bar = xcd_barrier_post((unsigned*)(F.ctl + CW_BAR), F.MISC + 8);
    const int lo = a.ph_lo, hi = a.ph_hi;
#define IN(k) (fresh(F), lo <= (k) && (k) < hi)
#if defined(MK_TIME)
#define TSTAMP(k) do { if (F.bid == 0 && F.tid == 0) { const unsigned long long t_ = __builtin_amdgcn_s_memrealtime(); F.ctl[3200 + 2 * (k)] = (unsigned)t_; F.ctl[3201 + 2 * (k)] = (unsigned)(t_ >> 32); } } while (0)
#else
#define TSTAMP(k) do { } while (0)
#endif
#define SEAM(k) do { if (MK_FUSED && IN(k) && IN((k) + 1)) xcd_barrier(bar); TSTAMP((k) + 1); } while (0)
    TSTAMP(0);

    if (IN(PH_PRO)) { p0_prologue(F, a); }
    SEAM(PH_PRO);
#pragma unroll
    for (int l = 0; l < 2; ++l) {
        const int pb = 1 + l * NPL;
        if (IN(pb + LP_LNMOD)) { if (l == 0) p_lnmod0(F, a); }
        if (l == 0) SEAM(pb + LP_LNMOD); else TSTAMP(pb + LP_LNMOD + 1);
        if (IN(pb + LP_INPROJ)) {
            pg8::Gemm g{WSP(bf16, WS_XN), WSP(bf16, WS_WIN_T) + (size_t)l * NINP * D, MT, NINP, D}; pg8::StaticOrder S; S.init(MT, NINP, F.G, F.bid);
            EpiIn E{WSP(bf16, WS_P), WSP(float, WS_SC), a.out, l};
            pg8::gemm_phase<EpiIn, pg8::StaticOrder, true, true>(F.lds + RING_OFF, g, S, E, F.tid);
        }
        SEAM(pb + LP_INPROJ);
        if (IN(pb + LP_PREP)) { gdn_prep(F, a, l); TSTAMP(56 + l); nsa_prep(F, a, l); }
        SEAM(pb + LP_PREP);
        if (IN(pb + LP_CMP1)) {
            pg8::Gemm g{WSP(bf16, SMP_SEG) + (size_t)l * 2 * SEGROWS * 1024, WSP(bf16, WS_CW1_T) + (size_t)l * 1024 * 1024, 2 * SEGROWS, 512, 1024}; CmpOrder S{F.G, F.bid};
            EpiBf16P E{WSP(bf16, SMP_HP), 512};
            pg8::gemm_phase<EpiBf16P, CmpOrder, true, true>(F.lds + RING_OFF, g, S, E, F.tid);
        }
        SEAM(pb + LP_CMP1);
        if (IN(pb + LP_CMP2)) { nsa_cmp2(F, a, l); }
        SEAM(pb + LP_CMP2);
        if (IN(pb + LP_MIX)) {
            if (l == 0 && F.bid >= 32 && F.bid < 32 + DEFER_WGS) { for (;;) { const int dch = q_pull(F, F.ctl + CW_Q + 64 * 6); if (dch >= DEFER_CHUNKS) break; defer_chunk(F, a, dch); } fresh(F); }
            if (F.bid < 32) gdn_scan(F, a, l, (F.bid & 7) * 4 + (F.bid >> 3));
            TSTAMP(40 + 4 * l); fresh(F);
            for (;;) { const int it = q_pull(F, F.ctl + CW_Q + 64 * (3 * l + 0)); if (it >= 128) break; gdn_sample(F, a, l, it); }
            TSTAMP(41 + 4 * l); fresh(F);
            for (;;) { const int it = q_pull(F, F.ctl + CW_Q + 64 * (3 * l + 1)); if (it >= 64) break; nsa_attn_sample(F, a, l, it); }
            TSTAMP(42 + 4 * l); fresh(F);
            for (;;) { fresh(F); const int L = q_pull(F, F.ctl + CW_Q + 64 * (3 * l + 2)); if (L >= 512) break; nsa_attn_tile(F, a, l, (L >> 1) & 1, L & 1, 127 - (L >> 2)); }
            TSTAMP(43 + 4 * l);
            if (l == 0) { fresh(F); for (;;) { const int dch = q_pull(F, F.ctl + CW_Q + 64 * 6); if (dch >= DEFER_CHUNKS) break; defer_chunk(F, a, dch); } }
#if defined(MK_TSEC)
            if (l == 0 && F.bid == 0 && F.tid == 0) { F.ctl[3200 + 2 * 50] = 0; F.ctl[3201 + 2 * 50] = 0; F.ctl[3200 + 2 * 51] = F.MISC[20]; F.ctl[3201 + 2 * 51] = 0; }
#endif
        }
        SEAM(pb + LP_MIX);
        if (IN(pb + LP_ONORM)) { gdn_onorm(F, a, l); }
        SEAM(pb + LP_ONORM);
        if (IN(pb + LP_UP)) {
            if (F.bid < 64) gemm_rows32<1>(F, a, F.bid, WSP(bf16, WS_OAB) + (size_t)MP * 512, 512, WSP(bf16, WS_WUP_T) + (size_t)l * 2048 * 512, 512,
                                            WSP(bf16, WS_OAB) + (size_t)(MT + MP) * 512, WSP(bf16, WS_WUP_T) + (size_t)l * 2048 * 512 + (size_t)1024 * 512, nullptr, WSP(bf16, WS_U));
            pg8::Gemm g{WSP(bf16, WS_OAB), WSP(bf16, WS_WUP_T) + (size_t)l * 2048 * 512, MT, 1024, 512}; ChainOrder S{F.G, F.bid};
            EpiUp E{WSP(bf16, WS_P), WSP(bf16, WS_U)};
            pg8::gemm_phase<EpiUp, ChainOrder, true, true>(F.lds + RING_OFF, g, S, E, F.tid);
        }
        SEAM(pb + LP_UP);
        if (IN(pb + LP_OUT)) {
            if (F.bid < 64) gemm_rows32<0>(F, a, F.bid, WSP(bf16, WS_U) + (size_t)MP * D, D, WSP(bf16, WS_WOUT_T) + (size_t)l * D * D, D, nullptr, nullptr, WSP(bf16, WS_Y), nullptr);
            pg8::Gemm g{WSP(bf16, WS_U), WSP(bf16, WS_WOUT_T) + (size_t)l * D * D, MP, D, D}; pg8::StaticOrder S; S.init(MP, D, F.G, F.bid);
            EpiY E{WSP(bf16, WS_Y)};
            pg8::gemm_phase<EpiY, pg8::StaticOrder, true, true>(F.lds + RING_OFF, g, S, E, F.tid);
        }
        SEAM(pb + LP_OUT);
        if (IN(pb + LP_LN1)) {
            if (l == 0) p_lnpass<1, false>(F, a, 0, 0, nullptr, WSP(float, WS_XA), WSP(bf16, WS_Y));
            else        p_lnpass<1, true>(F, a, 1, 0, WSP(float, WS_XB), WSP(float, WS_XA), WSP(bf16, WS_Y));
        }
        SEAM(pb + LP_LN1);
        if (IN(pb + LP_MOEG)) { if (l == 1) p_moe_gather(F, a); }
        if (l == 1) SEAM(pb + LP_MOEG); else TSTAMP(pb + LP_MOEG + 1);
        if (IN(pb + LP_FFN1)) {
            EpiSwiglu E{WSP(bf16, WS_ACT)};
            if (l == 0) { pg8::Gemm g{WSP(bf16, WS_XN), WSP(bf16, WS_WGU_T), MT, 2 * DFF, D}; pg8::StaticOrder S; S.init(MT, 2 * DFF, F.G, F.bid);
                pg8::gemm_phase<EpiSwiglu, pg8::StaticOrder, true, true>(F.lds + RING_OFF, g, S, E, F.tid); }
            else { pg8::Gemm g{WSP(bf16, WS_APERM), WSP(bf16, WS_MGU_T), MT, 2 * DFF, D}; MoeOrder<22> S{F.G, F.bid, WSP(int, MOE_META)};
                pg8::gemm_phase<EpiSwiglu, MoeOrder<22>, true, true>(F.lds + RING_OFF, g, S, E, F.tid); }
        }
        SEAM(pb + LP_FFN1);
        if (IN(pb + LP_FFN2)) {
            EpiY E{WSP(bf16, WS_Y)};
            if (l == 0) { if (F.bid < 64) gemm_rows32<0>(F, a, F.bid, WSP(bf16, WS_ACT) + (size_t)MP * DFF, DFF, WSP(bf16, WS_WDN_T), DFF, nullptr, nullptr, WSP(bf16, WS_Y), nullptr);
                pg8::Gemm g{WSP(bf16, WS_ACT), WSP(bf16, WS_WDN_T), MP, D, DFF}; pg8::StaticOrder S; S.init(MP, D, F.G, F.bid);
                pg8::gemm_phase<EpiY, pg8::StaticOrder, true, true>(F.lds + RING_OFF, g, S, E, F.tid); }
            else { pg8::Gemm g{WSP(bf16, WS_ACT), WSP(bf16, WS_MDN_T), MT, D, DFF}; MoeOrder<4> S{F.G, F.bid, WSP(int, MOE_META)};
                pg8::gemm_phase<EpiY, MoeOrder<4>, true, true>(F.lds + RING_OFF, g, S, E, F.tid); }
        }
        SEAM(pb + LP_FFN2);
        if (IN(pb + LP_LN2)) {
            if (l == 0) p_lnpass<1, false>(F, a, 0, 1, WSP(float, WS_XA), WSP(float, WS_XB), WSP(bf16, WS_Y));
            else        p_lnpass<2, false>(F, a, 1, 1, WSP(float, WS_XA), nullptr, WSP(bf16, WS_Y));
        }
        SEAM(pb + LP_LN2);
    }
#if defined(MK_TIME)
    if (F.bid == 0) { __syncthreads();
        auto st = [&](int k) { return (double)(((unsigned long long)F.ctl[3201 + 2 * k] << 32) | F.ctl[3200 + 2 * k]); };
        const double tot = st(NPH) - st(0); const int A0 = (MK_TIME) & 63, A1 = ((MK_TIME) >> 6) & 63, B0 = ((MK_TIME) >> 12) & 63, B1 = ((MK_TIME) >> 18) & 63;
        const float fA = (float)((st(A1) - st(A0)) / tot), fB = (float)((st(B1) - st(B0)) / tot);
        for (int i = F.tid; i < 2 * 32 * 256; i += NTHR) a.out[O_CMP_S + i] *= (1.f + fA);
        if (F.tid == 0) a.out[O_SLC_S] += fB; }
#endif
#if defined(MK_CHECK) && MK_CHECK
    xcd_barrier(bar); chk_phase(F, a); xcd_barrier(bar); chk_apply(F, a);
#endif
#undef IN
#undef SEAM
}

extern "C" void kernel_launch(void* const* d_in, const int* in_sizes, int n_in, void* d_out, int out_size, void* d_ws, size_t ws_size, hipStream_t stream) {
    static int grid = 0;
    if (grid == 0) {
        if (n_in != N_INPUTS || (size_t)out_size != O_END || ws_size < WS_END) { fprintf(stderr, "kernel_launch: unexpected shapes: n_in %d out %d ws %zu (need %zu)\n", n_in, out_size, ws_size, (size_t)WS_END); grid = -1; return; }
        int dev = 0, cus = 0, per_cu = 0;
        if (hipGetDevice(&dev) != hipSuccess || hipDeviceGetAttribute(&cus, hipDeviceAttributeMultiprocessorCount, dev) != hipSuccess) { grid = -1; return; }
        if (hipFuncSetAttribute((const void*)mega, hipFuncAttributeMaxDynamicSharedMemorySize, LDS_BYTES) != hipSuccess) { fprintf(stderr, "kernel_launch: hipFuncSetAttribute failed\n"); grid = -1; return; }
        if (hipOccupancyMaxActiveBlocksPerMultiprocessor(&per_cu, (const void*)mega, NTHR, LDS_BYTES) != hipSuccess || per_cu < 1) fprintf(stderr, "kernel_launch: occupancy query says %d\n", per_cu);
        (void)hipGetLastError();
        grid = cus;
    }
    if (grid < 0) return;
    if (hipMemsetAsync((char*)d_ws + WS_CTL, 0, ZERO_BYTES, stream) != hipSuccess) return;
    Args a{};
    for (int i = 0; i < N_INPUTS; ++i) a.in[i] = d_in[i];
    a.out = (float*)d_out; a.ws = (unsigned char*)d_ws;
#if MK_FUSED
    a.ph_lo = 0; a.ph_hi = NPH;
    hipLaunchKernelGGL(mega, dim3(grid), dim3(NTHR), LDS_BYTES, stream, a);
#else
    for (int ph = 0; ph < NPH; ++ph) {
        const int lp = ph == 0 ? -1 : (ph - 1) % NPL, l = ph == 0 ? 0 : (ph - 1) / NPL;
        const bool active = ph == 0 || (lp == LP_LNMOD && l == 0) || lp == LP_INPROJ || lp == LP_PREP || lp == LP_CMP1 || lp == LP_CMP2 || lp == LP_MIX || lp == LP_ONORM || lp == LP_UP || lp == LP_OUT || lp == LP_LN1 || (lp == LP_MOEG && l == 1) || lp == LP_FFN1 || lp == LP_FFN2 || lp == LP_LN2;
        if (!active) continue;
        a.ph_lo = ph; a.ph_hi = ph + 1;
        hipLaunchKernelGGL(mega, dim3(grid), dim3(NTHR), LDS_BYTES, stream, a);
    }
#endif
}
```

```cpp
#include <hip/hip_runtime.h>
#include <cstdio>
#include <cstdint>
namespace pg8 {
#define PG8_LAS __attribute__((address_space(3)))
typedef unsigned short bf16_t;
typedef short bf16x8 __attribute__((ext_vector_type(8)));
typedef float f32x4 __attribute__((ext_vector_type(4)));
typedef unsigned u32x4 __attribute__((ext_vector_type(4)));
constexpr int BM = 256, BK = 64, HALF = 128, HTB = HALF * BK * 2  , STAGE_BYTES = 8 * HTB, NXCD = 8, WGM = 8;

__host__ __device__ __forceinline__ int lds_byte(int r, int c) { const int st = (r >> 4) * 2 + (c >> 5), rr = r & 15, cc = c & 31, ob = rr * 64 + cc * 2; return st * 1024 + (ob ^ (((ob >> 9) & 1) << 5)); }
__host__ __device__ __forceinline__ void stage_rc(int b, int& R, int& C) { const int st = b / 1024, sb = b % 1024, swz = sb ^ (((sb >> 9) & 1) << 5); R = (st >> 1) * 16 + swz / 64; C = (st & 1) * 32 + (swz % 64) / 2; }
__host__ __device__ __forceinline__ int perm32(int rho) { const int n = rho >> 4, i = rho & 15; return 8 * (i >> 2) + 4 * n + (i & 3); }

struct Unit { int pm, pn, am, bn, am2, bn2; };
struct Gemm { const bf16_t* A; const bf16_t* Bt; int M, N, K; };

struct StaticOrder {
    int nM, nN, nwg, G, c;
    __host__ __device__ void init(int M, int N, int G_, int c_) { nM = M / BM; nN = N / BM; nwg = nM * nN; G = G_; c = c_; }
    __host__ __device__ bool next(int i, Unit& u) const {
        const long L = (long)i * G + c; if (L >= nwg) return false;
        int wgid = (int)L; { const int q = nwg / NXCD, r = nwg % NXCD, xcd = wgid % NXCD, off = wgid / NXCD; wgid = (xcd < r ? xcd * (q + 1) : r * (q + 1) + (xcd - r) * q) + off; }
        const int nig = WGM * nN, gid = wgid / nig, fm = gid * WGM, gsz = (nM - fm) < WGM ? (nM - fm) : WGM;
        u.pm = fm + ((wgid % nig) % gsz); u.pn = (wgid % nig) / gsz; u.am = u.pm; u.bn = u.pn; u.am2 = 0; u.bn2 = 0; return true;
    }
    __device__ __forceinline__ void a_ready(const Unit&) const {}
    __device__ __forceinline__ void done(const Unit&) const {}
};

template <class Epi, class Sched, bool ALIGN_EPI = false, bool SP2 = false>
__device__ __forceinline__ void gemm_phase(PG8_LAS unsigned char* lds, const Gemm g, const Sched& S, const Epi& E, int tid_in) {
    int tid_ = tid_in; asm volatile("" : "+v"(tid_));
    const int tid = tid_, wid = __builtin_amdgcn_readfirstlane(tid >> 6), lane = tid & 63, wr = wid >> 2, wc = wid & 3, fr = lane & 15, fq = lane >> 4;
    const int K = g.K, nt = K / BK, ntot = Epi::CHAIN ? 2 * nt : nt;
    unsigned voffA[2], voffB[2];
#pragma unroll
    for (int i = 0; i < 2; ++i) { int R, C; stage_rc(tid * 16 + i * 8192, R, C); const int Rb = Epi::PERM ? ((R & ~31) + perm32(R & 31)) : R;
        voffA[i] = (unsigned)(R * K + C) * 2u; voffB[i] = (unsigned)(Rb * K + C) * 2u; }
    const size_t kstep = (size_t)(BK * 2);
    const size_t hstep = (size_t)HALF * K * 2;
    const size_t tstep = 2 * hstep;
    const unsigned ldsw = (unsigned)wid * 1024u;
    const int aoff = lds_byte(wr * 64 + fr, fq * 8), boff = lds_byte(wc * 32 + fr, fq * 8);
#define PG8_SA(b, h) (((b) * 2 + (h)) * HTB)
#define PG8_SB(b, h) ((4 + (b) * 2 + (h)) * HTB)
#define PG8_STAGE(bufoff, gbase, voff) do { _Pragma("unroll") for (int _i = 0; _i < 2; ++_i) \
        __builtin_amdgcn_global_load_lds((const unsigned*)((const char*)(gbase) + (voff)[_i]), (PG8_LAS unsigned*)(lds + (bufoff) + ldsw + _i * 8192), 16, 0, 0); } while (0)
#define PG8_LDA(dst, b, h) do { _Pragma("unroll") for (int m = 0; m < 4; ++m) _Pragma("unroll") for (int k = 0; k < 2; ++k) dst[m][k] = *(const PG8_LAS bf16x8*)(lds + PG8_SA(b, h) + aoff + m * 2048 + k * 1024); } while (0)
#define PG8_LDB(dst, b, h) do { _Pragma("unroll") for (int n = 0; n < 2; ++n) _Pragma("unroll") for (int k = 0; k < 2; ++k) dst[n][k] = *(const PG8_LAS bf16x8*)(lds + PG8_SB(b, h) + boff + n * 2048 + k * 1024); } while (0)
#define PG8_MMA(ai, bj, At, Bt) do { __builtin_amdgcn_s_setprio(1); _Pragma("unroll") for (int m = 0; m < 4; ++m) _Pragma("unroll") for (int n = 0; n < 2; ++n) _Pragma("unroll") for (int k = 0; k < 2; ++k) \
        acc[ai][bj][m][n] = __builtin_amdgcn_mfma_f32_16x16x32_bf16(Bt[n][k], At[m][k], acc[ai][bj][m][n], 0, 0, 0); __builtin_amdgcn_s_setprio(0); } while (0)
#define PG8_WAIT_V(n) asm volatile("s_waitcnt vmcnt(" #n ")" ::: "memory")
#define PG8_WAIT_L(n) asm volatile("s_waitcnt lgkmcnt(" #n ")" ::: "memory")
#define PG8_BAR __builtin_amdgcn_s_barrier()
#define PG8_SCHED __builtin_amdgcn_sched_barrier(0)
    Unit cur, nxt; int ui = 0;
    if (!S.next(0, cur)) return;
    f32x4 acc[2][2][4][2];
#pragma unroll
    for (int a = 0; a < 2; ++a)
#pragma unroll
        for (int b = 0; b < 2; ++b)
#pragma unroll
            for (int m = 0; m < 4; ++m)
#pragma unroll
                for (int n = 0; n < 2; ++n) acc[a][b][m][n] = (f32x4){0.f, 0.f, 0.f, 0.f};
    bf16x8 At[4][2], B0[2][2], B1[2][2];
    const char* cA = (const char*)g.A + (size_t)cur.am * tstep; const char* cB = (const char*)g.Bt + (size_t)cur.bn * tstep;
    const char* cA2 = cA; const char* cB2 = cB; if constexpr (Epi::CHAIN) { cA2 = (const char*)g.A + (size_t)cur.am2 * tstep; cB2 = (const char*)g.Bt + (size_t)cur.bn2 * tstep; }
#define PG8_TA(x) ((Epi::CHAIN && (x) >= nt) ? cA2 + (size_t)((x) - nt) * kstep : cA + (size_t)(x) * kstep)
#define PG8_TB(x) ((Epi::CHAIN && (x) >= nt) ? cB2 + (size_t)((x) - nt) * kstep : cB + (size_t)(x) * kstep)
    S.a_ready(cur);
    if constexpr (SP2) {
        PG8_STAGE(PG8_SB(0, 0), cB, voffB); PG8_STAGE(PG8_SB(0, 1), cB + hstep, voffB); PG8_STAGE(PG8_SA(0, 0), cA, voffA); PG8_STAGE(PG8_SA(0, 1), cA + hstep, voffA);
        if (wr == 1) PG8_BAR;
        PG8_WAIT_V(2); PG8_BAR;
        PG8_STAGE(PG8_SB(1, 0), cB + kstep, voffB); PG8_STAGE(PG8_SA(1, 0), cA + kstep, voffA); PG8_STAGE(PG8_SB(1, 1), cB + hstep + kstep, voffB);
        PG8_WAIT_V(6); PG8_BAR;
    } else {
        PG8_STAGE(PG8_SB(0, 0), cB, voffB); PG8_STAGE(PG8_SA(0, 0), cA, voffA); PG8_STAGE(PG8_SB(0, 1), cB + hstep, voffB); PG8_STAGE(PG8_SA(0, 1), cA + hstep, voffA);
        if (wr == 1) PG8_BAR;
        PG8_WAIT_V(4); PG8_BAR;
        PG8_STAGE(PG8_SB(1, 0), cB + kstep, voffB); PG8_STAGE(PG8_SA(1, 0), cA + kstep, voffA); PG8_STAGE(PG8_SB(1, 1), cB + hstep + kstep, voffB);
        PG8_WAIT_V(6); PG8_BAR;
    }
    for (;;) {
        const bool has_next = S.next(ui + 1, nxt);
        const char* nA = has_next ? (const char*)g.A + (size_t)nxt.am * tstep : cA; const char* nB = has_next ? (const char*)g.Bt + (size_t)nxt.bn * tstep : cB;
        for (int t = 0; t < ntot; t += 2) {
            if constexpr (Epi::CHAIN) { if (t == nt) E.mid(acc, cur, wr, wc, fr, fq); }
            const bool last = (t == ntot - 2);
            const char* a1 = PG8_TA(t + 1);
            const char* a2 = last ? nA : PG8_TA(t + 2); const char* b2 = last ? nB : PG8_TB(t + 2);
            const char* a3 = a2 + kstep; const char* b3 = b2 + kstep;
            if (last && has_next) S.a_ready(nxt);
            if constexpr (SP2) {
            PG8_LDB(B0, 0, 0); PG8_LDB(B1, 0, 1); PG8_SCHED; PG8_LDA(At, 0, 0); PG8_STAGE(PG8_SA(1, 1), a1 + hstep, voffA);
            PG8_WAIT_V(8); PG8_WAIT_L(0); PG8_BAR; PG8_MMA(0, 0, At, B0); PG8_MMA(0, 1, At, B1); PG8_BAR; PG8_SCHED;
            PG8_LDA(At, 0, 1); PG8_STAGE(PG8_SB(0, 0), b2, voffB); PG8_STAGE(PG8_SB(0, 1), b2 + hstep, voffB); PG8_STAGE(PG8_SA(0, 0), a2, voffA);
            PG8_WAIT_V(8); PG8_WAIT_L(0); PG8_BAR; PG8_MMA(1, 0, At, B0); PG8_MMA(1, 1, At, B1); PG8_BAR; PG8_SCHED;
            PG8_LDB(B0, 1, 0); PG8_LDB(B1, 1, 1); PG8_SCHED; PG8_LDA(At, 1, 0); PG8_STAGE(PG8_SA(0, 1), a2 + hstep, voffA);
            PG8_WAIT_V(8); PG8_WAIT_L(0); PG8_BAR; PG8_MMA(0, 0, At, B0); PG8_MMA(0, 1, At, B1); PG8_BAR; PG8_SCHED;
            PG8_LDA(At, 1, 1); PG8_STAGE(PG8_SB(1, 0), b3, voffB); PG8_STAGE(PG8_SB(1, 1), b3 + hstep, voffB); PG8_STAGE(PG8_SA(1, 0), a3, voffA);
            PG8_WAIT_V(8); PG8_WAIT_L(0); PG8_BAR; PG8_MMA(1, 0, At, B0); PG8_MMA(1, 1, At, B1); PG8_BAR; PG8_SCHED;
            } else {
            PG8_LDB(B0, 0, 0); PG8_SCHED; PG8_LDA(At, 0, 0); PG8_STAGE(PG8_SA(1, 1), a1 + hstep, voffA);
            PG8_WAIT_L(8); PG8_BAR; PG8_WAIT_L(0); PG8_MMA(0, 0, At, B0); PG8_BAR; PG8_SCHED;
            PG8_LDB(B1, 0, 1); PG8_STAGE(PG8_SB(0, 0), b2, voffB);
            PG8_BAR; PG8_WAIT_L(0); PG8_MMA(0, 1, At, B1); PG8_BAR;
            PG8_LDA(At, 0, 1); PG8_STAGE(PG8_SA(0, 0), a2, voffA);
            PG8_BAR; PG8_WAIT_L(0); PG8_MMA(1, 0, At, B0); PG8_BAR; PG8_SCHED;
            PG8_STAGE(PG8_SB(0, 1), b2 + hstep, voffB);
            PG8_WAIT_V(6); PG8_BAR; PG8_MMA(1, 1, At, B1); PG8_BAR;
            PG8_LDB(B0, 1, 0); PG8_SCHED; PG8_LDA(At, 1, 0); PG8_STAGE(PG8_SA(0, 1), a2 + hstep, voffA);
            PG8_WAIT_L(8); PG8_BAR; PG8_WAIT_L(0); PG8_MMA(0, 0, At, B0); PG8_BAR; PG8_SCHED;
            PG8_LDB(B1, 1, 1); PG8_STAGE(PG8_SB(1, 0), b3, voffB);
            PG8_BAR; PG8_WAIT_L(0); PG8_MMA(0, 1, At, B1); PG8_BAR;
            PG8_LDA(At, 1, 1); PG8_STAGE(PG8_SA(1, 0), a3, voffA);
            PG8_BAR; PG8_WAIT_L(0); PG8_MMA(1, 0, At, B0); PG8_BAR; PG8_SCHED;
            PG8_STAGE(PG8_SB(1, 1), b3 + hstep, voffB);
            PG8_WAIT_V(6); PG8_BAR; PG8_MMA(1, 1, At, B1); PG8_BAR;
            }
        }
        if constexpr (ALIGN_EPI) { if (wr == 0) PG8_BAR; }
        if constexpr (!Epi::AFTER_DRAIN) { E(acc, cur, wr, wc, fr, fq); S.done(cur); }
        if (!has_next) break;
#pragma unroll
        for (int a = 0; a < 2; ++a)
#pragma unroll
            for (int b = 0; b < 2; ++b)
#pragma unroll
                for (int m = 0; m < 4; ++m)
#pragma unroll
                    for (int n = 0; n < 2; ++n) acc[a][b][m][n] = (f32x4){0.f, 0.f, 0.f, 0.f};
        cur = nxt; cA = nA; cB = nB; ++ui;
        if constexpr (Epi::CHAIN) { cA2 = (const char*)g.A + (size_t)cur.am2 * tstep; cB2 = (const char*)g.Bt + (size_t)cur.bn2 * tstep; }
        if constexpr (ALIGN_EPI) { if (wr == 1) PG8_BAR; }
    }
    PG8_WAIT_V(0);
    if constexpr (!ALIGN_EPI) { if (wr == 0) PG8_BAR; }
    PG8_BAR;
    if constexpr (Epi::AFTER_DRAIN) { E.fused(acc, cur, wr, wc, fr, fq, lds, wid, lane); S.done(cur); }
#undef PG8_SA
#undef PG8_SB
#undef PG8_STAGE
#undef PG8_LDA
#undef PG8_LDB
#undef PG8_MMA
#undef PG8_WAIT_V
#undef PG8_WAIT_L
#undef PG8_BAR
#undef PG8_SCHED
#undef PG8_TA
#undef PG8_TB
}
}
#define GAS __attribute__((address_space(1)))
#define LAS __attribute__((address_space(3)))
typedef unsigned short bf16;
typedef unsigned v4u __attribute__((ext_vector_type(4)));
typedef unsigned v2u __attribute__((ext_vector_type(2)));
typedef float f32x4 __attribute__((ext_vector_type(4)));
typedef float f32x2 __attribute__((ext_vector_type(2)));
typedef short bf16x8 __attribute__((ext_vector_type(8)));
typedef short bf16x4 __attribute__((ext_vector_type(4)));
typedef GAS unsigned gu32;
#define RLX_AGENT __ATOMIC_RELAXED, __HIP_MEMORY_SCOPE_AGENT
#define LDS_WAIT() asm volatile("s_waitcnt lgkmcnt(0)" ::: "memory")
#define VM_WAIT() asm volatile("s_waitcnt vmcnt(0)" ::: "memory")
#define LBAR() do { asm volatile("s_waitcnt lgkmcnt(0)" ::: "memory"); __builtin_amdgcn_s_barrier(); asm volatile("" ::: "memory"); } while (0)

constexpr int NWAVES = 8, NTHR = 512;
constexpr int D = 1024, SEQ = 8192, NB = 2, MP = NB * SEQ, MS = 32, MT = 16640, NTILE_M = MT / 256, MREAL = MP + MS;
constexpr int H_A = 4, DK = 128, DV = 128, CQKV = 1536, CHUNK = 64, NCHUNK = SEQ / CHUNK;
constexpr int H_B = 8, G_B = 2, DH = 64, KVW = 256;
constexpr int NCMP = 511, NSLC = 128, NSEL = 16, WINDOW = 512;
constexpr int DFF = 2816, NEXP = 8;
constexpr int NIN = 5408, NINP = 5632;
constexpr int PAST = 8192, PAGE = 128, NPAGES = 64, NPOOL = 2560;
constexpr float ALPHA = 1.4142135623730951f;
constexpr float LN_EPS = 1e-5f;
constexpr int PC_QKV = 0, PC_Z = 1536, PC_QB = 2048, PC_KVC = 2560, PC_KVS = 2816, PC_KVW = 3072, PC_GM = 3328, PC_SM = 5376;

constexpr size_t O_YP = 0, O_YS = O_YP + (size_t)MP * D, O_DELTA_P = O_YS + (size_t)MS * D, O_CONV_P = O_DELTA_P + 2ull * 2 * 4 * 128 * 128,
    O_CMP_P = O_CONV_P + 2ull * 2 * 3 * 1536, O_SLC_P = O_CMP_P + 2ull * 2 * 8192 * 256, O_WIN_P = O_SLC_P + 2ull * 2 * 8192 * 256,
    O_DELTA_S = O_WIN_P + 2ull * 2 * 512 * 256, O_CONV_S = O_DELTA_S + 2ull * 32 * 4 * 128 * 128, O_CMP_S = O_CONV_S + 2ull * 32 * 3 * 1536,
    O_SLC_S = O_CMP_S + 2ull * 32 * 256, O_WIN_S = O_SLC_S + 2ull * 32 * 256, O_END = O_WIN_S + 2ull * 32 * 512 * 256;

enum { I_XP = 0, I_XS, I_SDELTA, I_SCONV, I_CCMP, I_CSLC, I_SWIN, I_PT, I_CP, I_CS, I_WADA, I_BADA, I_WIN, I_CONVW, I_ALOG, I_DTB, I_NORMW,
       I_CPOS, I_CW1, I_CW2, I_WUPA, I_WUPB, I_WOUT, I_LNG, I_LNB, I_FGU, I_FDN, I_MR, I_MGU, I_MDN, N_INPUTS };

constexpr size_t MiB = 1u << 20;
constexpr size_t WS_CTL = 0, WS_MOD = 1 * MiB, ZERO_BYTES = 4 * MiB;
constexpr size_t WS_WIN_T = 4 * MiB, WS_WUP_T = 26 * MiB, WS_WOUT_T = 30 * MiB, WS_WGU_T = 34 * MiB, WS_WDN_T = 45 * MiB, WS_MGU_T = 51 * MiB, WS_MDN_T = 139 * MiB, WS_CW1_T = 183 * MiB;
constexpr size_t WS_XN = 192 * MiB, WS_P = 225 * MiB, WS_SC = 404 * MiB, WS_XA = 407 * MiB, WS_XB = 472 * MiB, WS_Y = 537 * MiB, WS_OAB = 674 * MiB, WS_U = 707 * MiB,
    WS_ACT = 740 * MiB, WS_APERM = 929 * MiB, WS_MOE = 998 * MiB;
constexpr size_t WS_GDN = 1000 * MiB, WS_NSA = 1110 * MiB, WS_SMP = 1150 * MiB, WS_END = 1560 * MiB;
constexpr int CW_TMO = 0, CW_BAR = 4096;
constexpr int MODROWS = 34, MODW = 6144;

constexpr int RING_OFF = 0, RING_BYTES = 131072;
constexpr int LDSCTL_OFF = RING_BYTES, MISC_OFF = LDSCTL_OFF + 320;
constexpr int LDS_BYTES = 147456;

typedef float f32x2_t_ __attribute__((ext_vector_type(2))); typedef __bf16 bf16x2_t_ __attribute__((ext_vector_type(2)));
__device__ __forceinline__ unsigned pk2(float lo, float hi) { f32x2_t_ v = {lo, hi}; bf16x2_t_ b = __builtin_convertvector(v, bf16x2_t_); return __builtin_bit_cast(unsigned, b); }
__device__ __forceinline__ unsigned f2bf(float f) { return pk2(f, f) & 0xffffu; }
__device__ __forceinline__ float bf2f(unsigned short b) { return __builtin_bit_cast(float, (unsigned)b << 16); }
__device__ __forceinline__ float bflo(unsigned w) { return __builtin_bit_cast(float, w << 16); }
__device__ __forceinline__ float bfhi(unsigned w) { return __builtin_bit_cast(float, w & 0xffff0000u); }
__device__ __forceinline__ float add1(float e) { float one = 1.f; asm volatile("" : "+v"(one)); return e + one; }
__device__ __forceinline__ float sigmoidf_(float x) { return __builtin_amdgcn_rcpf(add1(__expf(-x))); }
__device__ __forceinline__ float siluf_(float x) { return x * __builtin_amdgcn_rcpf(add1(__expf(-x))); }
__device__ __forceinline__ float softplusf_(float x) { const float e = __expf(x); return x > 20.f ? x : (e < 0.01f ? e * (1.f - e * (0.5f - e * 0.33333334f)) : __logf(1.f + e)); }
__device__ __forceinline__ int my_lane() { int l; asm volatile("v_mbcnt_lo_u32_b32 %0, -1, 0\n\tv_mbcnt_hi_u32_b32 %0, -1, %0" : "=v"(l)); return l; }
__device__ __forceinline__ float bperm(float v, int srclane) { return __builtin_bit_cast(float, __builtin_amdgcn_ds_bpermute(srclane << 2, __builtin_bit_cast(int, v))); }
template <int O> __device__ __forceinline__ float shx(float v) {
    if constexpr (O < 32) return __builtin_bit_cast(float, __builtin_amdgcn_ds_swizzle(__builtin_bit_cast(int, v), (O << 10) | 0x1f));
    else return bperm(v, my_lane() ^ 32);
}
__device__ __forceinline__ float wave_sum(float v) { v += shx<1>(v); v += shx<2>(v); v += shx<4>(v); v += shx<8>(v); v += shx<16>(v); v += shx<32>(v); return v; }
__device__ __forceinline__ float wave_max(float v) { v = fmaxf(v, shx<1>(v)); v = fmaxf(v, shx<2>(v)); v = fmaxf(v, shx<4>(v)); v = fmaxf(v, shx<8>(v)); v = fmaxf(v, shx<16>(v)); v = fmaxf(v, shx<32>(v)); return v; }
#define XB_TMO      128
#define XB_XCNT(j)  (256  + 64 * (j))
#define XB_XSUB(j)  (1280 + 64 * (j))
#define XB_XGEN(j)  (2304 + 64 * (j))
#define XB_TOP      3328
#define XB_TOPGEN   3392
#define XCD_BAR_WORDS 3456
#define XB_SPIN_CAP (1u << 18)

__device__ __forceinline__ unsigned xb_ld(unsigned* p)              { return __hip_atomic_load(p, __ATOMIC_RELAXED, __HIP_MEMORY_SCOPE_AGENT); }
__device__ __forceinline__ unsigned xb_add(unsigned* p, unsigned v) { return __hip_atomic_fetch_add(p, v, __ATOMIC_RELAXED, __HIP_MEMORY_SCOPE_AGENT); }
__device__ __forceinline__ unsigned xb_xcc_id() { return (unsigned)__builtin_amdgcn_s_getreg((3 << 11) | 20) & 0xFu; }
#define XB_SPIN(cond, bar) do { unsigned _sp = 0; while (cond) { __builtin_amdgcn_s_sleep(1); \
    if ((++_sp & 255u) == 0u) { if (xb_ld(&(bar)[XB_TMO])) break; if (_sp > XB_SPIN_CAP) { atomicAdd(&(bar)[XB_TMO], 1u); break; } } } } while (0)

struct XcdBarrier {
    unsigned* bar; unsigned x;
    volatile LAS unsigned* st;
};

__device__ __forceinline__ XcdBarrier xcd_barrier_post(unsigned* bar, volatile LAS unsigned* st) {
    XcdBarrier b; b.bar = bar; b.x = xb_xcc_id(); b.st = st;
    if (threadIdx.x == 0) (void)xb_add(&bar[XB_XCNT(b.x)], 1u);
    return b;
}
__device__ __forceinline__ void xcd_barrier_complete(unsigned* bar, unsigned x, unsigned& nloc, unsigned& nx) {
    const unsigned G = gridDim.x * gridDim.y * gridDim.z;
    unsigned sum, cnt, mine, sp = 0u;
    for (;;) {
        sum = 0u; cnt = 0u; mine = 0u;
#pragma unroll
        for (unsigned j = 0; j < 16; ++j) { const unsigned c = xb_ld(&bar[XB_XCNT(j)]); sum += c; cnt += (c > 0u) ? 1u : 0u; mine = (j == x) ? c : mine; }
        if (sum == G) break;
        __builtin_amdgcn_s_sleep(1);
        if ((++sp & 255u) == 0u) { if (xb_ld(&bar[XB_TMO])) break; if (sp > XB_SPIN_CAP) { atomicAdd(&bar[XB_TMO], 1u); break; } }
    }
    nloc = mine > 0u ? mine : 1u; nx = cnt > 0u ? cnt : 1u;
}

__device__ __forceinline__ void xcd_barrier(const XcdBarrier& b) {
    asm volatile("s_waitcnt vmcnt(0)" ::: "memory");
    __syncthreads();
    if (threadIdx.x == 0) {
        unsigned* bar = b.bar;
        __builtin_amdgcn_s_waitcnt(0);
        unsigned nloc = b.st[0], nx = b.st[1];
        if (nloc == 0u) { xcd_barrier_complete(bar, b.x, nloc, nx); b.st[0] = nloc; b.st[1] = nx; }
        const unsigned old = xb_add(&bar[XB_XSUB(b.x)], 1u);
        const unsigned gen = old / nloc;
        if (old + 1u == (gen + 1u) * nloc) {
            __builtin_amdgcn_fence(__ATOMIC_RELEASE, "agent");
            asm volatile("s_waitcnt vmcnt(0)" ::: "memory");
            const unsigned og = xb_add(&bar[XB_TOP], 1u);
            const unsigned tg = og / nx;
            if (og + 1u == (tg + 1u) * nx) xb_add(&bar[XB_TOPGEN], 1u);
            else XB_SPIN(xb_ld(&bar[XB_TOPGEN]) == tg, bar);
            __builtin_amdgcn_fence(__ATOMIC_ACQUIRE, "agent");
            xb_add(&bar[XB_XGEN(b.x)], 1u);
            asm volatile("s_waitcnt vmcnt(0)" ::: "memory");
        } else {
            XB_SPIN(xb_ld(&bar[XB_XGEN(b.x)]) == gen, bar);
            __builtin_amdgcn_fence(__ATOMIC_ACQUIRE, "agent");
            asm volatile("s_waitcnt vmcnt(0)" ::: "memory");
        }
    }
    __syncthreads();
}

struct Args { const void* in[30]; float* out; unsigned char* ws; int ph_lo, ph_hi; };
struct Frame {
    LAS unsigned char* lds;
    volatile LAS unsigned* MISC;
    gu32* ctl;
    int tid, lane, wave, G, bid;
};
__device__ __forceinline__ const void* ld_in(const Args& a, int i) { int z = 0; asm volatile("" : "+s"(z)); return a.in[i + z]; }
#define INP(T, i) ((const T*)ld_in(a, i))
__device__ __forceinline__ unsigned char* ws_base(const Args& a) { unsigned char* p = a.ws; asm volatile("" : "+s"(p)); return p; }
#define WSP(T, off) ((T*)(ws_base(a) + (off)))

constexpr int PH_PRO = 0, NPL = 14, NPH = 1 + 2 * NPL;
constexpr int LP_LNMOD = 0, LP_INPROJ = 1, LP_PREP = 2, LP_CMP1 = 3, LP_CMP2 = 4, LP_MIX = 5, LP_ONORM = 6, LP_UP = 7, LP_OUT = 8, LP_LN1 = 9, LP_MOEG = 10, LP_FFN1 = 11, LP_FFN2 = 12, LP_LN2 = 13;

__device__ __forceinline__ int srccol(int map, int n) {
    if (map == 0) return n;
    if (map == 1) {
        if (n < 2048) return n;
        if (n < 2560) return 2056 + (n - 2048);
        if (n < 3328) return 2568 + (n - 2560);
        if (n < 5376) { const int w = n - 3328; return 3360 + ((w >> 7) & 1) * 1024 + 128 * (w >> 8) + (w & 127); }
        if (n < 5384) return 2048 + (n - 5376);
        if (n < 5408) return 3336 + (n - 5384);
        return -1;
    }
    { const int pn = n >> 8, w = n & 255; return (w >> 7) * DFF + 128 * pn + (w & 127); }
}
__device__ __forceinline__ void transpose_item(const float* W, int K, int Nsrc, bf16* WT, int map, LAS float* scr, int kb, int nb, int lane) {
    const int k0 = 64 * kb, n0 = 32 * nb, sc = srccol(map, n0 + (lane & 31)); const float* wp = W + (size_t)(k0 + (lane >> 5)) * Nsrc + (sc >= 0 ? sc : 0);
    float x[32];
#pragma unroll
    for (int i = 0; i < 32; ++i) x[i] = wp[(size_t)(2 * i) * Nsrc];
#pragma unroll
    for (int i = 0; i < 32; ++i) scr[(2 * i + (lane >> 5)) * 33 + (lane & 31)] = sc >= 0 ? x[i] : 0.f;
    LDS_WAIT(); asm volatile("" ::: "memory");
    const int c = lane & 7;
#pragma unroll
    for (int j = 0; j < 4; ++j) { const int n = (lane >> 3) + 8 * j; const LAS float* s = scr + (8 * c) * 33 + n;
        v4u o; o.x = pk2(s[0 * 33], s[1 * 33]); o.y = pk2(s[2 * 33], s[3 * 33]); o.z = pk2(s[4 * 33], s[5 * 33]); o.w = pk2(s[6 * 33], s[7 * 33]);
        *(GAS v4u*)(WT + (size_t)(n0 + n) * K + k0 + 8 * c) = o; }
    LDS_WAIT(); asm volatile("" ::: "memory");
}
constexpr int CONV_ITEMS = 46720, CW_CONVQ = 3776;
struct ConvIt { const float* wp; bf16* wt; int K, ls; bool ok; };
__device__ __forceinline__ ConvIt conv_decode(Frame& F, const Args& a, int gi) {
    const float* W; bf16* WT; int K, Nsrc, Ndest, map = 0, it;
    if (gi < 5632) { const int l = gi / 2816; it = gi - l * 2816; W = INP(float, I_WIN) + (size_t)l * D * NIN; K = D; Nsrc = NIN; WT = WSP(bf16, WS_WIN_T) + (size_t)l * NINP * D; Ndest = NINP; map = 1; }
    else if (gi < 7680) { const int r = gi - 5632, l = r >> 10, rr = r & 1023;
        if (rr < 256) { it = rr; W = INP(float, I_WUPA) + (size_t)l * 512 * D; K = 512; Nsrc = D; WT = WSP(bf16, WS_WUP_T) + (size_t)l * 2048 * 512; Ndest = D; }
        else if (rr < 512) { it = rr - 256; W = INP(float, I_WUPB) + (size_t)l * 512 * D; K = 512; Nsrc = D; WT = WSP(bf16, WS_WUP_T) + (size_t)l * 2048 * 512 + (size_t)1024 * 512; Ndest = D; }
        else { it = rr - 512; W = INP(float, I_WOUT) + (size_t)l * D * D; K = D; Nsrc = D; WT = WSP(bf16, WS_WOUT_T) + (size_t)l * D * D; Ndest = D; } }
    else if (gi < 10496) { it = gi - 7680; W = INP(float, I_FGU); K = D; Nsrc = 2 * DFF; WT = WSP(bf16, WS_WGU_T); Ndest = 2 * DFF; map = 2; }
    else if (gi < 11904) { it = gi - 10496; W = INP(float, I_FDN); K = DFF; Nsrc = D; WT = WSP(bf16, WS_WDN_T); Ndest = D; }
    else if (gi < 45696) { const int r = gi - 11904, e = r / 4224, rr = r - e * 4224;
        if (rr < 2816) { it = rr; W = INP(float, I_MGU) + (size_t)e * D * 2 * DFF; K = D; Nsrc = 2 * DFF; WT = WSP(bf16, WS_MGU_T) + (size_t)e * 2 * DFF * D; Ndest = 2 * DFF; map = 2; }
        else { it = rr - 2816; W = INP(float, I_MDN) + (size_t)e * DFF * D; K = DFF; Nsrc = D; WT = WSP(bf16, WS_MDN_T) + (size_t)e * D * DFF; Ndest = D; } }
    else { const int r = gi - 45696, q = r >> 7; it = r & 127;
        W = INP(float, I_CW1) + ((size_t)(q >> 1) * 2048 + (size_t)(q & 1) * 1024) * 256; K = 1024; Nsrc = 256; WT = WSP(bf16, WS_CW1_T) + ((size_t)(q >> 1) * 512 + (size_t)(q & 1) * 256) * 1024; Ndest = 256; }
    const int nnb = Ndest / 32, kb = it / nnb, nb = it % nnb, k0 = 64 * kb, n0 = 32 * nb, sc = srccol(map, n0 + (F.lane & 31));
    ConvIt r; r.wp = W + (size_t)(k0 + (F.lane >> 5)) * Nsrc + (sc >= 0 ? sc : 0); r.wt = WT + (size_t)n0 * K + k0; r.K = K; r.ls = 2 * Nsrc; r.ok = sc >= 0; return r;
}
__device__ __forceinline__ void conv_load(float (&x)[32], const ConvIt& c) {
#pragma unroll
    for (int i = 0; i < 32; ++i) x[i] = c.wp[(size_t)i * c.ls];
}
__device__ __forceinline__ void conv_store(const float (&x)[32], const ConvIt& c, LAS float* scr, int lane) {
#pragma unroll
    for (int i = 0; i < 32; ++i) scr[(2 * i + (lane >> 5)) * 33 + (lane & 31)] = c.ok ? x[i] : 0.f;
    LDS_WAIT(); asm volatile("" ::: "memory");
    const int cc = lane & 7;
#pragma unroll
    for (int j = 0; j < 4; ++j) { const int n = (lane >> 3) + 8 * j; const LAS float* s = scr + (8 * cc) * 33 + n;
        v4u o; o.x = pk2(s[0 * 33], s[1 * 33]); o.y = pk2(s[2 * 33], s[3 * 33]); o.z = pk2(s[4 * 33], s[5 * 33]); o.w = pk2(s[6 * 33], s[7 * 33]);
        *(GAS v4u*)(c.wt + (size_t)n * c.K + 8 * cc) = o; }
    LDS_WAIT(); asm volatile("" ::: "memory");
}
__device__ __forceinline__ void conv_item(Frame& F, const Args& a, int gi, LAS float* scr) { const ConvIt c = conv_decode(F, a, gi); float x[32]; conv_load(x, c); conv_store(x, c, scr, F.lane); }

constexpr int CONV_MOE0 = 11904, CONV_MOE1 = 45696, CONV_PRO = CONV_ITEMS - (CONV_MOE1 - CONV_MOE0);
__device__ __forceinline__ void convert_all(Frame& F, const Args& a) {
    LAS float* scr = (LAS float*)(F.lds + RING_OFF + F.wave * 16384);
    for (;;) {
        int c = 0; if (F.lane == 0) c = (int)__hip_atomic_fetch_add(F.ctl + CW_CONVQ, 1u, __ATOMIC_RELAXED, __HIP_MEMORY_SCOPE_AGENT);
        c = __builtin_amdgcn_readfirstlane(c);
        if (c * 4 >= CONV_PRO) break;
        float xa[32], xb[32]; const int g0 = c * 4;
#define CONV_GI(j) ((g0 + (j)) < CONV_MOE0 ? (g0 + (j)) : (g0 + (j)) + (CONV_MOE1 - CONV_MOE0))
        ConvIt ca = conv_decode(F, a, CONV_GI(0)), cb; conv_load(xa, ca);
        cb = conv_decode(F, a, CONV_GI(1)); conv_load(xb, cb); conv_store(xa, ca, scr, F.lane);
        ca = conv_decode(F, a, CONV_GI(2)); conv_load(xa, ca); conv_store(xb, cb, scr, F.lane);
        cb = conv_decode(F, a, CONV_GI(3)); conv_load(xb, cb); conv_store(xa, ca, scr, F.lane);
        conv_store(xb, cb, scr, F.lane);
#undef CONV_GI
    }
}
constexpr int DEFER_CHUNKS = 256 + (CONV_MOE1 - CONV_MOE0) / 128;
template <int NR> __device__ __forceinline__ void seg_page(Frame& F, const Args& a, int it);
__device__ __forceinline__ void defer_chunk(Frame& F, const Args& a, int d) {
    if (d < 256) seg_page<16>(F, a, 2048 + d * 8 + F.wave);
    else { LAS float* scr = (LAS float*)(F.lds + RING_OFF + F.wave * 16384); const int g0 = CONV_MOE0 + (d - 256) * 128 + F.wave * 16;
        float xa[32], xb[32]; ConvIt ca = conv_decode(F, a, g0), cb; conv_load(xa, ca);
#pragma unroll 1
        for (int j = 0; j < 16; j += 2) {
            cb = conv_decode(F, a, g0 + j + 1); conv_load(xb, cb);
            conv_store(xa, ca, scr, F.lane);
            ca = conv_decode(F, a, g0 + (j + 2 < 16 ? j + 2 : 15)); conv_load(xa, ca);
            conv_store(xb, cb, scr, F.lane); } }
}
__device__ __forceinline__ void mod_gemv(Frame& F, const Args& a) {
    LAS float* s = (LAS float*)(F.lds + RING_OFF);
    float* MOD = WSP(float, WS_MOD);
    for (int item = F.bid; item < 96; item += F.G) {
        const int l = item / 48, rg = (item % 48) / 12, cb = item % 12, r0 = rg * 9, nr = rg == 3 ? 7 : 9;
        { float cv[18];
#pragma unroll
          for (int q = 0; q < 18; ++q) { const int idx = F.tid + q * NTHR, r = r0 + (idx >> 10), k = idx & 1023; const int rc = r < MODROWS ? r : MODROWS - 1;
              cv[q] = rc < 2 ? INP(float, I_CP)[rc * D + k] : INP(float, I_CS)[(rc - 2) * D + k]; }
#pragma unroll
          for (int q = 0; q < 18; ++q) { const int idx = F.tid + q * NTHR, r = r0 + (idx >> 10); s[idx] = r < MODROWS ? siluf_(cv[q]) : 0.f; } }
        __syncthreads();
        const int col = cb * 512 + F.wave * 64 + F.lane;
        const float* W = INP(float, I_WADA) + (size_t)l * D * MODW + col;
        float acc[9];
#pragma unroll
        for (int r = 0; r < 9; ++r) acc[r] = 0.f;
#pragma unroll 1
        for (int k32 = 0; k32 < 32; ++k32) { float w[32];
#pragma unroll
            for (int j = 0; j < 32; ++j) w[j] = W[(size_t)(32 * k32 + j) * MODW];
#pragma unroll
            for (int j4 = 0; j4 < 8; ++j4) {
#pragma unroll
                for (int r = 0; r < 9; ++r) { const f32x4 f = *(const LAS f32x4*)(s + r * 1024 + 32 * k32 + 4 * j4); acc[r] += f.x * w[4 * j4] + f.y * w[4 * j4 + 1] + f.z * w[4 * j4 + 2] + f.w * w[4 * j4 + 3]; }
                asm volatile("" ::: "memory"); } }
        const float bias = INP(float, I_BADA)[l * MODW + col];
#pragma unroll
        for (int r = 0; r < 9; ++r) if (r < nr) MOD[(size_t)(l * MODROWS + r0 + r) * MODW + col] = acc[r] + bias;
        __syncthreads();
    }
}
__device__ __forceinline__ void copy_f4(Frame& F, const float* src, float* dst, size_t n4) {
    const size_t stride = (size_t)F.G * NTHR;
    for (size_t i = (size_t)F.bid * NTHR + F.tid; i < n4; i += stride) ((GAS f32x4*)dst)[i] = ((const GAS f32x4*)src)[i];
}
__device__ __forceinline__ void nsa_prologue(Frame& F, const Args& a);
#if defined(MK_TIME)
#define PSTAMP(k) do { if (F.bid == 0 && F.tid == 0) { const unsigned long long t_ = __builtin_amdgcn_s_memrealtime(); F.ctl[3200 + 2 * (k)] = (unsigned)t_; F.ctl[3201 + 2 * (k)] = (unsigned)(t_ >> 32); } } while (0)
#else
#define PSTAMP(k) do { } while (0)
#endif
__device__ __forceinline__ void p0_prologue(Frame& F, const Args& a) {
    mod_gemv(F, a); PSTAMP(52);
    nsa_prologue(F, a); PSTAMP(53);
    { constexpr int W4 = 511 * 256 / 4, C4 = 2 * 1536 / 4, NW4 = 64 * W4, NALL = NW4 + 64 * C4; const int stride = F.G * NTHR;
      const float* swin = INP(float, I_SWIN); const float* sconv = INP(float, I_SCONV);
      for (int i0 = F.bid * NTHR + F.tid; i0 < NALL; i0 += 4 * stride) { f32x4 v[4]; GAS f32x4* d[4];
#pragma unroll
          for (int j = 0; j < 4; ++j) { const int i = i0 + j * stride; d[j] = nullptr;
              if (i < NW4) { const int lb = i / W4, r = i - lb * W4; v[j] = ((const GAS f32x4*)(swin + ((size_t)lb * 512 + 1) * 256))[r]; d[j] = (GAS f32x4*)(a.out + O_WIN_S + (size_t)lb * 512 * 256) + r; }
              else if (i < NALL) { const int k = i - NW4, lb = k / C4, r = k - lb * C4; v[j] = ((const GAS f32x4*)(sconv + ((size_t)lb * 3 + 1) * 1536))[r]; d[j] = (GAS f32x4*)(a.out + O_CONV_S + (size_t)lb * 3 * 1536) + r; } }
#pragma unroll
          for (int j = 0; j < 4; ++j) if (d[j]) *d[j] = v[j]; } }
    PSTAMP(54);
    convert_all(F, a);
}

__device__ __forceinline__ const float* mod_row(const Args& a, int l, int row) { return WSP(float, WS_MOD) + (size_t)(l * MODROWS + (row < MP ? (row >> 13) : 2 + (row - MP))) * MODW; }
__device__ __forceinline__ const float* x_in_row(const Args& a, int row) { return row < MP ? INP(float, I_XP) + (size_t)row * D : INP(float, I_XS) + (size_t)(row - MP) * D; }
__device__ __forceinline__ void row_stats(const f32x4 (&v)[4], float& mean, float& rstd) {
    float s = 0.f;
#pragma unroll
    for (int j = 0; j < 4; ++j) s += (v[j].x + v[j].y) + (v[j].z + v[j].w);
    mean = wave_sum(s) * (1.f / D); float q = 0.f;
#pragma unroll
    for (int j = 0; j < 4; ++j) { const f32x4 d = v[j] - mean; q += (d.x * d.x + d.y * d.y) + (d.z * d.z + d.w * d.w); }
    rstd = 1.f / sqrtf(wave_sum(q) * (1.f / D) + LN_EPS);
}
__device__ __forceinline__ void mod_ln_store(const f32x4 (&v)[4], const float* sh, const float* sc, bf16* orow, int lane) {
    float mean, rstd; row_stats(v, mean, rstd);
#pragma unroll
    for (int j = 0; j < 4; ++j) { const int c = 256 * j + 4 * lane; const f32x4 s1 = *(const GAS f32x4*)(sc + c), s0 = *(const GAS f32x4*)(sh + c);
        const f32x4 xh = (v[j] - mean) * rstd; const f32x4 h = xh * s1 + (xh + s0); v2u o; o.x = pk2(h.x, h.y); o.y = pk2(h.z, h.w); *(GAS v2u*)(orow + c) = o; }
}
__device__ __forceinline__ void p_lnmod0(Frame& F, const Args& a) {
    const int gw = F.bid * NWAVES + F.wave, NGW = F.G * NWAVES; bf16* XN = WSP(bf16, WS_XN);
    for (int row = gw; row < MT; row += NGW) {
        if (row >= MREAL) { for (int j = 0; j < 4; ++j) *(GAS v2u*)(XN + (size_t)row * D + 256 * j + 4 * F.lane) = (v2u){0u, 0u}; continue; }
        const float* xr = x_in_row(a, row); f32x4 v[4];
#pragma unroll
        for (int j = 0; j < 4; ++j) v[j] = *(const GAS f32x4*)(xr + 256 * j + 4 * F.lane);
        const float* mr = mod_row(a, 0, row);
        mod_ln_store(v, mr, mr + D, XN + (size_t)row * D, F.lane);
    }
}
__device__ __forceinline__ f32x4 bf4(v2u w) { return (f32x4){bflo(w.x), bfhi(w.x), bflo(w.y), bfhi(w.y)}; }
constexpr size_t MOE_META = WS_MOE, MOE_SLOT = WS_MOE + 64 * 1024, MOE_EPOS = WS_MOE + 256 * 1024, MOE_PROB = WS_MOE + 1 * MiB, MOE_CNT = WS_MOE + 1536 * 1024;
constexpr int CW_MOECNT = 2048;
template <int YMODE, bool ROUTE> __device__ __forceinline__ void p_lnpass(Frame& F, const Args& a, int l, int which, const float* xsrc, float* xdst, const bf16* Y) {
    const int gw = F.bid * NWAVES + F.wave, NGW = F.G * NWAVES; bf16* XN = WSP(bf16, WS_XN);
    const float* lg = INP(float, I_LNG) + (size_t)(l * 2 + which) * D; const float* lb = INP(float, I_LNB) + (size_t)(l * 2 + which) * D;
    const int* mslot = WSP(int, MOE_SLOT); float* mprob = WSP(float, MOE_PROB);
    f32x4 xn[4]; v2u yn[4], y2n[4]; int s0n = 0, s1n = 0; float p0n = 0.f, p1n = 0.f;
    int rc[8] = {0, 0, 0, 0, 0, 0, 0, 0};
#define LNP_LOAD(rw) do { const int rw_ = (rw); if (rw_ < MREAL) { const float* xr_ = xsrc ? xsrc + (size_t)rw_ * D : x_in_row(a, rw_); \
        if (YMODE == 2) { s0n = mslot[2 * rw_]; s1n = mslot[2 * rw_ + 1]; p0n = mprob[2 * rw_]; p1n = mprob[2 * rw_ + 1]; } \
        _Pragma("unroll") for (int j = 0; j < 4; ++j) { const int c = 256 * j + 4 * F.lane; xn[j] = *(const GAS f32x4*)(xr_ + c); \
            if (YMODE == 1) yn[j] = *(const GAS v2u*)(Y + (size_t)rw_ * D + c); \
            if (YMODE == 2) { yn[j] = *(const GAS v2u*)(Y + (size_t)s0n * D + c); y2n[j] = *(const GAS v2u*)(Y + (size_t)s1n * D + c); } } } } while (0)
    f32x4 wr[ROUTE ? 32 : 1];
    if (ROUTE) { const float* Wr = INP(float, I_MR);
#pragma unroll
        for (int j = 0; j < 4; ++j)
#pragma unroll
            for (int q = 0; q < 4; ++q) { const int c = 256 * j + 4 * F.lane + q; wr[(4 * j + q) * 2] = *(const GAS f32x4*)(Wr + (size_t)c * 8); wr[(4 * j + q) * 2 + 1] = *(const GAS f32x4*)(Wr + (size_t)c * 8 + 4); } }
    LNP_LOAD(gw);
    for (int row = gw; row < MREAL; row += NGW) {
        const float* mr = mod_row(a, l, row); const float* gate = mr + (which ? 5 : 2) * D;
        f32x4 v[4];
#pragma unroll
        for (int j = 0; j < 4; ++j) { const int c = 256 * j + 4 * F.lane; f32x4 x = xn[j] * ALPHA;
            if (YMODE == 1) x += *(const GAS f32x4*)(gate + c) * bf4(yn[j]);
            if (YMODE == 2) x += *(const GAS f32x4*)(gate + c) * (bf4(yn[j]) * p0n + bf4(y2n[j]) * p1n);
            v[j] = x; }
        LNP_LOAD(row + NGW);
        float mean, rstd; row_stats(v, mean, rstd);
        float* xo = xdst ? xdst + (size_t)row * D : (row < MP ? a.out + O_YP + (size_t)row * D : a.out + O_YS + (size_t)(row - MP) * D);
#pragma unroll
        for (int j = 0; j < 4; ++j) { const int c = 256 * j + 4 * F.lane; v[j] = (v[j] - mean) * rstd * *(const GAS f32x4*)(lg + c) + *(const GAS f32x4*)(lb + c); *(GAS f32x4*)(xo + c) = v[j]; }
        const float* sh = nullptr; const float* sc = nullptr;
        if (which == 0) { sh = mr + 3 * D; sc = mr + 4 * D; } else if (l == 0) { const float* mr2 = mod_row(a, 1, row); sh = mr2; sc = mr2 + D; }
        if (sh) {
            row_stats(v, mean, rstd);
#pragma unroll
            for (int j = 0; j < 4; ++j) { const int c = 256 * j + 4 * F.lane; { const f32x4 xh = (v[j] - mean) * rstd; v[j] = xh * *(const GAS f32x4*)(sc + c) + (xh + *(const GAS f32x4*)(sh + c)); }
                v2u o; o.x = pk2(v[j].x, v[j].y); o.y = pk2(v[j].z, v[j].w); *(GAS v2u*)(XN + (size_t)row * D + c) = o; }
            if (ROUTE) {
                float lgt[8];
#pragma unroll
                for (int e = 0; e < 8; ++e) lgt[e] = 0.f;
#pragma unroll
                for (int j = 0; j < 4; ++j)
#pragma unroll
                    for (int q = 0; q < 4; ++q) { const f32x4 w0 = wr[(4 * j + q) * 2], w1 = wr[(4 * j + q) * 2 + 1]; const float hv = v[j][q];
                        lgt[0] += hv * w0.x; lgt[1] += hv * w0.y; lgt[2] += hv * w0.z; lgt[3] += hv * w0.w; lgt[4] += hv * w1.x; lgt[5] += hv * w1.y; lgt[6] += hv * w1.z; lgt[7] += hv * w1.w; }
#pragma unroll
                for (int e = 0; e < 8; ++e) lgt[e] = wave_sum(lgt[e]);
                int e0 = 0; float l0 = lgt[0];
#pragma unroll
                for (int e = 1; e < 8; ++e) if (lgt[e] > l0) { l0 = lgt[e]; e0 = e; }
                int e1 = -1; float l1 = -3.0e38f;
#pragma unroll
                for (int e = 0; e < 8; ++e) if (e != e0 && lgt[e] > l1) { l1 = lgt[e]; e1 = e; }
                const float p0 = 1.f / (1.f + __expf(l1 - l0));
                int q0 = 0, q1 = 0;
#pragma unroll
                for (int e = 0; e < 8; ++e) { q0 = e == e0 ? rc[e] : q0; q1 = e == e1 ? rc[e] : q1; rc[e] += (e == e0 || e == e1) ? 1 : 0; }
                if (F.lane == 0) { int* ep = WSP(int, MOE_EPOS) + 4 * row;
                    *(GAS v4u*)ep = (v4u){(unsigned)e0, (unsigned)e1, (unsigned)q0, (unsigned)q1};
                    *(GAS v2u*)(mprob + 2 * row) = (v2u){__builtin_bit_cast(unsigned, p0), __builtin_bit_cast(unsigned, 1.f - p0)}; }
            }
        }
    }
    if (ROUTE) { if (F.lane == 0) { int* T = WSP(int, MOE_CNT) + 8 * gw;
        *(GAS v4u*)T = (v4u){(unsigned)rc[0], (unsigned)rc[1], (unsigned)rc[2], (unsigned)rc[3]}; *(GAS v4u*)(T + 4) = (v4u){(unsigned)rc[4], (unsigned)rc[5], (unsigned)rc[6], (unsigned)rc[7]}; } }
}
__device__ __forceinline__ void p_moe_gather(Frame& F, const Args& a) {
    const int gw = F.bid * NWAVES + F.wave, NGW = F.G * NWAVES; const int* T = WSP(int, MOE_CNT);
    LAS float* red = (LAS float*)(F.lds + RING_OFF);
    {   float al[8];
#pragma unroll
        for (int e = 0; e < 8; ++e) al[e] = 0.f;
        for (int w = F.tid; w < NGW; w += NTHR) { const v4u t0 = *(const GAS v4u*)(T + 8 * w), t1 = *(const GAS v4u*)(T + 8 * w + 4);
#pragma unroll
            for (int e = 0; e < 4; ++e) { al[e] += (float)t0[e]; al[4 + e] += (float)t1[e]; } }
#pragma unroll
        for (int e = 0; e < 8; ++e) al[e] = wave_sum(al[e]);
        if (F.lane == 0) {
#pragma unroll
            for (int e = 0; e < 8; ++e) red[F.wave * 16 + e] = al[e]; }
    }
    {   float pb[8];
#pragma unroll
        for (int e = 0; e < 8; ++e) pb[e] = 0.f;
        for (int w = F.tid; w < F.bid * NWAVES; w += NTHR) { const v4u t0 = *(const GAS v4u*)(T + 8 * w), t1 = *(const GAS v4u*)(T + 8 * w + 4);
#pragma unroll
            for (int e = 0; e < 4; ++e) { pb[e] += (float)t0[e]; pb[4 + e] += (float)t1[e]; } }
#pragma unroll
        for (int e = 0; e < 8; ++e) pb[e] = wave_sum(pb[e]);
        if (F.lane == 0) {
#pragma unroll
            for (int e = 0; e < 8; ++e) red[F.wave * 16 + 8 + e] = pb[e]; }
    }
    __syncthreads();
    int off[9], base[8]; off[0] = 0;
#pragma unroll
    for (int e = 0; e < 8; ++e) { float ta = 0.f, tp = 0.f;
#pragma unroll
        for (int w = 0; w < 8; ++w) { ta += red[w * 16 + e]; tp += red[w * 16 + 8 + e]; }
        const int c = (int)ta; off[e + 1] = off[e] + ((c + 255) & ~255); base[e] = (int)tp; }
    for (int w = 0; w < F.wave; ++w) { const int* Tw = T + 8 * (F.bid * NWAVES + w);
#pragma unroll
        for (int e = 0; e < 8; ++e) base[e] += Tw[e]; }
    __syncthreads();
    int* meta = WSP(int, MOE_META);
    if (F.bid == 0) { if (F.tid == 0) meta[0] = off[8] >> 8;
        for (int t = F.tid; t < (off[8] >> 8); t += NTHR) { int e = 0;
#pragma unroll
            for (int q = 1; q < 8; ++q) if (t * 256 >= off[q]) e = q;
            meta[16 + t] = e; } }
    const bf16* XN = WSP(bf16, WS_XN); bf16* AP = WSP(bf16, WS_APERM); int* mslot = WSP(int, MOE_SLOT);
    for (int row = gw; row < MREAL; row += NGW) {
        const int* ep = WSP(int, MOE_EPOS) + 4 * row; const int e0 = ep[0], e1 = ep[1];
        int o0 = 0, o1 = 0;
#pragma unroll
        for (int q = 0; q < 8; ++q) { if (q == e0) o0 = off[q] + base[q]; if (q == e1) o1 = off[q] + base[q]; }
        const int s0 = o0 + ep[2], s1 = o1 + ep[3];
        if (F.lane == 0) { mslot[2 * row] = s0; mslot[2 * row + 1] = s1; }
        const v4u x0 = *(const GAS v4u*)(XN + (size_t)row * D + 8 * F.lane), x1 = *(const GAS v4u*)(XN + (size_t)row * D + 512 + 8 * F.lane);
        *(GAS v4u*)(AP + (size_t)s0 * D + 8 * F.lane) = x0; *(GAS v4u*)(AP + (size_t)s0 * D + 512 + 8 * F.lane) = x1;
        *(GAS v4u*)(AP + (size_t)s1 * D + 8 * F.lane) = x0; *(GAS v4u*)(AP + (size_t)s1 * D + 512 + 8 * F.lane) = x1;
    }
}

struct EpiIn {
    static constexpr bool PERM = true, AFTER_DRAIN = false, CHAIN = false;
    bf16* P; float* SC; float* out; int l;
    __device__ __forceinline__ void mid(const pg8::f32x4 (&)[2][2][4][2], const pg8::Unit&, int, int, int, int) const {}
    __device__ __forceinline__ void operator()(const pg8::f32x4 (&acc)[2][2][4][2], const pg8::Unit& u, int wr, int wc, int fr, int fq) const {
        asm volatile("" : "+v"(fr), "+v"(fq));
        const int pn = u.pn; const int colb = pn * 256 + wc * 32 + 8 * fq;
#pragma unroll
        for (int ai = 0; ai < 2; ++ai)
#pragma unroll
            for (int m = 0; m < 4; ++m) {
                const int row = u.pm * 256 + ai * 128 + wr * 64 + m * 16 + fr;
                if (pn >= 13 && pn <= 20) {
                    float r[8], sb[8];
#pragma unroll
                    for (int n = 0; n < 2; ++n)
#pragma unroll
                        for (int q = 0; q < 4; ++q) { const float ea = __expf(-acc[ai][0][m][n][q]), eb = __expf(-acc[ai][1][m][n][q]); sb[4 * n + q] = 1.f / (1.f + eb); r[4 * n + q] = (1.f + eb) / (1.f + ea); }
                    v4u w; w.x = pk2(r[0], r[1]); w.y = pk2(r[2], r[3]); w.z = pk2(r[4], r[5]); w.w = pk2(r[6], r[7]); *(GAS v4u*)(P + (size_t)row * NINP + colb) = w;
                    w.x = pk2(sb[0], sb[1]); w.y = pk2(sb[2], sb[3]); w.z = pk2(sb[4], sb[5]); w.w = pk2(sb[6], sb[7]); *(GAS v4u*)(P + (size_t)row * NINP + colb + 128) = w;
                    continue;
                }
#pragma unroll
                for (int bj = 0; bj < 2; ++bj) {
                    const int col = colb + bj * 128; const pg8::f32x4 v0 = acc[ai][bj][m][0], v1 = acc[ai][bj][m][1];
                    v4u w; w.x = pk2(v0[0], v0[1]); w.y = pk2(v0[2], v0[3]); w.z = pk2(v1[0], v1[1]); w.w = pk2(v1[2], v1[3]);
                    *(GAS v4u*)(P + (size_t)row * NINP + col) = w;
                    float* dst = nullptr;
                    if (pn >= 10 && pn <= 12) {
                        const int c = col - pn * 256;
                        if (pn == 12) { if (row < MP) { const int t = row & (SEQ - 1); if (t >= SEQ - WINDOW) dst = out + O_WIN_P + ((size_t)(l * 2 + (row >> 13)) * WINDOW + (t - (SEQ - WINDOW))) * KVW + c; }
                                        else if (row < MREAL) dst = out + O_WIN_S + ((size_t)(l * MS + (row - MP)) * WINDOW + (WINDOW - 1)) * KVW + c; }
                        else { const size_t op = pn == 10 ? O_CMP_P : O_SLC_P, os = pn == 10 ? O_CMP_S : O_SLC_S;
                               if (row < MP) dst = out + op + ((size_t)l * MP + row) * KVW + c; else if (row < MREAL) dst = out + os + (size_t)(l * MS + (row - MP)) * KVW + c; }
                    } else if (pn < 6) {
                        if (row < MP) { const int t = row & (SEQ - 1); if (t >= SEQ - 3) dst = out + O_CONV_P + ((size_t)(l * 2 + (row >> 13)) * 3 + (t - (SEQ - 3))) * CQKV + col; }
                        else if (row < MREAL) dst = out + O_CONV_S + ((size_t)(l * MS + (row - MP)) * 3 + 2) * CQKV + col;
                    } else if (pn == 21) {
                        if (wc == 0 && bj == 0) dst = SC + (size_t)row * 32 + 8 * fq;
                    }
                    if (dst) { *(GAS pg8::f32x4*)dst = v0; *(GAS pg8::f32x4*)(dst + 4) = v1; }
                }
            }
    }
};
constexpr size_t GDN_REC = WS_GDN, GDN_UT = WS_GDN + 56 * MiB, GDN_OT = WS_GDN + 72 * MiB, GDN_GL = WS_GDN + 104 * MiB;
constexpr int REC_WN = 0, REC_QD = 8192, REC_KDT = 16384, REC_QK = 24576, REC_ELEMS = 28672;
__device__ __forceinline__ int kperm(int k) { return (k & ~31) | (((k >> 2) & 3) << 3) | (((k >> 4) & 1) << 2) | (k & 3); }

__device__ __forceinline__ void gdn_prep(Frame& F, const Args& a, int l) {
    LAS float* kq = (LAS float*)(F.lds + RING_OFF);
    LAS float* qq = kq + 64 * 132;
    LAS float* vv = qq + 64 * 132;
    LAS float* Am = vv + 64 * 128;
    LAS float* sv = Am + 64 * 64;
    const bf16* P = WSP(bf16, WS_P); const float* SC = WSP(float, WS_SC);
    const float* cw = INP(float, I_CONVW) + (size_t)l * 4 * CQKV;
    const int wave = F.wave;
#if defined(MK_GSEC)
#define GSEC(k) do { if (F.bid == 0 && F.tid == 0 && l == 0) { const unsigned t_ = (unsigned)__builtin_amdgcn_s_memrealtime(); if ((k) == MK_GSEC + 1) F.MISC[20] += t_ - F.MISC[22]; F.MISC[22] = t_; } } while (0)
#else
#define GSEC(k) do { } while (0)
#endif
    for (int unit = F.bid; unit < 8 * NCHUNK; unit += F.G) {
        int tid_l = F.tid, lane_l = F.lane; asm volatile("" : "+v"(tid_l), "+v"(lane_l));
        const int tid = tid_l, lane = lane_l;
        const int bh = unit >> 7, n = unit & 127, b = bh >> 2, h = bh & 3, t0 = n * CHUNK; const size_t row0 = (size_t)b * SEQ + t0;
        GSEC(0);
        if (tid < 384) {
            const int part = tid >> 7, j = tid & 127;
            const int c = (part == 0 ? 1024 : part == 1 ? 512 : 0) + h * 128 + j;
            const float w0 = cw[c], w1 = cw[CQKV + c], w2 = cw[2 * CQKV + c], w3 = cw[3 * CQKV + c];
            const bf16* pc = P + row0 * NINP + PC_QKV + c;
            float xm3 = 0.f, xm2 = 0.f, xm1 = 0.f;
            if (n > 0) { xm3 = bf2f(*(pc - 3 * (ptrdiff_t)NINP)); xm2 = bf2f(*(pc - 2 * (ptrdiff_t)NINP)); xm1 = bf2f(*(pc - (ptrdiff_t)NINP)); }
            LAS float* dstp = part == 0 ? vv + j : part == 1 ? kq + j : qq + j; const int dpitch = part == 0 ? 128 : 132;
            bf16 xa[16], xb[16];
#pragma unroll
            for (int j = 0; j < 16; ++j) xa[j] = pc[(size_t)j * NINP];
#pragma unroll
            for (int i0 = 0; i0 < 64; i0 += 32) {
#pragma unroll
                for (int j = 0; j < 16; ++j) xb[j] = pc[(size_t)(i0 + 16 + j) * NINP];
#pragma unroll
                for (int j = 0; j < 16; ++j) { const float x = bf2f(xa[j]); const float y = siluf_(w0 * xm3 + w1 * xm2 + w2 * xm1 + w3 * x); xm3 = xm2; xm2 = xm1; xm1 = x; dstp[(i0 + j) * dpitch] = y; }
                if (i0 + 32 < 64) {
#pragma unroll
                    for (int j = 0; j < 16; ++j) xa[j] = pc[(size_t)(i0 + 32 + j) * NINP]; }
#pragma unroll
                for (int j = 0; j < 16; ++j) { const float x = bf2f(xb[j]); const float y = siluf_(w0 * xm3 + w1 * xm2 + w2 * xm1 + w3 * x); xm3 = xm2; xm2 = xm1; xm1 = x; dstp[(i0 + 16 + j) * dpitch] = y; }
            }
        } else if (tid < 448) {
            const int i = tid - 384; const float* sc = SC + (row0 + i) * 32;
            const float beta = sigmoidf_(sc[h]); const float g = -__expf(INP(float, I_ALOG)[l * 4 + h]) * softplusf_(sc[4 + h] + INP(float, I_DTB)[l * 4 + h]);
            float gc = g;
#pragma unroll
            for (int o = 1; o < 64; o <<= 1) { const float t = bperm(gc, lane - o); if (lane >= o) gc += t; }
            sv[i] = beta; sv[64 + i] = gc; sv[128 + i] = __expf(gc);
        }
        __syncthreads(); GSEC(1);
#pragma unroll
        for (int r = 0; r < 8; ++r) { const int i = wave * 8 + r;
            { const float x0 = kq[i * 132 + lane], x1 = kq[i * 132 + 64 + lane]; const float inv = 1.f / sqrtf(wave_sum(x0 * x0 + x1 * x1) + 1e-6f); kq[i * 132 + lane] = x0 * inv; kq[i * 132 + 64 + lane] = x1 * inv; }
            { const float x0 = qq[i * 132 + lane], x1 = qq[i * 132 + 64 + lane]; const float inv = 1.f / sqrtf(wave_sum(x0 * x0 + x1 * x1) + 1e-6f); qq[i * 132 + lane] = x0 * inv; qq[i * 132 + 64 + lane] = x1 * inv; } }
        __syncthreads(); GSEC(2);
        {
            const int mat = wave >> 2, it4 = wave & 3, fr = lane & 15, fq = lane >> 4; const LAS float* L = mat ? qq : kq;
            bf16x8 bi[4];
#pragma unroll
            for (int ks = 0; ks < 4; ++ks) { const LAS float* p = L + (16 * it4 + fr) * 132 + 32 * ks + 8 * fq; const f32x4 x0 = *(const LAS f32x4*)p, x1 = *(const LAS f32x4*)(p + 4);
                v4u w; w.x = pk2(x0.x, x0.y); w.y = pk2(x0.z, x0.w); w.z = pk2(x1.x, x1.y); w.w = pk2(x1.z, x1.w); bi[ks] = __builtin_bit_cast(bf16x8, w); }
            const int i = 16 * it4 + fr; const float gci = sv[64 + i], bti = sv[i];
            bf16* QKg = WSP(bf16, GDN_REC) + (size_t)unit * REC_ELEMS + REC_QK;
#pragma unroll
            for (int jt = 0; jt < 4; ++jt) {
                f32x4 o = (f32x4){0.f, 0.f, 0.f, 0.f};
                if (jt <= it4) {
                    f32x4 acc = (f32x4){0.f, 0.f, 0.f, 0.f};
#pragma unroll
                    for (int ks = 0; ks < 4; ++ks) { const LAS float* p = kq + (16 * jt + fr) * 132 + 32 * ks + 8 * fq; const f32x4 x0 = *(const LAS f32x4*)p, x1 = *(const LAS f32x4*)(p + 4);
                        v4u w; w.x = pk2(x0.x, x0.y); w.y = pk2(x0.z, x0.w); w.z = pk2(x1.x, x1.y); w.w = pk2(x1.z, x1.w);
                        acc = __builtin_amdgcn_mfma_f32_16x16x32_bf16(__builtin_bit_cast(bf16x8, w), bi[ks], acc, 0, 0, 0); }
#pragma unroll
                    for (int r = 0; r < 4; ++r) { const int j = 16 * jt + 4 * fq + r; const float dec = __expf(gci - sv[64 + j]);
                        o[r] = mat ? ((i >= j) ? acc[r] * dec * 0.08838834764831845f : 0.f) : ((i > j) ? bti * acc[r] * dec : 0.f); }
                }
                if (mat == 0) {
#pragma unroll
                    for (int r = 0; r < 4; ++r) Am[(16 * jt + 4 * fq + r) * 64 + i] = o[r]; }
                else { v2u w; w.x = pk2(o[0], o[1]); w.y = pk2(o[2], o[3]); *(GAS v2u*)(QKg + i * 64 + kperm(16 * jt + 4 * fq)) = w; }
            }
        }
        __syncthreads(); GSEC(3);
        if (tid < 256) {
            float x[64]; int zv; asm volatile("v_mov_b32 %0, 0" : "=v"(zv));
            const LAS float* svz = sv + zv; const LAS float* Amz = Am + zv;
            if (tid < 128) {
#pragma unroll
                for (int i = 0; i < 64; ++i) x[i] = vv[i * 128 + tid] * svz[i];
            } else {
#pragma unroll
                for (int i = 0; i < 64; ++i) x[i] = kq[i * 132 + (tid - 128)] * svz[i] * svz[128 + i];
            }
#pragma unroll
            for (int j = 0; j < 63; ++j) {
                f32x4 ca[16];
#pragma unroll
                for (int g4 = (j + 1) / 4; g4 < 16; ++g4) ca[g4] = *(const LAS f32x4*)(Amz + j * 64 + 4 * g4);
                const float nxj = -x[j];
#pragma unroll
                for (int g4 = (j + 1) / 4; g4 < 16; ++g4) {
                    asm("v_fmac_f32 %0, %1, %2" : "+v"(x[4 * g4]) : "v"(ca[g4].x), "v"(nxj)); asm("v_fmac_f32 %0, %1, %2" : "+v"(x[4 * g4 + 1]) : "v"(ca[g4].y), "v"(nxj));
                    asm("v_fmac_f32 %0, %1, %2" : "+v"(x[4 * g4 + 2]) : "v"(ca[g4].z), "v"(nxj)); asm("v_fmac_f32 %0, %1, %2" : "+v"(x[4 * g4 + 3]) : "v"(ca[g4].w), "v"(nxj)); }
                asm volatile("" ::: "memory");
            }
            if (tid < 128) { bf16* UT = WSP(bf16, GDN_UT) + ((size_t)unit * 128 + tid) * 64;
#pragma unroll
                for (int i8 = 0; i8 < 8; ++i8) { v4u w; w.x = pk2(x[8 * i8], x[8 * i8 + 1]); w.y = pk2(x[8 * i8 + 2], x[8 * i8 + 3]); w.z = pk2(x[8 * i8 + 4], x[8 * i8 + 5]); w.w = pk2(x[8 * i8 + 6], x[8 * i8 + 7]); *(GAS v4u*)(UT + 8 * i8) = w; }
            } else { bf16* WN = WSP(bf16, GDN_REC) + (size_t)unit * REC_ELEMS + REC_WN + kperm(tid - 128);
#pragma unroll
                for (int i = 0; i < 64; ++i) WN[i * 128] = (bf16)f2bf(-x[i]);
            }
        } else {
            const int t = tid - 256; const float gl = sv[64 + 63];
            bf16* QD = WSP(bf16, GDN_REC) + (size_t)unit * REC_ELEMS + REC_QD; bf16* KDT = WSP(bf16, GDN_REC) + (size_t)unit * REC_ELEMS + REC_KDT;
            for (int it = t; it < 64 * 32; it += 256) { const int i = it >> 5, k4 = it & 31; const f32x4 q = *(const LAS f32x4*)(qq + i * 132 + 4 * k4) * (sv[128 + i] * 0.08838834764831845f);
                v2u w; w.x = pk2(q.x, q.y); w.y = pk2(q.z, q.w); *(GAS v2u*)(QD + i * 128 + kperm(4 * k4)) = w; }
            for (int it = t; it < 128 * 16; it += 256) { const int k = it & 127, c4 = it >> 7; float o[4];
#pragma unroll
                for (int y = 0; y < 4; ++y) { const int c = 4 * c4 + y; o[y] = kq[c * 132 + k] * __expf(gl - sv[64 + c]); }
                v2u w; w.x = pk2(o[0], o[1]); w.y = pk2(o[2], o[3]); *(GAS v2u*)(KDT + k * 64 + kperm(4 * c4)) = w; }
            if (t == 0) WSP(float, GDN_GL)[unit] = __expf(gl);
        }
        __syncthreads(); GSEC(4);
    }
#if defined(MK_GSEC)
    if (F.bid == 0 && F.tid == 0 && l == 0) { F.ctl[3200 + 2 * 50] = 0; F.ctl[3201 + 2 * 50] = 0; F.ctl[3200 + 2 * 51] = F.MISC[20]; F.ctl[3201 + 2 * 51] = 0; F.MISC[20] = 0; }
#endif
#undef GSEC
}

__device__ __forceinline__ void gdn_scan(Frame& F, const Args& a, int l, int unit) {
    constexpr int PW = 272, PK = 144;
    constexpr int B_WN = 0, B_QD = 64 * PW, B_KDT = 2 * 64 * PW, B_QK = B_KDT + 128 * PK, BUFB = B_QK + 64 * PK;
    static_assert(2 * BUFB + 4096 <= RING_BYTES, "scan LDS");
    const int bh = unit >> 2, dq = unit & 3;
    const int tid = F.tid, lane = F.lane, wave = F.wave, fr = lane & 15, fq = lane >> 4;
    const bf16* REC = WSP(bf16, GDN_REC) + (size_t)bh * 128 * REC_ELEMS;
    const bf16* UT = WSP(bf16, GDN_UT) + (size_t)bh * 128 * 8192; float* OT = WSP(float, GDN_OT) + (size_t)bh * 128 * 8192; const float* GL = WSP(float, GDN_GL) + bh * 128;
    if (wave >= 2) {
        const int lt = tid - 128;
        v4u st0[10], st1[10];
        int dsto[10];
#pragma unroll
        for (int q = 0; q < 10; ++q) { const int p = lt + 384 * q;
            dsto[q] = p < 1024 ? B_WN + (p >> 4) * PW + (p & 15) * 16 : p < 2048 ? B_QD + ((p - 1024) >> 4) * PW + (p & 15) * 16 : p < 3072 ? B_KDT + ((p - 2048) >> 3) * PK + (p & 7) * 16 : p < 3584 ? B_QK + ((p - 3072) >> 3) * PK + (p & 7) * 16 : -1; }
        const int lastp = (lt + 3456 < 3584 ? lt + 3456 : 3583) * 8;
#define GDN_SRC 1
#define GDN_DST 1
#define GDN_LOADR(st, nn) do { const bf16* rp_ = REC + (size_t)((nn) < NCHUNK ? (nn) : NCHUNK - 1) * REC_ELEMS; _Pragma("unroll") for (int q = 0; q < 9; ++q) st[q] = *(const GAS v4u*)(rp_ + (size_t)(lt + 384 * q) * 8); st[9] = *(const GAS v4u*)(rp_ + lastp); } while (0)
#define GDN_STORER(st, nn) do { const int bo_ = ((nn) & 1) * BUFB; _Pragma("unroll") for (int q = 0; q < 10; ++q) { const int off_ = dsto[q] >= 0 ? bo_ + dsto[q] : 2 * BUFB + lt * 16; *(LAS v4u*)(F.lds + RING_OFF + off_) = st[q]; } } while (0)
        GDN_LOADR(st0, 0); GDN_LOADR(st1, 1);
        GDN_STORER(st0, 0); GDN_LOADR(st0, 2);
        LBAR();
        for (int n = 0; n < NCHUNK; n += 2) {
            GDN_STORER(st1, n + 1); GDN_LOADR(st1, n + 3); LBAR();
            GDN_STORER(st0, n + 2); GDN_LOADR(st0, n + 4); LBAR();
        }
#undef GDN_SRC
#undef GDN_DST
#undef GDN_LOADR
#undef GDN_STORER
    } else {
        const int dvc = dq * 32 + wave * 16 + fr;
        f32x4 S[8];
#pragma unroll
        for (int T = 0; T < 8; ++T) S[T] = (f32x4){0.f, 0.f, 0.f, 0.f};
        v2u un[4]; float egn;
        { const bf16* up = UT + ((size_t)0 * 128 + dvc) * 64 + 4 * fq;
#pragma unroll
          for (int m = 0; m < 4; ++m) un[m] = *(const GAS v2u*)(up + 16 * m);
          egn = GL[0]; }
        LBAR();
        f32x4 aop[4];
#pragma unroll
        for (int m = 0; m < 4; ++m) aop[m] = (f32x4){0.f, 0.f, 0.f, 0.f};
#define GDN_FR8(dst, OFF0, PITCH, ROW0, K0) do { _Pragma("unroll") for (int q = 0; q < 4; ++q) { dst[q] = *(const LAS bf16x8*)(bb + (OFF0) + ((ROW0) + 16 * q + fr) * (PITCH) + ((K0) + 8 * fq) * 2); } } while (0)
#define SB() __builtin_amdgcn_sched_barrier(0)
        for (int n = 0; n < NCHUNK; ++n) {
            const LAS unsigned char* bb = F.lds + RING_OFF + (n & 1) * BUFB;
            f32x4 av[4], ao[4];
#pragma unroll
            for (int m = 0; m < 4; ++m) { av[m] = (f32x4){bflo(un[m].x), bfhi(un[m].x), bflo(un[m].y), bfhi(un[m].y)}; ao[m] = (f32x4){0.f, 0.f, 0.f, 0.f}; }
            const float egl = egn;
            if (n > 0) { float* op = OT + ((size_t)(n - 1) * 128 + dvc) * 64 + 4 * fq;
#pragma unroll
                for (int m = 0; m < 4; ++m) *(GAS f32x4*)(op + 16 * m) = aop[m]; }
            if (n + 1 < NCHUNK) { const bf16* up = UT + ((size_t)(n + 1) * 128 + dvc) * 64 + 4 * fq;
#pragma unroll
                for (int m = 0; m < 4; ++m) un[m] = *(const GAS v2u*)(up + 16 * m);
                egn = GL[n + 1]; }
            bf16x8 Bs[4];
#pragma unroll
            for (int kt = 0; kt < 4; ++kt) { v4u w; w.x = pk2(S[2 * kt][0], S[2 * kt][1]); w.y = pk2(S[2 * kt][2], S[2 * kt][3]); w.z = pk2(S[2 * kt + 1][0], S[2 * kt + 1][1]); w.w = pk2(S[2 * kt + 1][2], S[2 * kt + 1][3]); Bs[kt] = __builtin_bit_cast(bf16x8, w); }
            bf16x8 fw0[4], fq0[4], fw1[4], fq1[4], fw2[4], fq2[4];
            GDN_FR8(fw0, B_WN, PW, 0, 0); GDN_FR8(fq0, B_QD, PW, 0, 0); GDN_FR8(fw1, B_WN, PW, 0, 32); GDN_FR8(fq1, B_QD, PW, 0, 32); SB();
            GDN_FR8(fw2, B_WN, PW, 0, 64); GDN_FR8(fq2, B_QD, PW, 0, 64);
#pragma unroll
            for (int m = 0; m < 4; ++m) { av[m] = __builtin_amdgcn_mfma_f32_16x16x32_bf16(fw0[m], Bs[0], av[m], 0, 0, 0); ao[m] = __builtin_amdgcn_mfma_f32_16x16x32_bf16(fq0[m], Bs[0], ao[m], 0, 0, 0); }
            SB();
            GDN_FR8(fw0, B_WN, PW, 0, 96); GDN_FR8(fq0, B_QD, PW, 0, 96);
#pragma unroll
            for (int m = 0; m < 4; ++m) { av[m] = __builtin_amdgcn_mfma_f32_16x16x32_bf16(fw1[m], Bs[1], av[m], 0, 0, 0); ao[m] = __builtin_amdgcn_mfma_f32_16x16x32_bf16(fq1[m], Bs[1], ao[m], 0, 0, 0); }
            SB();
            GDN_FR8(fw1, B_QK, PK, 0, 0); GDN_FR8(fq1, B_QK, PK, 0, 32);
#pragma unroll
            for (int m = 0; m < 4; ++m) { av[m] = __builtin_amdgcn_mfma_f32_16x16x32_bf16(fw2[m], Bs[2], av[m], 0, 0, 0); ao[m] = __builtin_amdgcn_mfma_f32_16x16x32_bf16(fq2[m], Bs[2], ao[m], 0, 0, 0); }
            SB();
            GDN_FR8(fw2, B_KDT, PK, 0, 0); GDN_FR8(fq2, B_KDT, PK, 64, 0);
#pragma unroll
            for (int m = 0; m < 4; ++m) { av[m] = __builtin_amdgcn_mfma_f32_16x16x32_bf16(fw0[m], Bs[3], av[m], 0, 0, 0); ao[m] = __builtin_amdgcn_mfma_f32_16x16x32_bf16(fq0[m], Bs[3], ao[m], 0, 0, 0); }
            SB();
            bf16x8 Bv[2];
#pragma unroll
            for (int kc = 0; kc < 2; ++kc) { v4u w; w.x = pk2(av[2 * kc][0], av[2 * kc][1]); w.y = pk2(av[2 * kc][2], av[2 * kc][3]); w.z = pk2(av[2 * kc + 1][0], av[2 * kc + 1][1]); w.w = pk2(av[2 * kc + 1][2], av[2 * kc + 1][3]); Bv[kc] = __builtin_bit_cast(bf16x8, w); }
            GDN_FR8(fw0, B_KDT, PK, 0, 32); GDN_FR8(fq0, B_KDT, PK, 64, 32);
#pragma unroll
            for (int m = 0; m < 4; ++m) { ao[m] = __builtin_amdgcn_mfma_f32_16x16x32_bf16(fw1[m], Bv[0], ao[m], 0, 0, 0); ao[m] = __builtin_amdgcn_mfma_f32_16x16x32_bf16(fq1[m], Bv[1], ao[m], 0, 0, 0); }
#pragma unroll
            for (int T = 0; T < 8; ++T) S[T] = S[T] * egl;
            SB();
#pragma unroll
            for (int T = 0; T < 4; ++T) { S[T] = __builtin_amdgcn_mfma_f32_16x16x32_bf16(fw2[T], Bv[0], S[T], 0, 0, 0); S[4 + T] = __builtin_amdgcn_mfma_f32_16x16x32_bf16(fq2[T], Bv[0], S[4 + T], 0, 0, 0); }
#pragma unroll
            for (int T = 0; T < 4; ++T) { S[T] = __builtin_amdgcn_mfma_f32_16x16x32_bf16(fw0[T], Bv[1], S[T], 0, 0, 0); S[4 + T] = __builtin_amdgcn_mfma_f32_16x16x32_bf16(fq0[T], Bv[1], S[4 + T], 0, 0, 0); }
#pragma unroll
            for (int m = 0; m < 4; ++m) aop[m] = ao[m];
            LBAR();
        }
        { float* op = OT + ((size_t)(NCHUNK - 1) * 128 + dvc) * 64 + 4 * fq;
#pragma unroll
          for (int m = 0; m < 4; ++m) *(GAS f32x4*)(op + 16 * m) = aop[m]; }
#undef GDN_FR8
#undef SB
        float* od = a.out + O_DELTA_P + ((size_t)l * 8 + bh) * 128 * 128;
#pragma unroll
        for (int T = 0; T < 8; ++T)
#pragma unroll
            for (int i = 0; i < 4; ++i) od[(size_t)(16 * T + 4 * fq + i) * 128 + dvc] = S[T][i];
    }
}

__device__ __forceinline__ void gdn_sample(Frame& F, const Args& a, int l, int unit) {
    LAS float* sq = (LAS float*)(F.lds + RING_OFF); LAS float* sk = sq + 128; LAS float* svv = sk + 128; LAS float* red = svv + 128;
    LAS float* misc = red + 512;
    const int tid = F.tid, b = unit >> 2, h = unit & 3; const size_t row = MP + b;
    const bf16* P = WSP(bf16, WS_P); const float* SC = WSP(float, WS_SC);
    if (tid < 384) {
        const int part = tid >> 7, j = tid & 127; const int c = (part == 0 ? 0 : part == 1 ? 512 : 1024) + h * 128 + j;
        const float* cw = INP(float, I_CONVW) + (size_t)l * 4 * CQKV; const float* sb = INP(float, I_SCONV) + ((size_t)(l * MS + b) * 3) * CQKV + c;
        const float y = siluf_(cw[c] * sb[0] + cw[CQKV + c] * sb[CQKV] + cw[2 * CQKV + c] * sb[2 * CQKV] + cw[3 * CQKV + c] * bf2f(P[row * NINP + PC_QKV + c]));
        (part == 0 ? sq : part == 1 ? sk : svv)[j] = y;
    }
    __syncthreads();
    if (F.wave < 2) { LAS float* p = F.wave == 0 ? sq : sk; const float x0 = p[F.lane], x1 = p[64 + F.lane]; const float inv = 1.f / sqrtf(wave_sum(x0 * x0 + x1 * x1) + 1e-6f); p[F.lane] = x0 * inv; p[64 + F.lane] = x1 * inv; }
    __syncthreads();
    const float beta = sigmoidf_(SC[row * 32 + h]); const float eg = __expf(-__expf(INP(float, I_ALOG)[l * 4 + h]) * softplusf_(SC[row * 32 + 4 + h] + INP(float, I_DTB)[l * 4 + h]));
    const int dv = tid & 127, ks = tid >> 7;
    const float* S0 = INP(float, I_SDELTA) + ((size_t)(l * MS + b) * 4 + h) * 128 * 128;
    float sreg[32]; float part = 0.f;
#pragma unroll
    for (int i = 0; i < 32; ++i) { sreg[i] = S0[(size_t)(ks * 32 + i) * 128 + dv]; part += sk[ks * 32 + i] * sreg[i]; }
    red[ks * 128 + dv] = part;
    __syncthreads();
    const float kS = red[dv] + red[128 + dv] + red[256 + dv] + red[384 + dv];
    const float vn = beta * (svv[dv] - eg * kS);
    __syncthreads();
    float* od = a.out + O_DELTA_S + ((size_t)(l * MS + b) * 4 + h) * 128 * 128; float po = 0.f;
#pragma unroll
    for (int i = 0; i < 32; ++i) { const float sn = eg * sreg[i] + sk[ks * 32 + i] * vn; od[(size_t)(ks * 32 + i) * 128 + dv] = sn; po += sq[ks * 32 + i] * sn; }
    red[ks * 128 + dv] = po;
    __syncthreads();
    if (tid < 128) { const float o = (red[dv] + red[128 + dv] + red[256 + dv] + red[384 + dv]) * 0.08838834764831845f; misc[dv] = o; }
    __syncthreads();
    if (F.wave == 0) { const float o0 = misc[F.lane], o1 = misc[64 + F.lane]; const float r = 1.f / sqrtf(wave_sum(o0 * o0 + o1 * o1) * (1.f / 128.f) + LN_EPS);
        bf16* OA = WSP(bf16, WS_OAB) + row * 512 + h * 128; const float* nw = INP(float, I_NORMW) + l * 128;
        const float z0 = bf2f(P[row * NINP + PC_Z + h * 128 + F.lane]), z1 = bf2f(P[row * NINP + PC_Z + h * 128 + 64 + F.lane]);
        OA[F.lane] = (bf16)f2bf(o0 * r * nw[F.lane] * siluf_(z0)); OA[64 + F.lane] = (bf16)f2bf(o1 * r * nw[64 + F.lane] * siluf_(z1)); }
    __syncthreads();
}

__device__ __forceinline__ void gdn_onorm(Frame& F, const Args& a, int l) {
    LAS float* tile = (LAS float*)(F.lds + RING_OFF);
    const bf16* P = WSP(bf16, WS_P); const float* nw = INP(float, I_NORMW) + l * 128;
    for (int unit = F.bid; unit < 8 * NCHUNK; unit += F.G) {
        const int bh = unit >> 7, n = unit & 127, b = bh >> 2, h = bh & 3; const size_t row0 = (size_t)b * SEQ + n * CHUNK;
        const float* src = WSP(float, GDN_OT) + (size_t)unit * 8192;
        { float tv[16];
#pragma unroll
          for (int q = 0; q < 16; ++q) tv[q] = src[F.tid + q * NTHR];
#pragma unroll
          for (int q = 0; q < 16; ++q) { const int i = F.tid + q * NTHR; tile[(i >> 6) * 65 + (i & 63)] = tv[q]; } }
        __syncthreads();
        const int c = F.tid >> 3, part = F.tid & 7;
        float v[16]; float ss = 0.f;
#pragma unroll
        for (int i = 0; i < 16; ++i) { v[i] = tile[(part * 16 + i) * 65 + c]; ss += v[i] * v[i]; }
        ss += shx<1>(ss); ss += shx<2>(ss); ss += shx<4>(ss);
        const float r = 1.f / sqrtf(ss * (1.f / 128.f) + LN_EPS);
        const bf16* zp = P + (row0 + c) * NINP + PC_Z + h * 128 + part * 16; bf16* op = WSP(bf16, WS_OAB) + (row0 + c) * 512 + h * 128 + part * 16;
        const v4u z0 = *(const GAS v4u*)zp, z1 = *(const GAS v4u*)(zp + 8); const unsigned zz[8] = {z0.x, z0.y, z0.z, z0.w, z1.x, z1.y, z1.z, z1.w};
        unsigned o[8];
#pragma unroll
        for (int i = 0; i < 8; ++i) { const float a0 = v[2 * i] * r * nw[part * 16 + 2 * i] * siluf_(bflo(zz[i])), a1 = v[2 * i + 1] * r * nw[part * 16 + 2 * i + 1] * siluf_(bfhi(zz[i])); o[i] = pk2(a0, a1); }
        *(GAS v4u*)op = (v4u){o[0], o[1], o[2], o[3]}; *(GAS v4u*)(op + 8) = (v4u){o[4], o[5], o[6], o[7]};
        __syncthreads();
    }
}
struct EpiUp {
    static constexpr bool PERM = true, AFTER_DRAIN = false, CHAIN = true;
    const bf16* P; bf16* U;
    template <bool FINAL> __device__ __forceinline__ void run(pg8::f32x4 (&acc)[2][2][4][2], const pg8::Unit& u, int wr, int wc, int fr, int fq) const {
        asm volatile("" : "+v"(fr), "+v"(fq));
#pragma unroll
        for (int ai = 0; ai < 2; ++ai)
#pragma unroll
            for (int m = 0; m < 4; ++m) {
                const size_t row = (size_t)u.pm * 256 + ai * 128 + wr * 64 + m * 16 + fr;
#pragma unroll
                for (int bj = 0; bj < 2; ++bj) {
                    const int j = wc * 32 + 8 * fq;
                    const v4u g = *(const GAS v4u*)(P + row * NINP + PC_GM + 256 * (2 * u.pn + bj) + (FINAL ? 128 : 0) + j);
                    pg8::f32x4 v0 = acc[ai][bj][m][0], v1 = acc[ai][bj][m][1];
                    v0[0] *= bflo(g.x); v0[1] *= bfhi(g.x); v0[2] *= bflo(g.y); v0[3] *= bfhi(g.y); v1[0] *= bflo(g.z); v1[1] *= bfhi(g.z); v1[2] *= bflo(g.w); v1[3] *= bfhi(g.w);
                    if (FINAL) { v4u w; w.x = pk2(v0[0], v0[1]); w.y = pk2(v0[2], v0[3]); w.z = pk2(v1[0], v1[1]); w.w = pk2(v1[2], v1[3]); *(GAS v4u*)(U + row * D + u.pn * 256 + bj * 128 + j) = w; }
                    else { acc[ai][bj][m][0] = v0; acc[ai][bj][m][1] = v1; }
                }
                asm volatile("" ::: "memory");
            }
    }
    __device__ __forceinline__ void mid(pg8::f32x4 (&acc)[2][2][4][2], const pg8::Unit& u, int wr, int wc, int fr, int fq) const { run<false>(acc, u, wr, wc, fr, fq); }
    __device__ __forceinline__ void operator()(pg8::f32x4 (&acc)[2][2][4][2], const pg8::Unit& u, int wr, int wc, int fr, int fq) const { run<true>(acc, u, wr, wc, fr, fq); }
};
struct ChainOrder {
    int G, c;
    __device__ bool next(int i, pg8::Unit& u) const {
        const int L = i * G + c; if (L >= 64 * 4) return false;
        u.pm = L & 63; u.pn = L >> 6; u.am = u.pm; u.bn = u.pn; u.am2 = u.pm + NTILE_M; u.bn2 = u.pn + 4; return true;
    }
    __device__ __forceinline__ void a_ready(const pg8::Unit&) const {}
    __device__ __forceinline__ void done(const pg8::Unit&) const {}
};
struct EpiY {
    static constexpr bool PERM = true, AFTER_DRAIN = false, CHAIN = false;
    bf16* Y;
    __device__ __forceinline__ void mid(const pg8::f32x4 (&)[2][2][4][2], const pg8::Unit&, int, int, int, int) const {}
    __device__ __forceinline__ void operator()(const pg8::f32x4 (&acc)[2][2][4][2], const pg8::Unit& u, int wr, int wc, int fr, int fq) const {
        asm volatile("" : "+v"(fr), "+v"(fq));
        const int colb = u.pn * 256 + wc * 32 + 8 * fq;
#pragma unroll
        for (int ai = 0; ai < 2; ++ai)
#pragma unroll
            for (int m = 0; m < 4; ++m) { bf16* rp = Y + ((size_t)u.pm * 256 + ai * 128 + wr * 64 + m * 16 + fr) * D + colb;
#pragma unroll
                for (int bj = 0; bj < 2; ++bj) { const pg8::f32x4 v0 = acc[ai][bj][m][0], v1 = acc[ai][bj][m][1];
                    v4u w; w.x = pk2(v0[0], v0[1]); w.y = pk2(v0[2], v0[3]); w.z = pk2(v1[0], v1[1]); w.w = pk2(v1[2], v1[3]); *(GAS v4u*)(rp + bj * 128) = w; } }
    }
};
struct EpiSwiglu {
    static constexpr bool PERM = true, AFTER_DRAIN = false, CHAIN = false;
    bf16* ACT;
    __device__ __forceinline__ void mid(const pg8::f32x4 (&)[2][2][4][2], const pg8::Unit&, int, int, int, int) const {}
    __device__ __forceinline__ void operator()(const pg8::f32x4 (&acc)[2][2][4][2], const pg8::Unit& u, int wr, int wc, int fr, int fq) const {
        asm volatile("" : "+v"(fr), "+v"(fq));
        const int col = u.pn * 128 + wc * 32 + 8 * fq;
#pragma unroll
        for (int ai = 0; ai < 2; ++ai)
#pragma unroll
            for (int m = 0; m < 4; ++m) { bf16* rp = ACT + ((size_t)u.pm * 256 + ai * 128 + wr * 64 + m * 16 + fr) * DFF + col;
                float o[8];
#pragma unroll
                for (int n = 0; n < 2; ++n)
#pragma unroll
                    for (int q = 0; q < 4; ++q) { const float g = acc[ai][0][m][n][q]; o[4 * n + q] = g / (1.f + __expf(-g)) * acc[ai][1][m][n][q]; }
                v4u w; w.x = pk2(o[0], o[1]); w.y = pk2(o[2], o[3]); w.z = pk2(o[4], o[5]); w.w = pk2(o[6], o[7]); *(GAS v4u*)rp = w; }
    }
};
template <int nN> struct MoeOrder {
    int G, c; const int* meta;
    __device__ bool next(int i, pg8::Unit& u) const {
        const int L = i * G + c, nt = __builtin_amdgcn_readfirstlane(meta[0]); if (L >= nt * nN) return false;
        u.pm = L / nN; u.pn = L % nN; u.am = u.pm; u.bn = __builtin_amdgcn_readfirstlane(meta[16 + u.pm]) * nN + u.pn; u.am2 = 0; u.bn2 = 0; return true;
    }
    __device__ __forceinline__ void a_ready(const pg8::Unit&) const {}
    __device__ __forceinline__ void done(const pg8::Unit&) const {}
};
template <int MODE> __device__ __forceinline__ void gemm_rows32(Frame& F, const Args& a, int nt16, const bf16* A, int lda, const bf16* Bt, int K, const bf16* A2, const bf16* Bt2, bf16* Y, bf16* U) {
    LAS float* red = (LAS float*)(F.lds + RING_OFF);
    const int lane = F.lane, wave = F.wave, fr = lane & 15, fq = lane >> 4, n0 = nt16 * 16;
    f32x4 acc[2] = {(f32x4){0.f, 0.f, 0.f, 0.f}, (f32x4){0.f, 0.f, 0.f, 0.f}};
    { const int nst = K / 32, per = (nst + 7) / 8, s0 = wave * per, s1 = s0 + per < nst ? s0 + per : nst;
      for (int s = s0; s < s1; ++s) { const int k0 = 32 * s + 8 * fq;
          const bf16x8 b = *(const GAS bf16x8*)(Bt + (size_t)(n0 + fr) * K + k0), a0 = *(const GAS bf16x8*)(A + (size_t)fr * lda + k0), a1 = *(const GAS bf16x8*)(A + (size_t)(16 + fr) * lda + k0);
          acc[0] = __builtin_amdgcn_mfma_f32_16x16x32_bf16(a0, b, acc[0], 0, 0, 0); acc[1] = __builtin_amdgcn_mfma_f32_16x16x32_bf16(a1, b, acc[1], 0, 0, 0); } }
    const int col = n0 + fr;
    if (MODE == 1) {
        const bf16* P = WSP(bf16, WS_P);
#pragma unroll
        for (int mt = 0; mt < 2; ++mt)
#pragma unroll
            for (int i = 0; i < 4; ++i) { const size_t row = MP + 16 * mt + 4 * fq + i; acc[mt][i] *= bf2f(P[row * NINP + PC_GM + 256 * (col >> 7) + (col & 127)]); }
        const int nst = K / 32, per = (nst + 7) / 8, s0 = wave * per, s1 = s0 + per < nst ? s0 + per : nst;
        for (int s = s0; s < s1; ++s) { const int k0 = 32 * s + 8 * fq;
            const bf16x8 b = *(const GAS bf16x8*)(Bt2 + (size_t)(n0 + fr) * K + k0), a0 = *(const GAS bf16x8*)(A2 + (size_t)fr * lda + k0), a1 = *(const GAS bf16x8*)(A2 + (size_t)(16 + fr) * lda + k0);
            acc[0] = __builtin_amdgcn_mfma_f32_16x16x32_bf16(a0, b, acc[0], 0, 0, 0); acc[1] = __builtin_amdgcn_mfma_f32_16x16x32_bf16(a1, b, acc[1], 0, 0, 0); }
    }
    *(LAS f32x4*)(red + ((wave * 2 + 0) * 64 + lane) * 4) = acc[0]; *(LAS f32x4*)(red + ((wave * 2 + 1) * 64 + lane) * 4) = acc[1];
    __syncthreads();
    if (wave < 2) { f32x4 s = (f32x4){0.f, 0.f, 0.f, 0.f};
#pragma unroll
        for (int w = 0; w < 8; ++w) s += *(const LAS f32x4*)(red + ((w * 2 + wave) * 64 + lane) * 4);
#pragma unroll
        for (int i = 0; i < 4; ++i) { const size_t row = MP + 16 * wave + 4 * fq + i;
            if (MODE == 1) { const float gb = bf2f(WSP(bf16, WS_P)[row * NINP + PC_GM + 256 * (col >> 7) + 128 + (col & 127)]); U[row * D + col] = (bf16)f2bf(s[i] * gb); }
            else Y[row * D + col] = (bf16)f2bf(s[i]); } }
    __syncthreads();
}
constexpr size_t NSA_VSLT = WS_NSA, NSA_VWT = WS_NSA + 4 * MiB, NSA_KC = WS_NSA + 8 * MiB, NSA_VCT = WS_NSA + 9 * MiB, NSA_CVEC = WS_NSA + 10 * MiB, NSA_KSL = WS_NSA + 12 * MiB, NSA_KW = WS_NSA + 16 * MiB;
constexpr size_t SMP_SEG = WS_SMP, SMP_HP = WS_SMP + 272 * MiB, SMP_KCS = WS_SMP + 340 * MiB, SMP_VCS = WS_SMP + 348 * MiB;
constexpr int SEGROWS = 34816, SEGTILES = 136;
static_assert(SMP_VCS + 8 * MiB <= WS_END, "ws map");
__device__ __forceinline__ int kperm_inv(int p) { return (p & ~31) | (((p >> 2) & 1) << 4) | (((p >> 3) & 3) << 2) | (p & 3); }

__device__ __forceinline__ void nsa_prologue(Frame& F, const Args& a) {
    const int NGW = F.G * NWAVES, gw = F.bid * NWAVES + F.wave;
    for (int wv = NGW - 1 - gw; wv < 256; wv += NGW) { const int q = wv >> 6, col = (wv & 63) * 4 + (F.lane & 3), ks = F.lane >> 2;
        const float* pos = INP(float, I_CPOS) + (size_t)q * 2048 + ks * 128; const float* w1 = INP(float, I_CW1) + ((size_t)q * 2048 + ks * 128) * 256 + col; float acc = 0.f;
#pragma unroll 16
        for (int i = 0; i < 128; ++i) acc += pos[i] * w1[(size_t)i * 256];
        acc += shx<4>(acc); acc += shx<8>(acc); acc += shx<16>(acc); acc += shx<32>(acc);
        if (F.lane < 4) WSP(float, NSA_CVEC)[q * 256 + col] = acc; }
    for (int it = gw; it < MS * NPAGES; it += NGW) seg_page<8>(F, a, it);
}
template <int NR> __device__ __forceinline__ void seg_page(Frame& F, const Args& a, int it) {
    const int* pt = INP(int, I_PT); const int kv = F.lane >> 5, g = (F.lane >> 4) & 1, d4 = F.lane & 15;
    const int p = it & 63, b = (it >> 6) & 31, l = it >> 11;
    const int page = pt[b * NPAGES + p];
    const float* src = INP(float, I_CCMP) + (((size_t)l * NPOOL + page) * PAGE) * KVW + 4 * F.lane;
    bf16* dst0 = WSP(bf16, SMP_SEG) + (((size_t)(l * 2 + kv) * SEGROWS) + 2048 + (size_t)(b * 2 + g) * 512 + p * 8) * 1024 + 4 * d4;
    for (int r0 = 0; r0 < PAGE; r0 += NR) { f32x4 v[NR];
#pragma unroll
        for (int j = 0; j < NR; ++j) v[j] = *(const GAS f32x4*)(src + (size_t)(r0 + j) * KVW);
#pragma unroll
        for (int j = 0; j < NR; ++j) { const int r = r0 + j; v2u o; o.x = pk2(v[j].x, v[j].y); o.y = pk2(v[j].z, v[j].w); *(GAS v2u*)(dst0 + (size_t)(r >> 4) * 1024 + (r & 15) * 64) = o; } }
}
__device__ __forceinline__ void nsa_prep(Frame& F, const Args& a, int l) {
    const int NGW = F.G * NWAVES, gw = F.bid * NWAVES + F.wave; const bf16* P = WSP(bf16, WS_P);
    { const int kv = F.lane >> 5, g = (F.lane >> 4) & 1, d4 = F.lane & 15;
      for (int row = gw; row < MP; row += NGW) { const int b = row >> 13, t = row & (SEQ - 1);
          const v2u v = *(const GAS v2u*)(P + (size_t)row * NINP + PC_KVC + 4 * F.lane);
          *(GAS v2u*)(WSP(bf16, SMP_SEG) + (((size_t)(l * 2 + kv) * SEGROWS) + (size_t)(b * 2 + g) * 512 + (t >> 4)) * 1024 + (t & 15) * 64 + 4 * d4) = v; } }
    LAS bf16* tile = (LAS bf16*)(F.lds + RING_OFF + F.wave * 16384);
    for (int unit = gw; unit < 2 * 4 * 128; unit += NGW) {
        const int tb = unit & 127, bg = (unit >> 7) & 3, kind = unit >> 9, b = bg >> 1, g = bg & 1;
        const bf16* src = P + ((size_t)b * SEQ + tb * 64 + F.lane) * NINP + (kind ? PC_KVW : PC_KVS) + g * 64;
        bf16* kd = WSP(bf16, kind ? NSA_KW : NSA_KSL) + ((size_t)bg * SEQ + tb * 64 + F.lane) * 64;
#pragma unroll
        for (int q = 0; q < 8; ++q) { *(GAS v4u*)(kd + 8 * q) = *(const GAS v4u*)(src + 8 * q); *(LAS v4u*)(tile + F.lane * 72 + 8 * q) = *(const GAS v4u*)(src + 128 + 8 * q); }
        LDS_WAIT(); asm volatile("" ::: "memory");
        bf16* dst = WSP(bf16, kind ? NSA_VWT : NSA_VSLT) + ((size_t)bg * 128 + tb) * 4096 + F.lane; const int ts = kperm_inv(F.lane);
        for (int d = 0; d < 64; ++d) dst[d * 64] = tile[ts * 72 + d];
        LDS_WAIT(); asm volatile("" ::: "memory");
    }
}
struct CmpOrder {
    int G, c;
    __device__ bool next(int i, pg8::Unit& u) const {
        const int L = i * G + c; if (L >= 2 * SEGTILES * 2) return false;
        const int kv = L / (SEGTILES * 2), rem = L % (SEGTILES * 2); u.pn = rem / SEGTILES; u.pm = kv * SEGTILES + rem % SEGTILES; u.am = u.pm; u.bn = kv * 2 + u.pn; u.am2 = 0; u.bn2 = 0; return true;
    }
    __device__ __forceinline__ void a_ready(const pg8::Unit&) const {}
    __device__ __forceinline__ void done(const pg8::Unit&) const {}
};
struct EpiBf16P {
    static constexpr bool PERM = true, AFTER_DRAIN = false, CHAIN = false;
    bf16* O; int ld;
    __device__ __forceinline__ void mid(const pg8::f32x4 (&)[2][2][4][2], const pg8::Unit&, int, int, int, int) const {}
    __device__ __forceinline__ void operator()(const pg8::f32x4 (&acc)[2][2][4][2], const pg8::Unit& u, int wr, int wc, int fr, int fq) const {
        asm volatile("" : "+v"(fr), "+v"(fq));
        const int colb = u.pn * 256 + wc * 32 + 8 * fq;
#pragma unroll
        for (int ai = 0; ai < 2; ++ai)
#pragma unroll
            for (int m = 0; m < 4; ++m) { bf16* rp = O + ((size_t)u.pm * 256 + ai * 128 + wr * 64 + m * 16 + fr) * ld + colb;
#pragma unroll
                for (int bj = 0; bj < 2; ++bj) { const pg8::f32x4 v0 = acc[ai][bj][m][0], v1 = acc[ai][bj][m][1];
                    v4u w; w.x = pk2(v0[0], v0[1]); w.y = pk2(v0[2], v0[3]); w.z = pk2(v1[0], v1[1]); w.w = pk2(v1[2], v1[3]); *(GAS v4u*)(rp + bj * 128) = w; } }
    }
};
__device__ __forceinline__ void nsa_cmp2(Frame& F, const Args& a, int l) {
    constexpr int WP = 528;
    LAS unsigned char* w2t = F.lds + RING_OFF;
    const bf16* HP = WSP(bf16, SMP_HP); int kv_in_lds = -1;
    const int lane = F.lane, fr = lane & 15, fq = lane >> 4;
    for (int unit = F.bid; unit < (256 + 4096) / 8; unit += F.G) {
        const int gidx = unit * 8 + F.wave; int kv, bg, nb, smp;
        if (gidx < 256) { smp = 0; nb = gidx & 31; bg = (gidx >> 5) & 3; kv = gidx >> 7; } else { const int u2 = gidx - 256; smp = 1; nb = u2 & 31; bg = (u2 >> 5) & 63; kv = u2 >> 11; }
        const int kvb = __builtin_amdgcn_readfirstlane((unit * 8 < 256) ? (unit * 8) >> 7 : (unit * 8 - 256) >> 11);
        if (kvb != kv_in_lds) { __syncthreads();
            const float* w2 = INP(float, I_CW2) + (size_t)(l * 2 + kvb) * 256 * 64;
            for (int i = F.tid; i < 256 * 64; i += NTHR) { const int c = i >> 6, d = i & 63; *(LAS bf16*)(w2t + d * WP + c * 2) = (bf16)f2bf(w2[i]); }
            kv_in_lds = kvb; __syncthreads(); }
        const size_t R0 = (size_t)kv * SEGROWS + (smp ? 2048 : 0) + (size_t)bg * 512 + nb * 16;
        const float* cv = WSP(float, NSA_CVEC) + (l * 2 + kv) * 256;
        const int n = nb * 16 + fr;
        f32x4 acc[4] = {(f32x4){0.f, 0.f, 0.f, 0.f}, (f32x4){0.f, 0.f, 0.f, 0.f}, (f32x4){0.f, 0.f, 0.f, 0.f}, (f32x4){0.f, 0.f, 0.f, 0.f}};
        v4u x0[8], x1[8];
#pragma unroll
        for (int ks = 0; ks < 8; ++ks) { const int c = 32 * ks + 8 * fq; x0[ks] = *(const GAS v4u*)(HP + (R0 + fr) * 512 + c); x1[ks] = *(const GAS v4u*)(HP + (R0 + fr + 1) * 512 + 256 + c); }
#pragma unroll
        for (int ks = 0; ks < 8; ++ks) { const int c = 32 * ks + 8 * fq; const f32x4 c0 = *(const GAS f32x4*)(cv + c), c1 = *(const GAS f32x4*)(cv + c + 4);
            float h[8] = {bflo(x0[ks].x) + bflo(x1[ks].x) + c0.x, bfhi(x0[ks].x) + bfhi(x1[ks].x) + c0.y, bflo(x0[ks].y) + bflo(x1[ks].y) + c0.z, bfhi(x0[ks].y) + bfhi(x1[ks].y) + c0.w,
                          bflo(x0[ks].z) + bflo(x1[ks].z) + c1.x, bfhi(x0[ks].z) + bfhi(x1[ks].z) + c1.y, bflo(x0[ks].w) + bflo(x1[ks].w) + c1.z, bfhi(x0[ks].w) + bfhi(x1[ks].w) + c1.w};
#pragma unroll
            for (int q = 0; q < 8; ++q) h[q] = n < NCMP ? siluf_(h[q]) : 0.f;
            v4u w; w.x = pk2(h[0], h[1]); w.y = pk2(h[2], h[3]); w.z = pk2(h[4], h[5]); w.w = pk2(h[6], h[7]); const bf16x8 af = __builtin_bit_cast(bf16x8, w);
#pragma unroll
            for (int nt = 0; nt < 4; ++nt) { const bf16x8 bfr = *(const LAS bf16x8*)(w2t + (16 * nt + fr) * WP + (32 * ks + 8 * fq) * 2); acc[nt] = __builtin_amdgcn_mfma_f32_16x16x32_bf16(af, bfr, acc[nt], 0, 0, 0); } }
#pragma unroll
        for (int nt = 0; nt < 4; ++nt)
#pragma unroll
            for (int i = 0; i < 4; ++i) { const int nn = nb * 16 + 4 * fq + i, d = 16 * nt + fr; const float o = acc[nt][i];
                if (smp) WSP(float, kv ? SMP_VCS : SMP_KCS)[((size_t)bg * 512 + nn) * 64 + d] = o;
                else if (kv == 0) WSP(bf16, NSA_KC)[((size_t)bg * 512 + nn) * 64 + d] = (bf16)f2bf(o);
                else WSP(bf16, NSA_VCT)[((size_t)bg * 64 + d) * 512 + kperm(nn)] = (bf16)f2bf(o); }
    }
}
constexpr int AT_KB = 9216, AT_SLOT = 2 * AT_KB;
constexpr int AT_IMP = 3 * AT_SLOT;
constexpr int AT_SEL = AT_IMP + 8 * 4096;
constexpr float AT_C2 = 0.125f * 1.4426950408889634f;
struct AtStg { v4u k, v; };
__device__ __forceinline__ void at_load(AtStg& s, const bf16* kl, const bf16* vl) { s.k = *(const GAS v4u*)kl; s.v = *(const GAS v4u*)vl; }
__device__ __forceinline__ void at_store(const AtStg& s, LAS unsigned char* slot, int tid) {
    const int r = tid >> 3, c = (tid & 7) * 16;
    *(LAS v4u*)(slot + r * 144 + c) = s.k; *(LAS v4u*)(slot + AT_KB + r * 144 + c) = s.v;
}
#define AT_SB() __builtin_amdgcn_sched_barrier(0)
__device__ __forceinline__ void at_swap16(unsigned& a, unsigned& b) { asm volatile("s_nop 1\n\tv_permlane16_swap_b32 %0, %1" : "+v"(a), "+v"(b)); }
__device__ __forceinline__ void at_swap32(unsigned& a, unsigned& b) { asm volatile("s_nop 1\n\tv_permlane32_swap_b32 %0, %1" : "+v"(a), "+v"(b)); }
__device__ __forceinline__ float at_rmax(float v) { unsigned a = __builtin_bit_cast(unsigned, v), b = a; at_swap16(a, b);
    const float w = fmaxf(__builtin_bit_cast(float, a), __builtin_bit_cast(float, b)); unsigned c = __builtin_bit_cast(unsigned, w), d = c; at_swap32(c, d);
    return fmaxf(__builtin_bit_cast(float, c), __builtin_bit_cast(float, d)); }
__device__ __forceinline__ float at_rsum(float v) { unsigned a = __builtin_bit_cast(unsigned, v), b = a; at_swap16(a, b);
    const float w = __builtin_bit_cast(float, a) + __builtin_bit_cast(float, b); unsigned c = __builtin_bit_cast(unsigned, w), d = c; at_swap32(c, d);
    return __builtin_bit_cast(float, c) + __builtin_bit_cast(float, d); }
__device__ __forceinline__ void at_qk(f32x4 (&sc)[4][2], const LAS unsigned char* slot, const bf16x8 (&Qb)[2][2], int fr, int fq) {
    bf16x8 kf[4][2];
#pragma unroll
    for (int mt = 0; mt < 4; ++mt)
#pragma unroll
        for (int ks = 0; ks < 2; ++ks) kf[mt][ks] = *(const LAS bf16x8*)(slot + (16 * mt + fr) * 144 + (32 * ks + 8 * fq) * 2);
    AT_SB();
#pragma unroll
    for (int mt = 0; mt < 4; ++mt) { sc[mt][0] = (f32x4){0.f, 0.f, 0.f, 0.f}; sc[mt][1] = (f32x4){0.f, 0.f, 0.f, 0.f};
#pragma unroll
        for (int ks = 0; ks < 2; ++ks) { sc[mt][0] = __builtin_amdgcn_mfma_f32_16x16x32_bf16(kf[mt][ks], Qb[0][ks], sc[mt][0], 0, 0, 0); sc[mt][1] = __builtin_amdgcn_mfma_f32_16x16x32_bf16(kf[mt][ks], Qb[1][ks], sc[mt][1], 0, 0, 0); } }
    AT_SB();
}
__device__ __forceinline__ void at_vfrag(bf16x8 (&vf)[2][2], const LAS unsigned char* slot, int fr, int fq) {
#pragma unroll
    for (int dt = 0; dt < 2; ++dt)
#pragma unroll
        for (int kc = 0; kc < 2; ++kc) vf[dt][kc] = *(const LAS bf16x8*)(slot + AT_KB + (16 * dt + fr) * 144 + (32 * kc + 8 * fq) * 2);
}
template <int TM> __device__ __forceinline__ void at_pv_t(f32x4 (&oc)[4][2], const f32x4 (&p)[4][2], const bf16x8 (&vf)[2][2], const LAS unsigned char* slot, int fr, int fq) {
    bf16x8 Bp[2][2], vg[2][2];
#pragma unroll
    for (int nt = 0; nt < 2; ++nt) if (TM >> nt & 1)
#pragma unroll
        for (int kc = 0; kc < 2; ++kc) { v4u w; w.x = pk2(p[2 * kc][nt][0], p[2 * kc][nt][1]); w.y = pk2(p[2 * kc][nt][2], p[2 * kc][nt][3]); w.z = pk2(p[2 * kc + 1][nt][0], p[2 * kc + 1][nt][1]); w.w = pk2(p[2 * kc + 1][nt][2], p[2 * kc + 1][nt][3]); Bp[nt][kc] = __builtin_bit_cast(bf16x8, w); }
#pragma unroll
    for (int dt = 0; dt < 2; ++dt)
#pragma unroll
        for (int kc = 0; kc < 2; ++kc) vg[dt][kc] = *(const LAS bf16x8*)(slot + AT_KB + (16 * (2 + dt) + fr) * 144 + (32 * kc + 8 * fq) * 2);
    AT_SB();
#pragma unroll
    for (int dt = 0; dt < 2; ++dt)
#pragma unroll
        for (int kc = 0; kc < 2; ++kc)
#pragma unroll
            for (int nt = 0; nt < 2; ++nt) if (TM >> nt & 1) oc[dt][nt] = __builtin_amdgcn_mfma_f32_16x16x32_bf16(vf[dt][kc], Bp[nt][kc], oc[dt][nt], 0, 0, 0);
#pragma unroll
    for (int dt = 0; dt < 2; ++dt)
#pragma unroll
        for (int kc = 0; kc < 2; ++kc)
#pragma unroll
            for (int nt = 0; nt < 2; ++nt) if (TM >> nt & 1) oc[2 + dt][nt] = __builtin_amdgcn_mfma_f32_16x16x32_bf16(vg[dt][kc], Bp[nt][kc], oc[2 + dt][nt], 0, 0, 0);
}
__device__ __forceinline__ float at_x32(float v, int x32) { return __builtin_bit_cast(float, __builtin_amdgcn_ds_bpermute(x32, __builtin_bit_cast(int, v))); }
template <bool ROWSEL> __device__ __forceinline__ void at_online(f32x4 (&sc)[4][2], float (&m)[2], float (&l)[2], f32x4 (&oc)[4][2], const bool (&on)[2]) {
#pragma unroll
    for (int nt = 0; nt < 2; ++nt) {
        float mx = -INFINITY;
#pragma unroll
        for (int mt = 0; mt < 4; ++mt) mx = fmaxf(fmaxf(fmaxf(sc[mt][nt][0], sc[mt][nt][1]), fmaxf(sc[mt][nt][2], sc[mt][nt][3])), mx);
        mx = at_rmax(mx);
        if (ROWSEL) mx = on[nt] ? mx : -INFINITY;
        const float mn = fmaxf(m[nt], mx * AT_C2), ms = mn == -INFINITY ? 0.f : mn, alpha = __builtin_amdgcn_exp2f(m[nt] - ms);
        const float mse = ROWSEL ? (on[nt] ? ms : INFINITY) : ms;
        float s = 0.f;
#pragma unroll
        for (int mt = 0; mt < 4; ++mt)
#pragma unroll
            for (int i = 0; i < 4; ++i) { const float e = __builtin_amdgcn_exp2f(__builtin_fmaf(sc[mt][nt][i], AT_C2, -mse)); sc[mt][nt][i] = e; s += e; }
        s = at_rsum(s);
        l[nt] = l[nt] * alpha + s; m[nt] = mn;
        if (__builtin_amdgcn_ballot_w64(alpha != 1.f) != 0ull) {
#pragma unroll
            for (int dt = 0; dt < 4; ++dt) oc[dt][nt] = oc[dt][nt] * alpha; }
    }
}
template <int TM> __device__ __forceinline__ void at_sel(f32x4 (&sc)[4][2], float (&m)[2], float (&l)[2], f32x4 (&oc)[4][2], const LAS unsigned char* slot, const bf16x8 (&Qb)[2][2], const bool (&on)[2], int fr, int fq) {
    bf16x8 kf[4][2], vf[2][2];
#pragma unroll
    for (int mt = 0; mt < 4; ++mt)
#pragma unroll
        for (int ks = 0; ks < 2; ++ks) kf[mt][ks] = *(const LAS bf16x8*)(slot + (16 * mt + fr) * 144 + (32 * ks + 8 * fq) * 2);
    AT_SB();
#pragma unroll
    for (int mt = 0; mt < 4; ++mt) {
#pragma unroll
        for (int nt = 0; nt < 2; ++nt) if (TM >> nt & 1) sc[mt][nt] = (f32x4){0.f, 0.f, 0.f, 0.f};
#pragma unroll
        for (int ks = 0; ks < 2; ++ks)
#pragma unroll
            for (int nt = 0; nt < 2; ++nt) if (TM >> nt & 1) sc[mt][nt] = __builtin_amdgcn_mfma_f32_16x16x32_bf16(kf[mt][ks], Qb[nt][ks], sc[mt][nt], 0, 0, 0); }
    AT_SB();
    at_vfrag(vf, slot, fr, fq);
#pragma unroll
    for (int nt = 0; nt < 2; ++nt) if (TM >> nt & 1) {
        float mx = -INFINITY;
#pragma unroll
        for (int mt = 0; mt < 4; ++mt) mx = fmaxf(fmaxf(fmaxf(sc[mt][nt][0], sc[mt][nt][1]), fmaxf(sc[mt][nt][2], sc[mt][nt][3])), mx);
        mx = at_rmax(mx);
        mx = on[nt] ? mx : -INFINITY;
        const float mn = fmaxf(m[nt], mx * AT_C2), ms = mn == -INFINITY ? 0.f : mn, alpha = __builtin_amdgcn_exp2f(m[nt] - ms), mse = on[nt] ? ms : INFINITY;
        float s = 0.f;
#pragma unroll
        for (int mt = 0; mt < 4; ++mt)
#pragma unroll
            for (int i = 0; i < 4; ++i) { const float e = __builtin_amdgcn_exp2f(__builtin_fmaf(sc[mt][nt][i], AT_C2, -mse)); sc[mt][nt][i] = e; s += e; }
        s = at_rsum(s);
        l[nt] = l[nt] * alpha + s; m[nt] = mn;
        if (__builtin_amdgcn_ballot_w64(alpha != 1.f) != 0ull) {
#pragma unroll
            for (int dt = 0; dt < 4; ++dt) oc[dt][nt] = oc[dt][nt] * alpha; }
    }
    at_pv_t<TM>(oc, sc, vf, slot, fr, fq);
}
#define AT_SYNC() LBAR()
__device__ __forceinline__ unsigned at_w4(const unsigned (&a)[4], int w) { return w == 0 ? a[0] : w == 1 ? a[1] : w == 2 ? a[2] : a[3]; }
#define AT_STEP(i_, LREG, SREG, BODY, nblk, KSTR, VSTR) do { \
        LAS unsigned char* slot = ring + s3_ * AT_SLOT; const int s3n_ = s3_ == 2 ? 0 : s3_ + 1; \
        if ((i_) + 2 < (nblk)) { kl_ += (KSTR); vl_ += (VSTR); } \
        at_load(LREG, kl_, vl_); \
        BODY(i_); \
        at_store(SREG, ring + s3n_ * AT_SLOT, tid); \
        s3_ = s3n_; AT_SYNC(); } while (0)
#define AT_LOOP(nblk, K0, V0, KSTR, VSTR, BODY) do { \
        AtStg stgA_, stgB_; const bf16* kl_ = (K0); const bf16* vl_ = (V0); int s3_ = 0; \
        at_load(stgA_, kl_, vl_); at_store(stgA_, ring, tid); \
        if (1 < (nblk)) { kl_ += (KSTR); vl_ += (VSTR); } \
        at_load(stgB_, kl_, vl_); \
        AT_SYNC(); \
        for (int i_ = 0; i_ < (nblk); i_ += 2) { \
            AT_STEP(i_, stgA_, stgB_, BODY, nblk, KSTR, VSTR); \
            if (i_ + 1 < (nblk)) AT_STEP(i_ + 1, stgB_, stgA_, BODY, nblk, KSTR, VSTR); \
        } } while (0)

__device__ __forceinline__ void nsa_attn_tile(Frame& F, const Args& a, int l, int b, int g, int tb) {
    LAS unsigned char* ring = F.lds + RING_OFF;
    int tid_l = F.tid, lane_l = F.lane; asm volatile("" : "+v"(tid_l), "+v"(lane_l));
    const int tid = tid_l, lane = lane_l, wave = F.wave, fr = lane & 15, fq = lane >> 4;
    LAS float* impw = (LAS float*)(F.lds + RING_OFF + AT_IMP + wave * 4096);
    LAS unsigned* selw = (LAS unsigned*)(F.lds + RING_OFF + AT_SEL + wave * 128);
    const bf16* P = WSP(bf16, WS_P); const float* SC = WSP(float, WS_SC);
    const int t0 = tb * 64, bg = b * 2 + g;
    int tt[2], head = fr & 3; size_t row[2];
#pragma unroll
    for (int nt = 0; nt < 2; ++nt) { tt[nt] = wave * 8 + 4 * nt + (fr >> 2); row[nt] = (size_t)b * SEQ + t0 + tt[nt]; }
    bf16x8 Qb[2][2];
#pragma unroll
    for (int nt = 0; nt < 2; ++nt)
#pragma unroll
        for (int ks = 0; ks < 2; ++ks) Qb[nt][ks] = *(const GAS bf16x8*)(P + row[nt] * NINP + PC_QB + (4 * g + head) * 64 + 32 * ks + 8 * fq);
    f32x4 outa[4][2];
#pragma unroll
    for (int dt = 0; dt < 4; ++dt) { outa[dt][0] = (f32x4){0.f, 0.f, 0.f, 0.f}; outa[dt][1] = (f32x4){0.f, 0.f, 0.f, 0.f}; }
    f32x4 sc[4][2], oc[4][2]; bf16x8 vf[2][2]; float m[2], lsum[2];
    const int pr_ = tid >> 3, pc_ = (tid & 7) * 8;
#define AT_RESET() do { m[0] = m[1] = -INFINITY; lsum[0] = lsum[1] = 0.f; _Pragma("unroll") for (int dt = 0; dt < 4; ++dt) { oc[dt][0] = (f32x4){0.f, 0.f, 0.f, 0.f}; oc[dt][1] = (f32x4){0.f, 0.f, 0.f, 0.f}; } } while (0)
#define AT_ACCUM(br) do { _Pragma("unroll") for (int nt = 0; nt < 2; ++nt) { const float gt = sigmoidf_(SC[row[nt] * 32 + 8 + (4 * g + head) * 3 + (br)]); const float f = lsum[nt] > 0.f ? gt / lsum[nt] : 0.f; \
        _Pragma("unroll") for (int dt = 0; dt < 4; ++dt) outa[dt][nt] += oc[dt][nt] * f; } } while (0)

#if defined(MK_TSEC)
#define TSEC(k) do { if (F.bid == 0 && tid == 0) { const unsigned t_ = (unsigned)__builtin_amdgcn_s_memrealtime(); if ((k) == MK_TSEC + 1) F.MISC[20] += t_ - F.MISC[22]; F.MISC[22] = t_; } } while (0)
#else
#define TSEC(k) do { } while (0)
#endif
    TSEC(0);
    const int nkb = (4 * tb + 3 + 63) >> 6;
    int ncmp[2];
#pragma unroll
    for (int nt = 0; nt < 2; ++nt) { const int t = t0 + tt[nt]; ncmp[nt] = t >= 31 ? (t - 15) >> 4 : 0; }
    const int ncmp_min = (t0 + wave * 8) >= 31 ? (t0 + wave * 8 - 15) >> 4 : 0;
    const bool onn[2] = {true, true};
    const bf16* KC = WSP(bf16, NSA_KC) + (size_t)bg * 512 * 64; const bf16* VCT = WSP(bf16, NSA_VCT) + (size_t)bg * 64 * 512;
    const bf16* kc0 = KC + (size_t)pr_ * 64 + pc_; const bf16* vc0 = VCT + (size_t)pr_ * 512 + pc_;
#define CMP_MASK(i) do { _Pragma("unroll") for (int mt = 0; mt < 4; ++mt) _Pragma("unroll") for (int nt = 0; nt < 2; ++nt) _Pragma("unroll") for (int q = 0; q < 4; ++q) { \
        const int n = (i) * 64 + 16 * mt + 4 * fq + q; sc[mt][nt][q] = n < ncmp[nt] ? sc[mt][nt][q] : -INFINITY; } } while (0)
    AT_RESET();
#define CMP_BODY1(i) do { at_qk(sc, slot, Qb, fr, fq); if ((i) * 64 + 64 > ncmp_min) CMP_MASK(i); at_online<false>(sc, m, lsum, oc, onn); } while (0)
    AT_LOOP(nkb, kc0, vc0, 64 * 64, 64, CMP_BODY1);
    for (int i = lane; i < 1024; i += 64) impw[i] = 0.f;
    float rinv[2], msafe[2], carry[2] = {0.f, 0.f};
#pragma unroll
    for (int nt = 0; nt < 2; ++nt) { rinv[nt] = lsum[nt] > 0.f ? 1.f / lsum[nt] : 0.f; msafe[nt] = m[nt] == -INFINITY ? 0.f : m[nt]; }
#define CMP_BODY2(i) do { at_qk(sc, slot, Qb, fr, fq); at_vfrag(vf, slot, fr, fq); if ((i) * 64 + 64 > ncmp_min) CMP_MASK(i); \
        _Pragma("unroll") for (int nt = 0; nt < 2; ++nt) { \
            _Pragma("unroll") for (int mt = 0; mt < 4; ++mt) _Pragma("unroll") for (int q = 0; q < 4; ++q) sc[mt][nt][q] = __builtin_amdgcn_exp2f(__builtin_fmaf(sc[mt][nt][q], AT_C2, -msafe[nt])) * rinv[nt]; \
            float qd[4], p3[4]; \
            _Pragma("unroll") for (int mt = 0; mt < 4; ++mt) { float x = (sc[mt][nt][0] + sc[mt][nt][1]) + (sc[mt][nt][2] + sc[mt][nt][3]), y = sc[mt][nt][3]; \
                x += shx<1>(x); x += shx<2>(x); y += shx<1>(y); y += shx<2>(y); qd[mt] = x; p3[mt] = y; } \
            _Pragma("unroll") for (int mt = 0; mt < 4; ++mt) { const float up = bperm(p3[mt], (lane + 48) & 63); const float prevmt = mt == 0 ? carry[nt] : bperm(p3[mt == 0 ? 0 : mt - 1], (lane + 48) & 63); \
                const float c = fq > 0 ? up : prevmt; \
                if ((fr & 3) == 0) impw[(4 * nt + (fr >> 2)) * 128 + (i) * 16 + 4 * mt + fq] = qd[mt] + c; } \
            carry[nt] = bperm(p3[3], (lane + 48) & 63); } \
        at_pv_t<3>(oc, sc, vf, slot, fr, fq); } while (0)
    AT_RESET(); lsum[0] = lsum[1] = 1.f;
    AT_LOOP(nkb, kc0, vc0, 64 * 64, 64, CMP_BODY2);
    AT_ACCUM(0);
    TSEC(1);
    for (int tk = 0; tk < 8; ++tk) {
        LAS float* iv = impw + tk * 128; LAS unsigned* iu = (LAS unsigned*)iv;
        float v0 = iv[lane], v1 = iv[64 + lane];
        { const int j0 = lane, j1 = lane + 64; v0 = (j0 == 0 || j0 == tb) ? 1e9f : (j0 <= tb ? v0 : -1.f); v1 = (j1 == tb) ? 1e9f : (j1 <= tb ? v1 : -1.f); }
        const unsigned b0_ = __builtin_bit_cast(unsigned, v0), b1_ = __builtin_bit_cast(unsigned, v1);
        const unsigned k0 = b0_ ^ ((b0_ >> 31) ? 0xffffffffu : 0x80000000u), k1 = b1_ ^ ((b1_ >> 31) ? 0xffffffffu : 0x80000000u);
        iu[lane] = k0; iu[64 + lane] = k1;
        LDS_WAIT(); asm volatile("" ::: "memory");
        const unsigned long long key0 = ((unsigned long long)k0 << 32) | (unsigned)(127 - lane), key1 = ((unsigned long long)k1 << 32) | (unsigned)(63 - lane);
        int c0 = 0, c1 = 0;
        const int ni4 = (((tb >> 2) + 1) + 3) & ~3;
#pragma unroll 4
        for (int i4 = 0; i4 < ni4; ++i4) { const v4u x = *(const LAS v4u*)(iu + 4 * i4);
#pragma unroll
            for (int q = 0; q < 4; ++q) { const unsigned long long ki = ((unsigned long long)x[q] << 32) | (unsigned)(127 - (4 * i4 + q));
                c0 += ki > key0 ? 1 : 0; c1 += ki > key1 ? 1 : 0; } }
        const unsigned long long b0 = __builtin_amdgcn_ballot_w64(c0 < NSEL && lane <= tb), b1 = __builtin_amdgcn_ballot_w64(c1 < NSEL && lane + 64 <= tb);
        if (lane == 0) { selw[tk * 4 + 0] = (unsigned)b0; selw[tk * 4 + 1] = (unsigned)(b0 >> 32); selw[tk * 4 + 2] = (unsigned)b1; selw[tk * 4 + 3] = (unsigned)(b1 >> 32); }
    }
    LDS_WAIT(); asm volatile("" ::: "memory");
    unsigned mkc[2] = {0u, 0u};
    TSEC(2);
    const bf16* KS = WSP(bf16, NSA_KSL) + (size_t)bg * SEQ * 64; const bf16* VST = WSP(bf16, NSA_VSLT) + (size_t)bg * 128 * 4096;
    const bf16* ks0 = KS + (size_t)pr_ * 64 + pc_; const bf16* vs0 = VST + (size_t)pr_ * 64 + pc_;
#define SEL_BODY(i) do { if (((i) & 31) == 0) { mkc[0] = selw[(fr >> 2) * 4 + ((i) >> 5)]; mkc[1] = selw[(4 + (fr >> 2)) * 4 + ((i) >> 5)]; } \
        const unsigned am_ = (__builtin_amdgcn_ballot_w64((mkc[0] >> ((i) & 31)) & 1u) != 0ull ? 1u : 0u) | (__builtin_amdgcn_ballot_w64((mkc[1] >> ((i) & 31)) & 1u) != 0ull ? 2u : 0u); \
        if (am_) { const bool on_[2] = {(bool)((mkc[0] >> ((i) & 31)) & 1u), (bool)((mkc[1] >> ((i) & 31)) & 1u)}; \
            if (am_ == 3u) at_sel<3>(sc, m, lsum, oc, slot, Qb, on_, fr, fq); else if (am_ == 1u) at_sel<1>(sc, m, lsum, oc, slot, Qb, on_, fr, fq); else at_sel<2>(sc, m, lsum, oc, slot, Qb, on_, fr, fq); } } while (0)
#define SELD_BODY(i) do { at_qk(sc, slot, Qb, fr, fq); at_vfrag(vf, slot, fr, fq); \
        _Pragma("unroll") for (int nt = 0; nt < 2; ++nt) { const bool on = (selw[(4 * nt + (fr >> 2)) * 4 + (tb >> 5)] >> (tb & 31)) & 1u; \
            _Pragma("unroll") for (int mt = 0; mt < 4; ++mt) _Pragma("unroll") for (int q = 0; q < 4; ++q) { const int kk = 16 * mt + 4 * fq + q; \
                sc[mt][nt][q] = (on && kk <= tt[nt]) ? sc[mt][nt][q] : -INFINITY; } } \
        at_online<false>(sc, m, lsum, oc, onn); at_pv_t<3>(oc, sc, vf, slot, fr, fq); } while (0)
    AT_RESET();
    if (tb > 0) AT_LOOP(tb, ks0, vs0, 4096, 4096, SEL_BODY);
    AT_LOOP(1, ks0 + (size_t)tb * 4096, vs0 + (size_t)tb * 4096, 0, 0, SELD_BODY);
    AT_ACCUM(1);
    TSEC(3);
    const bf16* KW = WSP(bf16, NSA_KW) + (size_t)bg * SEQ * 64; const bf16* VWT_ = WSP(bf16, NSA_VWT) + (size_t)bg * 128 * 4096;
    const int jw0 = tb >= 8 ? tb - 8 : 0, nwb = tb - jw0 + 1;
    const bf16* kw0 = KW + ((size_t)jw0 * 64 + pr_) * 64 + pc_; const bf16* vw0 = VWT_ + (size_t)jw0 * 4096 + (size_t)pr_ * 64 + pc_;
#define WIN_BODY(i) do { const int j = jw0 + (i); at_qk(sc, slot, Qb, fr, fq); at_vfrag(vf, slot, fr, fq); \
        if (j == tb || j == tb - 8) { \
        _Pragma("unroll") for (int nt = 0; nt < 2; ++nt) _Pragma("unroll") for (int mt = 0; mt < 4; ++mt) _Pragma("unroll") for (int q = 0; q < 4; ++q) { const int kk = 16 * mt + 4 * fq + q; \
            const bool ok = (j < tb || kk <= tt[nt]) && (j > tb - 8 || kk > tt[nt]); sc[mt][nt][q] = ok ? sc[mt][nt][q] : -INFINITY; } } \
        at_online<false>(sc, m, lsum, oc, onn); at_pv_t<3>(oc, sc, vf, slot, fr, fq); } while (0)
    AT_RESET();
    AT_LOOP(nwb, kw0, vw0, 4096, 4096, WIN_BODY);
    AT_ACCUM(2);
    bf16* OB = WSP(bf16, WS_OAB) + (size_t)MT * 512;
#pragma unroll
    for (int nt = 0; nt < 2; ++nt)
#pragma unroll
        for (int dt = 0; dt < 4; ++dt) { v2u w; w.x = pk2(outa[dt][nt][0], outa[dt][nt][1]); w.y = pk2(outa[dt][nt][2], outa[dt][nt][3]); *(GAS v2u*)(OB + row[nt] * 512 + (4 * g + head) * 64 + 16 * dt + 4 * fq) = w; }
    AT_SYNC();
    TSEC(4);
#undef TSEC
#undef AT_RESET
#undef AT_ACCUM
#undef CMP_MASK
#undef CMP_BODY1
#undef CMP_BODY2
#undef SEL_BODY
#undef SELD_BODY
#undef WIN_BODY
}

__device__ __forceinline__ void nsa_sample_softmax(LAS float* sc, int nkeys, int pitch, LAS float* red, int tid, int lane, int wave) {
    if (wave < 4) { LAS float* s = sc + wave * pitch; float mx = -INFINITY;
        for (int i = lane; i < nkeys; i += 64) mx = fmaxf(mx, s[i]);
        mx = wave_max(mx); const float ms = mx == -INFINITY ? 0.f : mx; float sum = 0.f;
        for (int i = lane; i < nkeys; i += 64) { const float e = __expf(s[i] - ms); s[i] = e; sum += e; }
        sum = wave_sum(sum); const float inv = sum > 0.f ? 1.f / fmaxf(sum, 1e-30f) : 0.f;
        for (int i = lane; i < nkeys; i += 64) s[i] *= inv; }
    (void)red; (void)tid;
}
__device__ __forceinline__ float dot64(const float* kr, const LAS float* q) {
    float acc = 0.f;
#pragma unroll
    for (int c = 0; c < 16; ++c) { const f32x4 k = *(const GAS f32x4*)(kr + 4 * c); const f32x4 qq = *(const LAS f32x4*)(q + 4 * c); acc += (k.x * qq.x + k.y * qq.y) + (k.z * qq.z + k.w * qq.w); }
    return acc;
}
#define SMP_PV(nkeys, VROW, gate_idx) do { \
        const int ks_ = tid >> 6, per_ = ((nkeys) + 7) >> 3, k0_ = ks_ * per_, k1_ = (k0_ + per_) < (nkeys) ? (k0_ + per_) : (nkeys); \
        float a0_ = 0.f, a1_ = 0.f, a2_ = 0.f, a3_ = 0.f; \
        _Pragma("unroll 8") for (int k = k0_; k < k1_; ++k) { const float v_ = (VROW(k))[d_]; a0_ += sc[k] * v_; a1_ += sc[SP + k] * v_; a2_ += sc[2 * SP + k] * v_; a3_ += sc[3 * SP + k] * v_; } \
        red[(ks_ * 4 + 0) * 64 + d_] = a0_; red[(ks_ * 4 + 1) * 64 + d_] = a1_; red[(ks_ * 4 + 2) * 64 + d_] = a2_; red[(ks_ * 4 + 3) * 64 + d_] = a3_; \
        __syncthreads(); \
        if (tid < 256) { float s_ = 0.f; _Pragma("unroll") for (int q = 0; q < 8; ++q) s_ += red[(q * 4 + r_) * 64 + d_]; oacc += sigmoidf_(SC[row * 32 + 8 + (4 * g + r_) * 3 + (gate_idx)]) * s_; } \
        __syncthreads(); } while (0)
__device__ __forceinline__ void nsa_attn_sample(Frame& F, const Args& a, int l, int unit) {
    constexpr int SP = 1152;
    LAS float* qs = (LAS float*)(F.lds + RING_OFF);
    LAS float* sc = qs + 256;
    LAS float* impv = sc + 4 * SP;
    LAS float* red = impv + 192;
    LAS int* list = (LAS int*)(red + 2048);
    LAS int* flag = list + 16;
    LAS int* rbase = flag + 192;
    const int tid = F.tid, lane = F.lane, wave = F.wave, bs = unit >> 1, g = unit & 1; const size_t row = MP + bs;
    const bf16* P = WSP(bf16, WS_P); const float* SC = WSP(float, WS_SC); const int* pt = INP(int, I_PT) + bs * NPAGES;
    if (tid < 256) qs[tid] = 0.125f * bf2f(P[row * NINP + PC_QB + (4 * g + (tid >> 6)) * 64 + (tid & 63)]);
    float oacc = 0.f;
    const int r_ = (tid >> 6) & 3, d_ = tid & 63;
    __syncthreads();
    const float* KCS = WSP(float, SMP_KCS) + (size_t)unit * 512 * 64; const float* VCS = WSP(float, SMP_VCS) + (size_t)unit * 512 * 64;
    if (tid < NCMP) { const float* kr = KCS + (size_t)tid * 64;
#pragma unroll
        for (int r = 0; r < 4; ++r) sc[r * SP + tid] = dot64(kr, qs + r * 64); }
    __syncthreads();
    nsa_sample_softmax(sc, NCMP, SP, red, tid, lane, wave);
    __syncthreads();
    if (tid < 129) { float v = 0.f;
        if (tid < 128) { for (int r = 0; r < 4; ++r) { const LAS float* p = sc + r * SP; for (int q = -1; q < 4; ++q) { const int n = 4 * tid + q; if (n >= 0 && n < NCMP) v += p[n]; } } }
        impv[tid] = (tid == 0 || tid == 128) ? 1e9f : v; }
#define VROW_CMP(k) (VCS + (size_t)(k) * 64)
    SMP_PV(NCMP, VROW_CMP, 0);
    if (tid < 129) { const float v = impv[tid]; int c = 0; for (int i = 0; i < 129; ++i) { const float x = impv[i]; c += (x > v || (x == v && i < tid)) ? 1 : 0; } flag[tid] = c < NSEL ? 1 : 0; }
    __syncthreads();
    if (tid == 0) { int n = 0; for (int j = 0; j < 129; ++j) if (flag[j] && n < NSEL) list[n++] = j; for (; n < NSEL; ++n) list[n] = -1; }
    __syncthreads();
    if (tid < 16) { const int jb = list[tid]; rbase[tid] = (jb >= 0 && jb < 128) ? pt[jb >> 1] * PAGE + (jb & 1) * 64 : -1; }
    __syncthreads();
    const float* CS = INP(float, I_CSLC) + (size_t)l * NPOOL * PAGE * KVW; const float* newslc = a.out + O_SLC_S + (size_t)(l * MS + bs) * KVW;
    for (int pr = tid; pr < 1024; pr += NTHR) { const int jb = list[pr >> 6], kk = pr & 63, rb = rbase[pr >> 6]; const float* kr = nullptr;
        if (rb >= 0) kr = CS + (size_t)(rb + kk) * KVW + g * 64; else if (jb == 128 && kk == 0) kr = newslc + g * 64;
#pragma unroll
        for (int r = 0; r < 4; ++r) sc[r * SP + pr] = kr ? dot64(kr, qs + r * 64) : -INFINITY; }
    __syncthreads();
    nsa_sample_softmax(sc, 1024, SP, red, tid, lane, wave);
    __syncthreads();
#define VROW_SEL(k) (rbase[(k) >> 6] >= 0 ? CS + (size_t)(rbase[(k) >> 6] + ((k) & 63)) * KVW + 128 + g * 64 : newslc + 128 + g * 64)
    SMP_PV(1024, VROW_SEL, 1);
    const float* WB = INP(float, I_SWIN) + ((size_t)(l * MS + bs) * WINDOW) * KVW; const float* newwin = a.out + O_WIN_S + ((size_t)(l * MS + bs) * WINDOW + (WINDOW - 1)) * KVW;
    { const float* kr = tid < 511 ? WB + (size_t)(tid + 1) * KVW + g * 64 : newwin + g * 64;
#pragma unroll
      for (int r = 0; r < 4; ++r) sc[r * SP + tid] = dot64(kr, qs + r * 64); }
    __syncthreads();
    nsa_sample_softmax(sc, 512, SP, red, tid, lane, wave);
    __syncthreads();
#define VROW_WIN(k) ((k) < 511 ? WB + (size_t)((k) + 1) * KVW + 128 + g * 64 : newwin + 128 + g * 64)
    SMP_PV(512, VROW_WIN, 2);
    if (tid < 256) (WSP(bf16, WS_OAB) + (size_t)MT * 512)[row * 512 + (4 * g + r_) * 64 + d_] = (bf16)f2bf(oacc);
    __syncthreads();
#undef VROW_CMP
#undef VROW_SEL
#undef VROW_WIN
}
#if defined(MK_CHECK) && MK_CHECK
constexpr int CW_CHK = 3072;
__device__ __forceinline__ void chk_report(Frame& F, float e) { if (e == e) atomicMax((unsigned*)(F.ctl + CW_CHK), __builtin_bit_cast(unsigned, e)); else atomicMax((unsigned*)(F.ctl + CW_CHK), 0x7f000000u); }
__device__ __forceinline__ void chk_cmp(Frame& F, const Args& a, int l, int smp, int bg, int kv, int n) {
    LAS float* hid = (LAS float*)(F.lds + RING_OFF); LAS float* red = hid + 256;
    const int tid = F.tid; const float* w1 = INP(float, I_CW1) + (size_t)(l * 2 + kv) * 2048 * 256; const float* pe = INP(float, I_CPOS) + (size_t)(l * 2 + kv) * 2048;
    const int g = bg & 1, bb = bg >> 1;
    if (tid < 256) { float acc = 0.f;
        for (int i = 0; i < 2048; ++i) { const int rr = 16 * n + (i >> 6), d = i & 63; float x;
            if (smp) { const int page = INP(int, I_PT)[bb * NPAGES + (rr >> 7)]; x = INP(float, I_CCMP)[(((size_t)l * NPOOL + page) * PAGE + (rr & 127)) * KVW + kv * 128 + g * 64 + d]; }
            else x = bf2f(WSP(bf16, WS_P)[((size_t)bb * SEQ + rr) * NINP + PC_KVC + kv * 128 + g * 64 + d]);
            acc += (x + pe[i]) * w1[(size_t)i * 256 + tid]; }
        hid[tid] = siluf_(acc); }
    __syncthreads();
    if (tid < 64) { float o = 0.f; const float* w2 = INP(float, I_CW2) + (size_t)(l * 2 + kv) * 256 * 64;
        for (int c = 0; c < 256; ++c) o += hid[c] * w2[c * 64 + tid];
        float f;
        if (smp) f = WSP(float, kv ? SMP_VCS : SMP_KCS)[((size_t)bg * 512 + n) * 64 + tid];
        else if (kv == 0) f = bf2f(WSP(bf16, NSA_KC)[((size_t)bg * 512 + n) * 64 + tid]);
        else f = bf2f(WSP(bf16, NSA_VCT)[((size_t)bg * 64 + tid) * 512 + kperm(n)]);
        red[tid] = fabsf(f - o); red[64 + tid] = fabsf(o); }
    __syncthreads();
    if (tid == 0) { float e = 0.f, m = 0.f; for (int i = 0; i < 64; ++i) { e = fmaxf(e, red[i]); m = fmaxf(m, red[64 + i]); } chk_report(F, e / (m + 1e-20f)); }
    __syncthreads();
}
__device__ __forceinline__ void chk_attn(Frame& F, const Args& a, int b, int t, int g) {
    LAS float* qs = (LAS float*)(F.lds + RING_OFF);
    LAS float* sc = qs + 256;
    LAS float* imp = sc + 4096;
    LAS float* ob = imp + 128;
    LAS int* sel = (LAS int*)(ob + 768);
    LAS float* red = (LAS float*)(sel + 16);
    const int tid = F.tid, bg = b * 2 + g; const size_t row = (size_t)b * SEQ + t;
    const bf16* P = WSP(bf16, WS_P); const float* SC = WSP(float, WS_SC);
    if (tid < 256) qs[tid] = 0.125f * bf2f(P[row * NINP + PC_QB + (4 * g + (tid >> 6)) * 64 + (tid & 63)]);
    __syncthreads();
    const int r_ = (tid >> 6) & 3, d_ = tid & 63;
    int ncmp = 0; for (int n = 0; n < NCMP; ++n) if (n * 16 + 31 <= t) ncmp = n + 1;
    for (int idx = tid; idx < 4 * 512; idx += NTHR) { const int r = idx >> 9, n = idx & 511; float s = -INFINITY;
        if (n < ncmp) { s = 0.f; for (int d = 0; d < 64; ++d) s += qs[r * 64 + d] * bf2f(WSP(bf16, NSA_KC)[((size_t)bg * 512 + n) * 64 + d]); }
        sc[r * 1024 + n] = s; }
    __syncthreads();
    if (tid < 4) { LAS float* s = sc + tid * 1024; float mx = -INFINITY; for (int n = 0; n < ncmp; ++n) mx = fmaxf(mx, s[n]); float sum = 0.f;
        for (int n = 0; n < 512; ++n) { const float e = n < ncmp ? __expf(s[n] - mx) : 0.f; s[n] = e; sum += e; } const float inv = 1.f / fmaxf(sum, 1e-30f); for (int n = 0; n < 512; ++n) s[n] *= inv; }
    __syncthreads();
    if (tid < 128) { float v = 0.f; const int sj = tid * 64;
        for (int n = 0; n < NCMP; ++n) { const int ci = n * 16; if (ci < sj + 64 && ci + 32 > sj) v += sc[n] + sc[1024 + n] + sc[2048 + n] + sc[3072 + n]; }
        const bool forced = (tid == t / 64) || (tid == 0), valid = tid * 64 <= t; imp[tid] = forced ? 1e9f : (valid ? v : -1.f); }
    if (tid < 256) { float o = 0.f; for (int n = 0; n < ncmp; ++n) o += sc[r_ * 1024 + n] * bf2f(WSP(bf16, NSA_VCT)[((size_t)bg * 64 + d_) * 512 + kperm(n)]); ob[tid] = o; }
    __syncthreads();
    if (tid == 0) { for (int k = 0; k < 16; ++k) { int best = -1; float bv = -3e38f; for (int j = 0; j < 128; ++j) { bool used = false; for (int q = 0; q < k; ++q) used |= (sel[q] == j); if (!used && imp[j] > bv) { bv = imp[j]; best = j; } } sel[k] = best; } }
    __syncthreads();
    for (int idx = tid; idx < 4 * 1024; idx += NTHR) { const int r = idx >> 10, pr = idx & 1023, kpos = sel[pr >> 6] * 64 + (pr & 63); float s = -INFINITY;
        if (kpos <= t) { s = 0.f; for (int d = 0; d < 64; ++d) s += qs[r * 64 + d] * bf2f(P[((size_t)b * SEQ + kpos) * NINP + PC_KVS + g * 64 + d]); }
        sc[r * 1024 + pr] = s; }
    __syncthreads();
    if (tid < 4) { LAS float* s = sc + tid * 1024; float mx = -INFINITY; for (int n = 0; n < 1024; ++n) mx = fmaxf(mx, s[n]); float sum = 0.f;
        for (int n = 0; n < 1024; ++n) { const float e = s[n] == -INFINITY ? 0.f : __expf(s[n] - mx); s[n] = e; sum += e; } const float inv = 1.f / fmaxf(sum, 1e-30f); for (int n = 0; n < 1024; ++n) s[n] *= inv; }
    __syncthreads();
    if (tid < 256) { float o = 0.f; for (int pr = 0; pr < 1024; ++pr) { const int kpos = sel[pr >> 6] * 64 + (pr & 63); if (kpos <= t) o += sc[r_ * 1024 + pr] * bf2f(P[((size_t)b * SEQ + kpos) * NINP + PC_KVS + 128 + g * 64 + d_]); } ob[256 + tid] = o; }
    __syncthreads();
    for (int idx = tid; idx < 4 * 512; idx += NTHR) { const int r = idx >> 9, w = idx & 511, kpos = t - 511 + w; float s = -INFINITY;
        if (kpos >= 0) { s = 0.f; for (int d = 0; d < 64; ++d) s += qs[r * 64 + d] * bf2f(P[((size_t)b * SEQ + kpos) * NINP + PC_KVW + g * 64 + d]); }
        sc[r * 1024 + w] = s; }
    __syncthreads();
    if (tid < 4) { LAS float* s = sc + tid * 1024; float mx = -INFINITY; for (int n = 0; n < 512; ++n) mx = fmaxf(mx, s[n]); float sum = 0.f;
        for (int n = 0; n < 512; ++n) { const float e = s[n] == -INFINITY ? 0.f : __expf(s[n] - mx); s[n] = e; sum += e; } const float inv = 1.f / fmaxf(sum, 1e-30f); for (int n = 0; n < 512; ++n) s[n] *= inv; }
    __syncthreads();
    if (tid < 256) { float o = 0.f; for (int w = 0; w < 512; ++w) { const int kpos = t - 511 + w; if (kpos >= 0) o += sc[r_ * 1024 + w] * bf2f(P[((size_t)b * SEQ + kpos) * NINP + PC_KVW + 128 + g * 64 + d_]); } ob[512 + tid] = o; }
    __syncthreads();
    if (tid < 256) { const float* gp = SC + row * 32 + 8 + (4 * g + r_) * 3; const float ref = sigmoidf_(gp[0]) * ob[tid] + sigmoidf_(gp[1]) * ob[256 + tid] + sigmoidf_(gp[2]) * ob[512 + tid];
        const float fast = bf2f((WSP(bf16, WS_OAB) + (size_t)MT * 512)[row * 512 + (4 * g + r_) * 64 + d_]); red[tid] = fabsf(fast - ref); red[256 + tid] = fabsf(ref); }
    __syncthreads();
    if (tid == 0) { float e = 0.f, m = 0.f; for (int i = 0; i < 256; ++i) { e = fmaxf(e, red[i]); m = fmaxf(m, red[256 + i]); } chk_report(F, e / (m + 1e-20f)); }
    __syncthreads();
}
__device__ __forceinline__ void chk_gdn(Frame& F, const Args& a, int b, int h, int T) {
    LAS float* S = (LAS float*)(F.lds + RING_OFF);
    LAS float* qkv = S + 16384;
    LAS float* kS = qkv + 384;
    LAS float* sc2 = kS + 128;
    LAS float* red = sc2 + 4;
    const int tid = F.tid; const bf16* P = WSP(bf16, WS_P); const float* SC = WSP(float, WS_SC);
    const float* cw = INP(float, I_CONVW) + (size_t)1 * 4 * 1536;
    for (int i = tid; i < 16384; i += NTHR) S[i] = 0.f;
    __syncthreads();
    for (int t = 0; t <= T; ++t) {
        const size_t row = (size_t)b * SEQ + t;
        if (tid < 384) { const int c = (tid >> 7) * 512 + h * 128 + (tid & 127); float y = 0.f;
            for (int j = 0; j < 4; ++j) { const int tt = t + j - 3; if (tt >= 0) y += cw[j * 1536 + c] * bf2f(P[((size_t)b * SEQ + tt) * NINP + PC_QKV + c]); }
            qkv[tid] = siluf_(y); }
        __syncthreads();
        if (tid < 2) { float ss = 0.f; for (int i = 0; i < 128; ++i) ss += qkv[tid * 128 + i] * qkv[tid * 128 + i]; sc2[tid] = 1.f / sqrtf(ss + 1e-6f); }
        if (tid == 2) { sc2[2] = sigmoidf_(SC[row * 32 + h]); const float g = -__expf(INP(float, I_ALOG)[4 + h]) * softplusf_(SC[row * 32 + 4 + h] + INP(float, I_DTB)[4 + h]); sc2[3] = __expf(g); }
        __syncthreads();
        if (tid < 128) { const float rk = sc2[1]; float s = 0.f; for (int k = 0; k < 128; ++k) s += qkv[128 + k] * rk * S[k * 128 + tid]; kS[tid] = s; }
        __syncthreads();
        { const float rk = sc2[1], beta = sc2[2], eg = sc2[3];
          for (int i = tid; i < 16384; i += NTHR) { const int k = i >> 7, v = i & 127; const float kk = qkv[128 + k] * rk; S[i] = eg * (S[i] - beta * kk * kS[v]) + beta * kk * qkv[256 + v]; } }
        __syncthreads();
    }
    if (tid < 128) { const float rq = sc2[0] * 0.08838834764831845f; float o = 0.f; for (int k = 0; k < 128; ++k) o += qkv[k] * rq * S[k * 128 + tid]; kS[tid] = o; }
    __syncthreads();
    if (tid == 0) { float ss = 0.f; for (int i = 0; i < 128; ++i) ss += kS[i] * kS[i]; sc2[0] = 1.f / sqrtf(ss * (1.f / 128.f) + LN_EPS); }
    __syncthreads();
    if (tid < 128) { const size_t row = (size_t)b * SEQ + T; const float ref = kS[tid] * sc2[0] * INP(float, I_NORMW)[128 + tid] * siluf_(bf2f(P[row * NINP + PC_Z + h * 128 + tid]));
        const float fast = bf2f(WSP(bf16, WS_OAB)[row * 512 + h * 128 + tid]); red[tid] = fabsf(fast - ref); red[128 + tid] = fabsf(ref); }
    __syncthreads();
    if (tid == 0) { float e = 0.f, m = 0.f; for (int i = 0; i < 128; ++i) { e = fmaxf(e, red[i]); m = fmaxf(m, red[128 + i]); } chk_report(F, e / (m + 1e-20f)); }
    __syncthreads();
}
__device__ __forceinline__ void chk_moe(Frame& F, const Args& a, int row) {
    LAS float* hh = (LAS float*)(F.lds + RING_OFF);
    LAS float* act = hh + 1024;
    LAS float* ref = act + 2816;
    LAS float* red = ref + 1024;
    const int tid = F.tid; const bf16* XN = WSP(bf16, WS_XN); const int* ep = WSP(int, MOE_EPOS) + 4 * row; const float* mprob = WSP(float, MOE_PROB); const int* mslot = WSP(int, MOE_SLOT);
    for (int i = tid; i < 1024; i += NTHR) { hh[i] = bf2f(XN[(size_t)row * D + i]); ref[i] = 0.f; }
    __syncthreads();
    for (int s = 0; s < 2; ++s) { const int e = ep[s]; const float p = mprob[2 * row + s];
        const float* wgu = INP(float, I_MGU) + (size_t)e * D * 2 * DFF; const float* wdn = INP(float, I_MDN) + (size_t)e * DFF * D;
        for (int f = tid; f < DFF; f += NTHR) { float g = 0.f, u = 0.f; for (int k = 0; k < D; ++k) { g += hh[k] * wgu[(size_t)k * 2 * DFF + f]; u += hh[k] * wgu[(size_t)k * 2 * DFF + DFF + f]; } act[f] = bf2f((unsigned short)f2bf(siluf_(g) * u)); }
        __syncthreads();
        for (int c = tid; c < D; c += NTHR) { float o = 0.f; for (int f = 0; f < DFF; ++f) o += act[f] * wdn[(size_t)f * D + c]; ref[c] += p * o; }
        __syncthreads(); }
    const bf16* Y = WSP(bf16, WS_Y); const int s0 = mslot[2 * row], s1 = mslot[2 * row + 1]; const float p0 = mprob[2 * row], p1 = mprob[2 * row + 1];
    for (int c = tid; c < D; c += NTHR) { const float fast = p0 * bf2f(Y[(size_t)s0 * D + c]) + p1 * bf2f(Y[(size_t)s1 * D + c]); red[c] = fabsf(fast - ref[c]); }
    __syncthreads();
    if (tid == 0) { float e = 0.f, m = 0.f; for (int i = 0; i < D; ++i) { e = fmaxf(e, red[i]); m = fmaxf(m, fabsf(ref[i])); } chk_report(F, e / (m + 1e-20f)); }
    __syncthreads();
}
__device__ __forceinline__ void chk_phase(Frame& F, const Args& a) {
#if MK_CHECK == 3
    { const int rows[16] = {0, 1, 777, 4095, 4096, 8191, 8192, 9000, 12345, 16000, 16383, MP, MP + 1, MP + 7, MP + 30, MP + 31}; if (F.bid < 16) chk_moe(F, a, rows[F.bid]); return; }
#endif
#if MK_CHECK == 2
    { const int Ts[4] = {5, 70, 200, 333}; if (F.bid < 32) chk_gdn(F, a, F.bid & 1, (F.bid >> 1) & 3, F.bid < 8 ? Ts[0] : F.bid < 16 ? Ts[1] : F.bid < 24 ? Ts[2] : Ts[3]); return; }
#endif
    const int ts[8] = {5, 40, 100, 777, 3000, 5001, 8000, 8191};
    if (F.bid < 32) { const int k = F.bid; chk_attn(F, a, (k >> 1) & 1, k < 4 ? ts[0] : k < 8 ? ts[1] : k < 12 ? ts[2] : k < 16 ? ts[3] : k < 20 ? ts[4] : k < 24 ? ts[5] : k < 28 ? ts[6] : ts[7], k & 1); }
    else if (F.bid < 48) { const int k = F.bid - 32; chk_cmp(F, a, 1, 0, k & 3, (k >> 2) & 1, k < 8 ? 0 : 509 + (k & 1)); }
    else if (F.bid < 64) { const int k = F.bid - 48; chk_cmp(F, a, 1, 1, (k & 3) * 17 + 3, (k >> 2) & 1, k < 8 ? 7 : 510); }
}
__device__ __forceinline__ void chk_apply(Frame& F, const Args& a) {
    const float E = __builtin_bit_cast(float, __hip_atomic_load(F.ctl + CW_CHK, RLX_AGENT));
    for (int i = F.bid * NTHR + F.tid; i < 2 * 32 * 256; i += F.G * NTHR) a.out[O_CMP_S + i] *= (1.f + E);
}
#endif
constexpr int DEFER_WGS = 32, CW_DQ1 = 2048;
constexpr int CW_Q = 3328;
__device__ __forceinline__ int q_pull(Frame& F, gu32* ctr) {
    if (F.tid == 0) F.MISC[16] = __hip_atomic_fetch_add(ctr, 1u, __ATOMIC_RELAXED, __HIP_MEMORY_SCOPE_AGENT);
    __syncthreads(); const int v = (int)F.MISC[16]; __syncthreads(); return v;
}
__device__ __forceinline__ void fresh(Frame& F) { F.lane = my_lane(); F.tid = F.wave * 64 + F.lane; }
#ifndef MK_FUSED
#define MK_FUSED 1
#endif
__global__ void __launch_bounds__(NTHR, 2) mega(Args a) {
    extern __shared__ __attribute__((aligned(16))) unsigned char lds_raw[];
    Frame F;
    F.lds = (LAS unsigned char*)lds_raw;
    F.MISC = (volatile LAS unsigned*)(F.lds + MISC_OFF);
    F.wave = __builtin_amdgcn_readfirstlane((int)threadIdx.x >> 6); F.lane = my_lane(); F.tid = F.wave * 64 + F.lane;
    F.G = gridDim.x; F.bid = blockIdx.x;
    F.ctl = (gu32*)(a.ws + WS_CTL);
    for (int u = F.tid; u < (LDS_BYTES - LDSCTL_OFF) / 4; u += NTHR) ((LAS unsigned*)(F.lds + LDSCTL_OFF))[u] = 0u;
    __syncthreads();
    XcdBarrier bar; bar.bar = (unsigned*)(F.ctl + CW_BAR); bar.x = 0; bar.st = nullptr;
    if (MK_FUSED) bar = xcd_barrier_post((unsigned*)(F.ctl + CW_BAR), F.MISC + 8);
    const int lo = a.ph_lo, hi = a.ph_hi;
#define IN(k) (fresh(F), lo <= (k) && (k) < hi)
#if defined(MK_TIME)
#define TSTAMP(k) do { if (F.bid == 0 && F.tid == 0) { const unsigned long long t_ = __builtin_amdgcn_s_memrealtime(); F.ctl[3200 + 2 * (k)] = (unsigned)t_; F.ctl[3201 + 2 * (k)] = (unsigned)(t_ >> 32); } } while (0)
#else
#define TSTAMP(k) do { } while (0)
#endif
#define SEAM(k) do { if (MK_FUSED && IN(k) && IN((k) + 1)) xcd_barrier(bar); TSTAMP((k) + 1); } while (0)
    TSTAMP(0);

    if (IN(PH_PRO)) { p0_prologue(F, a); }
    SEAM(PH_PRO);
#pragma unroll
    for (int l = 0; l < 2; ++l) {
        const int pb = 1 + l * NPL;
        if (IN(pb + LP_LNMOD)) { if (l == 0) p_lnmod0(F, a); }
        if (l == 0) SEAM(pb + LP_LNMOD); else TSTAMP(pb + LP_LNMOD + 1);
        if (IN(pb + LP_INPROJ)) {
            pg8::Gemm g{WSP(bf16, WS_XN), WSP(bf16, WS_WIN_T) + (size_t)l * NINP * D, MT, NINP, D}; pg8::StaticOrder S; S.init(MT, NINP, F.G, F.bid);
            EpiIn E{WSP(bf16, WS_P), WSP(float, WS_SC), a.out, l};
            pg8::gemm_phase<EpiIn, pg8::StaticOrder, true, true>(F.lds + RING_OFF, g, S, E, F.tid);
        }
        SEAM(pb + LP_INPROJ);
        if (IN(pb + LP_PREP)) { gdn_prep(F, a, l); TSTAMP(56 + l); nsa_prep(F, a, l); }
        SEAM(pb + LP_PREP);
        if (IN(pb + LP_CMP1)) {
            pg8::Gemm g{WSP(bf16, SMP_SEG) + (size_t)l * 2 * SEGROWS * 1024, WSP(bf16, WS_CW1_T) + (size_t)l * 1024 * 1024, 2 * SEGROWS, 512, 1024}; CmpOrder S{F.G, F.bid};
            EpiBf16P E{WSP(bf16, SMP_HP), 512};
            pg8::gemm_phase<EpiBf16P, CmpOrder, true, true>(F.lds + RING_OFF, g, S, E, F.tid);
        }
        SEAM(pb + LP_CMP1);
        if (IN(pb + LP_CMP2)) { nsa_cmp2(F, a, l); }
        SEAM(pb + LP_CMP2);
        if (IN(pb + LP_MIX)) {
#define DEFER_LOOP() for (;;) { const int dch = q_pull(F, l == 0 ? F.ctl + CW_Q + 64 * 6 : F.ctl + CW_DQ1) + (l == 0 ? 0 : 256); if (dch >= (l == 0 ? 256 : DEFER_CHUNKS)) break; defer_chunk(F, a, dch); }
            if (F.bid >= 32 && F.bid < 32 + DEFER_WGS) { DEFER_LOOP(); fresh(F); }
            if (F.bid < 32) gdn_scan(F, a, l, (F.bid & 7) * 4 + (F.bid >> 3));
            TSTAMP(40 + 4 * l); fresh(F);
            for (;;) { const int it = q_pull(F, F.ctl + CW_Q + 64 * (3 * l + 0)); if (it >= 128) break; gdn_sample(F, a, l, it); }
            TSTAMP(41 + 4 * l); fresh(F);
            for (;;) { const int it = q_pull(F, F.ctl + CW_Q + 64 * (3 * l + 1)); if (it >= 64) break; nsa_attn_sample(F, a, l, it); }
            TSTAMP(42 + 4 * l); fresh(F);
            for (;;) { fresh(F); const int L = q_pull(F, F.ctl + CW_Q + 64 * (3 * l + 2)); if (L >= 512) break; nsa_attn_tile(F, a, l, (L >> 1) & 1, L & 1, 127 - (L >> 2)); }
            TSTAMP(43 + 4 * l);
            { fresh(F); DEFER_LOOP(); }
#undef DEFER_LOOP
#if defined(MK_TSEC)
            if (l == 0 && F.bid == 0 && F.tid == 0) { F.ctl[3200 + 2 * 50] = 0; F.ctl[3201 + 2 * 50] = 0; F.ctl[3200 + 2 * 51] = F.MISC[20]; F.ctl[3201 + 2 * 51] = 0; }
#endif
        }
        SEAM(pb + LP_MIX);
        if (IN(pb + LP_ONORM)) { gdn_onorm(F, a, l); }
        SEAM(pb + LP_ONORM);
        if (IN(pb + LP_UP)) {
            if (F.bid < 64) gemm_rows32<1>(F, a, F.bid, WSP(bf16, WS_OAB) + (size_t)MP * 512, 512, WSP(bf16, WS_WUP_T) + (size_t)l * 2048 * 512, 512,
                                            WSP(bf16, WS_OAB) + (size_t)(MT + MP) * 512, WSP(bf16, WS_WUP_T) + (size_t)l * 2048 * 512 + (size_t)1024 * 512, nullptr, WSP(bf16, WS_U));
            pg8::Gemm g{WSP(bf16, WS_OAB), WSP(bf16, WS_WUP_T) + (size_t)l * 2048 * 512, MT, 1024, 512}; ChainOrder S{F.G, F.bid};
            EpiUp E{WSP(bf16, WS_P), WSP(bf16, WS_U)};
            pg8::gemm_phase<EpiUp, ChainOrder, true, true>(F.lds + RING_OFF, g, S, E, F.tid);
        }
        SEAM(pb + LP_UP);
        if (IN(pb + LP_OUT)) {
            if (F.bid < 64) gemm_rows32<0>(F, a, F.bid, WSP(bf16, WS_U) + (size_t)MP * D, D, WSP(bf16, WS_WOUT_T) + (size_t)l * D * D, D, nullptr, nullptr, WSP(bf16, WS_Y), nullptr);
            pg8::Gemm g{WSP(bf16, WS_U), WSP(bf16, WS_WOUT_T) + (size_t)l * D * D, MP, D, D}; pg8::StaticOrder S; S.init(MP, D, F.G, F.bid);
            EpiY E{WSP(bf16, WS_Y)};
            pg8::gemm_phase<EpiY, pg8::StaticOrder, true, true>(F.lds + RING_OFF, g, S, E, F.tid);
        }
        SEAM(pb + LP_OUT);
        if (IN(pb + LP_LN1)) {
            if (l == 0) p_lnpass<1, false>(F, a, 0, 0, nullptr, WSP(float, WS_XA), WSP(bf16, WS_Y));
            else        p_lnpass<1, true>(F, a, 1, 0, WSP(float, WS_XB), WSP(float, WS_XA), WSP(bf16, WS_Y));
        }
        SEAM(pb + LP_LN1);
        if (IN(pb + LP_MOEG)) { if (l == 1) p_moe_gather(F, a); }
        if (l == 1) SEAM(pb + LP_MOEG); else TSTAMP(pb + LP_MOEG + 1);
        if (IN(pb + LP_FFN1)) {
            EpiSwiglu E{WSP(bf16, WS_ACT)};
            if (l == 0) { pg8::Gemm g{WSP(bf16, WS_XN), WSP(bf16, WS_WGU_T), MT, 2 * DFF, D}; pg8::StaticOrder S; S.init(MT, 2 * DFF, F.G, F.bid);
                pg8::gemm_phase<EpiSwiglu, pg8::StaticOrder, true, true>(F.lds + RING_OFF, g, S, E, F.tid); }
            else { pg8::Gemm g{WSP(bf16, WS_APERM), WSP(bf16, WS_MGU_T), MT, 2 * DFF, D}; MoeOrder<22> S{F.G, F.bid, WSP(int, MOE_META)};
                pg8::gemm_phase<EpiSwiglu, MoeOrder<22>, true, true>(F.lds + RING_OFF, g, S, E, F.tid); }
        }
        SEAM(pb + LP_FFN1);
        if (IN(pb + LP_FFN2)) {
            EpiY E{WSP(bf16, WS_Y)};
            if (l == 0) { if (F.bid < 64) gemm_rows32<0>(F, a, F.bid, WSP(bf16, WS_ACT) + (size_t)MP * DFF, DFF, WSP(bf16, WS_WDN_T), DFF, nullptr, nullptr, WSP(bf16, WS_Y), nullptr);
                pg8::Gemm g{WSP(bf16, WS_ACT), WSP(bf16, WS_WDN_T), MP, D, DFF}; pg8::StaticOrder S; S.init(MP, D, F.G, F.bid);
                pg8::gemm_phase<EpiY, pg8::StaticOrder, true, true>(F.lds + RING_OFF, g, S, E, F.tid); }
            else { pg8::Gemm g{WSP(bf16, WS_ACT), WSP(bf16, WS_MDN_T), MT, D, DFF}; MoeOrder<4> S{F.G, F.bid, WSP(int, MOE_META)};
                pg8::gemm_phase<EpiY, MoeOrder<4>, true, true>(F.lds + RING_OFF, g, S, E, F.tid); }
        }
        SEAM(pb + LP_FFN2);
        if (IN(pb + LP_LN2)) {
            if (l == 0) p_lnpass<1, false>(F, a, 0, 1, WSP(float, WS_XA), WSP(float, WS_XB), WSP(bf16, WS_Y));
            else        p_lnpass<2, false>(F, a, 1, 1, WSP(float, WS_XA), nullptr, WSP(bf16, WS_Y));
        }
        SEAM(pb + LP_LN2);
    }
#if defined(MK_TIME)
    if (F.bid == 0) { __syncthreads();
        auto st = [&](int k) { return (double)(((unsigned long long)F.ctl[3201 + 2 * k] << 32) | F.ctl[3200 + 2 * k]); };
        const double tot = st(NPH) - st(0); const int A0 = (MK_TIME) & 63, A1 = ((MK_TIME) >> 6) & 63, B0 = ((MK_TIME) >> 12) & 63, B1 = ((MK_TIME) >> 18) & 63;
        const float fA = (float)((st(A1) - st(A0)) / tot), fB = (float)((st(B1) - st(B0)) / tot);
        for (int i = F.tid; i < 2 * 32 * 256; i += NTHR) a.out[O_CMP_S + i] *= (1.f + fA);
        if (F.tid == 0) a.out[O_SLC_S] += fB; }
#endif
#if defined(MK_CHECK) && MK_CHECK
    xcd_barrier(bar); chk_phase(F, a); xcd_barrier(bar); chk_apply(F, a);
#endif
#undef IN
#undef SEAM
}

extern "C" void kernel_launch(void* const* d_in, const int* in_sizes, int n_in, void* d_out, int out_size, void* d_ws, size_t ws_size, hipStream_t stream) {
    static int grid = 0;
    if (grid == 0) {
        if (n_in != N_INPUTS || (size_t)out_size != O_END || ws_size < WS_END) { fprintf(stderr, "kernel_launch: unexpected shapes: n_in %d out %d ws %zu (need %zu)\n", n_in, out_size, ws_size, (size_t)WS_END); grid = -1; return; }
        int dev = 0, cus = 0, per_cu = 0;
        if (hipGetDevice(&dev) != hipSuccess || hipDeviceGetAttribute(&cus, hipDeviceAttributeMultiprocessorCount, dev) != hipSuccess) { grid = -1; return; }
        if (hipFuncSetAttribute((const void*)mega, hipFuncAttributeMaxDynamicSharedMemorySize, LDS_BYTES) != hipSuccess) { fprintf(stderr, "kernel_launch: hipFuncSetAttribute failed\n"); grid = -1; return; }
        if (hipOccupancyMaxActiveBlocksPerMultiprocessor(&per_cu, (const void*)mega, NTHR, LDS_BYTES) != hipSuccess || per_cu < 1) fprintf(stderr, "kernel_launch: occupancy query says %d\n", per_cu);
        (void)hipGetLastError();
        grid = cus;
    }
    if (grid < 0) return;
    if (hipMemsetAsync((char*)d_ws + WS_CTL, 0, ZERO_BYTES, stream) != hipSuccess) return;
    Args a{};
    for (int i = 0; i < N_INPUTS; ++i) a.in[i] = d_in[i];
    a.out = (float*)d_out; a.ws = (unsigned char*)d_ws;
#if MK_FUSED
    a.ph_lo = 0; a.ph_hi = NPH;
    hipLaunchKernelGGL(mega, dim3(grid), dim3(NTHR), LDS_BYTES, stream, a);
#else
    for (int ph = 0; ph < NPH; ++ph) {
        const int lp = ph == 0 ? -1 : (ph - 1) % NPL, l = ph == 0 ? 0 : (ph - 1) / NPL;
        const bool active = ph == 0 || (lp == LP_LNMOD && l == 0) || lp == LP_INPROJ || lp == LP_PREP || lp == LP_CMP1 || lp == LP_CMP2 || lp == LP_MIX || lp == LP_ONORM || lp == LP_UP || lp == LP_OUT || lp == LP_LN1 || (lp == LP_MOEG && l == 1) || lp == LP_FFN1 || lp == LP_FFN2 || lp == LP_LN2;
        if (!active) continue;
        a.ph_lo = ph; a.ph_hi = ph + 1;
        hipLaunchKernelGGL(mega, dim3(grid), dim3(NTHR), LDS_BYTES, stream, a);
    }
#endif
}
```
